# Optimizing an MI355X kernel written in HIP

```python
import math
import jax, jax.numpy as jnp
from jax import lax
import numpy as np

D_MODEL = 1024
BATCH = 4
SEQ = 8192
DEPTH = 2

D_MIX = D_MODEL
D_POOL = D_MIX // 4
D_S5 = 3 * D_MIX // 8
D_LRU = D_MIX - D_POOL - D_S5
D_IN = D_POOL + D_S5 + 2 * D_LRU

POOL_WINDOWS = (2, 4, 8, 16)
POOL_GROUP = D_POOL // len(POOL_WINDOWS)

S5_GROUP = 16
S5_NGROUPS = D_S5 // S5_GROUP
S5_STATE = 64
S5_DT_MIN = 1e-3
S5_DT_MAX = 1e-1

LRU_HEADS = 6
LRU_HEAD_DIM = D_LRU // LRU_HEADS
CONV_WIDTH = 4
RG_C = 8.0

N_EXPERTS = 32
TOP_K = 4
D_FF = D_MODEL
SWIGLU_LIMIT = 7.0
SWIGLU_ALPHA = 1.702
MOE_BLOCK = 128
EPS = 1e-5

kernel_name = "hybrid_pool_s5_rglru_moe_encoder"


def rmsnorm(x, g):
    xf = x.astype(jnp.float32)
    y = xf * lax.rsqrt(jnp.mean(xf * xf, axis=-1, keepdims=True) + EPS)
    return (y * g.astype(jnp.float32)).astype(x.dtype)


def pool_mixer(u, pool_w, pool_scale):
    b, s, _ = u.shape
    uf = u.astype(jnp.float32)
    cs = jnp.concatenate([jnp.zeros((b, 1, D_POOL), jnp.float32), jnp.cumsum(uf, axis=1)], axis=1)
    t = jnp.arange(s)
    outs = []
    for g, w in enumerate(POOL_WINDOWS):
        half = w // 2
        lo = jnp.maximum(t - half, 0)
        hi = jnp.minimum(t + half, s)
        sl = slice(g * POOL_GROUP, (g + 1) * POOL_GROUP)
        csg = cs[..., sl]
        mean = (jnp.take(csg, hi, axis=1) - jnp.take(csg, lo, axis=1)) / (hi - lo).astype(jnp.float32)[None, :, None]
        d = (mean - uf[..., sl]).astype(u.dtype)
        outs.append(jnp.einsum('bsc,cd->bsd', d, pool_w[g]))
    return jnp.concatenate(outs, axis=-1) * pool_scale


def _cplx_lin_combine(left, right):
    a1r, a1i, b1r, b1i = left
    a2r, a2i, b2r, b2i = right
    return (a2r * a1r - a2i * a1i,
            a2r * a1i + a2i * a1r,
            a2r * b1r - a2i * b1i + b2r,
            a2r * b1i + a2i * b1r + b2i)


def _lin_combine(left, right):
    a1, b1 = left
    a2, b2 = right
    return (a2 * a1, a2 * b1 + b2)


def _s5_scan(ug, lam_re, lam_im, log_step, b_re, b_im, c_re, c_im, reverse):
    lr = lam_re.astype(jnp.float32)
    li = lam_im.astype(jnp.float32)
    dt = jnp.exp(log_step.astype(jnp.float32))[:, None]
    mag = jnp.exp(lr * dt)
    abar_re = mag * jnp.cos(li * dt)
    abar_im = mag * jnp.sin(li * dt)
    den = lr * lr + li * li
    nr = abar_re - 1.0
    ni = abar_im
    q_re = (nr * lr + ni * li) / den
    q_im = (ni * lr - nr * li) / den
    br = b_re.astype(jnp.float32)
    bi = b_im.astype(jnp.float32)
    bb_re = q_re[..., None] * br - q_im[..., None] * bi
    bb_im = q_re[..., None] * bi + q_im[..., None] * br
    bu_re = jnp.einsum('bsgc,gpc->bsgp', ug, bb_re)
    bu_im = jnp.einsum('bsgc,gpc->bsgp', ug, bb_im)
    a_re = jnp.broadcast_to(abar_re, bu_re.shape)
    a_im = jnp.broadcast_to(abar_im, bu_re.shape)
    _, _, xr, xi = lax.associative_scan(_cplx_lin_combine, (a_re, a_im, bu_re, bu_im), axis=1, reverse=reverse)
    return (jnp.einsum('bsgp,gcp->bsgc', xr, c_re.astype(jnp.float32))
            - jnp.einsum('bsgp,gcp->bsgc', xi, c_im.astype(jnp.float32)))


def s5_mixer(u, lam_re, lam_im, log_step, b_re, b_im, c_re, c_im, d_skip, w_glu, b_glu):
    b, s, _ = u.shape
    uf = u.astype(jnp.float32)
    ug = uf.reshape(b, s, S5_NGROUPS, S5_GROUP)
    y = d_skip.astype(jnp.float32) * uf
    for dirn, rev in enumerate((False, True)):
        y = y + _s5_scan(ug, lam_re[dirn], lam_im[dirn], log_step[dirn], b_re[dirn], b_im[dirn],
                         c_re[dirn], c_im[dirn], rev).reshape(b, s, D_S5)
    v = jax.nn.gelu(y).astype(u.dtype)
    gl = v @ w_glu + b_glu
    return gl[..., :D_S5] * jax.nn.sigmoid(gl[..., D_S5:])


def rglru_mixer(u, gate, conv_w, conv_b, w_a, b_a, w_x, b_x, lam):
    b, s, _ = u.shape
    xc = lax.conv_general_dilated(u, conv_w[:, None, :], window_strides=(1,), padding=[(1, 2)],
                                  dimension_numbers=('NWC', 'WIO', 'NWC'),
                                  feature_group_count=D_LRU) + conv_b
    xf = xc.astype(jnp.float32)
    xh = xf.reshape(b, s, LRU_HEADS, LRU_HEAD_DIM)
    h_sum = jnp.zeros_like(xf)
    for dirn, rev in enumerate((False, True)):
        r = jax.nn.sigmoid(jnp.einsum('bshi,hij->bshj', xh, w_a[dirn].astype(jnp.float32)).reshape(b, s, D_LRU)
                           + b_a[dirn].astype(jnp.float32))
        ig = jax.nn.sigmoid(jnp.einsum('bshi,hij->bshj', xh, w_x[dirn].astype(jnp.float32)).reshape(b, s, D_LRU)
                            + b_x[dirn].astype(jnp.float32))
        log_a = -RG_C * r * jax.nn.softplus(-lam[dirn].astype(jnp.float32))
        a = jnp.exp(log_a)
        bt = jnp.sqrt(-jnp.expm1(2.0 * log_a)) * (ig * xf)
        _, hdir = lax.associative_scan(_lin_combine, (a, bt), axis=1, reverse=rev)
        h_sum = h_sum + hdir
    return (h_sum * jax.nn.gelu(gate.astype(jnp.float32))).astype(u.dtype)


def token_mixer(h, w_in, pool_w, pool_scale, s5_lam_re, s5_lam_im, s5_log_step, s5_b_re, s5_b_im,
                s5_c_re, s5_c_im, s5_d, s5_w_glu, s5_b_glu, lru_conv_w, lru_conv_b, lru_w_a, lru_b_a,
                lru_w_x, lru_b_x, lru_lam, mix_gain, w_out):
    z = h @ w_in
    o1 = D_POOL
    o2 = o1 + D_S5
    o3 = o2 + D_LRU
    y_a = pool_mixer(z[..., :o1], pool_w, pool_scale)
    y_b = s5_mixer(z[..., o1:o2], s5_lam_re, s5_lam_im, s5_log_step, s5_b_re, s5_b_im, s5_c_re, s5_c_im,
                   s5_d, s5_w_glu, s5_b_glu)
    y_c = rglru_mixer(z[..., o2:o3], z[..., o3:], lru_conv_w, lru_conv_b, lru_w_a, lru_b_a, lru_w_x, lru_b_x, lru_lam)
    o = jnp.concatenate([rmsnorm(y_a, mix_gain[:o1]),
                         rmsnorm(y_b, mix_gain[o1:o2]),
                         rmsnorm(y_c, mix_gain[o2:])], axis=-1)
    return o @ w_out


def moe_ffn(h, router_w, router_b, w_gate_up, b_gate_up, w_down, b_down):
    b, s, d = h.shape
    t = b * s
    xt = h.reshape(t, d)
    logits = (xt @ router_w + router_b).astype(jnp.float32)
    top_v, top_i = lax.top_k(logits, TOP_K)
    gates = jax.nn.softmax(top_v, axis=-1)
    n_assign = t * TOP_K
    flat_e = top_i.reshape(-1)
    order = jnp.argsort(flat_e)
    sorted_e = flat_e[order]
    tok = order // TOP_K
    gate_sorted = gates.reshape(-1)[order]
    counts = jnp.bincount(flat_e, length=N_EXPERTS)
    padded = ((counts + MOE_BLOCK - 1) // MOE_BLOCK) * MOE_BLOCK
    pad_end = jnp.cumsum(padded)
    pad_start = pad_end - padded
    start = jnp.cumsum(counts) - counts
    dest = pad_start[sorted_e] + (jnp.arange(n_assign) - start[sorted_e])
    n_blocks = -(-n_assign // MOE_BLOCK) + N_EXPERTS
    n_rows = n_blocks * MOE_BLOCK
    row_tok = jnp.zeros((n_rows,), jnp.int32).at[dest].set(tok.astype(jnp.int32))
    row_valid = jnp.zeros((n_rows,), jnp.bool_).at[dest].set(True)
    xs = jnp.where(row_valid[:, None], xt[row_tok], jnp.zeros((), xt.dtype)).reshape(n_blocks, MOE_BLOCK, d)
    blk_e = jnp.minimum(jnp.searchsorted(pad_end, jnp.arange(n_blocks) * MOE_BLOCK, side='right'), N_EXPERTS - 1)

    def expert_block(args):
        xb, e = args
        gu = xb @ w_gate_up[e] + b_gate_up[e]
        g = jnp.minimum(gu[:, 0::2], SWIGLU_LIMIT)
        up = jnp.clip(gu[:, 1::2], -SWIGLU_LIMIT, SWIGLU_LIMIT)
        glu = g * jax.nn.sigmoid(g * SWIGLU_ALPHA)
        return ((up + 1.0) * glu) @ w_down[e] + b_down[e]

    ys = lax.map(expert_block, (xs, blk_e)).reshape(n_rows, d)
    y_assign = ys[dest] * gate_sorted.astype(ys.dtype)[:, None]
    out = jnp.zeros((t, d), h.dtype).at[tok].add(y_assign.astype(h.dtype))
    return out.reshape(b, s, d)


def setup_inputs(seed: int = 0) -> dict:
    key = jax.random.key(seed)
    ks = iter(jax.random.split(key, 40))
    f32 = jnp.float32

    def nrm(shape, scale):
        return jax.random.normal(next(ks), shape, f32) * scale

    L = DEPTH
    x = nrm((BATCH, SEQ, D_MODEL), 1.0)
    norm1_g = 1.0 + nrm((L, D_MODEL), 0.02)
    w_in = nrm((L, D_MODEL, D_IN), D_MODEL ** -0.5)
    pool_w = nrm((L, len(POOL_WINDOWS), POOL_GROUP, POOL_GROUP), POOL_GROUP ** -0.5)
    pool_scale = 1.0 + nrm((L, D_POOL), 0.02)
    s5_lam_re = -0.5 + nrm((L, 2, S5_NGROUPS, S5_STATE), 0.01)
    s5_lam_im = math.pi * jnp.arange(S5_STATE, dtype=f32) + nrm((L, 2, S5_NGROUPS, S5_STATE), 0.01)
    s5_log_step = jax.random.uniform(next(ks), (L, 2, S5_NGROUPS), f32,
                                     minval=math.log(S5_DT_MIN), maxval=math.log(S5_DT_MAX))
    s5_b_re = nrm((L, 2, S5_NGROUPS, S5_STATE, S5_GROUP), (2.0 * S5_GROUP) ** -0.5)
    s5_b_im = nrm((L, 2, S5_NGROUPS, S5_STATE, S5_GROUP), (2.0 * S5_GROUP) ** -0.5)
    s5_c_re = nrm((L, 2, S5_NGROUPS, S5_GROUP, S5_STATE), (2.0 * S5_STATE) ** -0.5)
    s5_c_im = nrm((L, 2, S5_NGROUPS, S5_GROUP, S5_STATE), (2.0 * S5_STATE) ** -0.5)
    s5_d = nrm((L, D_S5), 1.0)
    s5_w_glu = nrm((L, D_S5, 2 * D_S5), D_S5 ** -0.5)
    s5_b_glu = nrm((L, 2 * D_S5), 0.01)
    lru_conv_w = nrm((L, CONV_WIDTH, D_LRU), CONV_WIDTH ** -0.5)
    lru_conv_b = nrm((L, D_LRU), 0.01)
    lru_w_a = nrm((L, 2, LRU_HEADS, LRU_HEAD_DIM, LRU_HEAD_DIM), LRU_HEAD_DIM ** -0.5)
    lru_b_a = nrm((L, 2, D_LRU), 0.01)
    lru_w_x = nrm((L, 2, LRU_HEADS, LRU_HEAD_DIM, LRU_HEAD_DIM), LRU_HEAD_DIM ** -0.5)
    lru_b_x = nrm((L, 2, D_LRU), 0.01)
    a0 = jax.random.uniform(next(ks), (L, 2, D_LRU), f32, minval=0.9, maxval=0.999)
    p = a0 ** (1.0 / RG_C)
    lru_lam = jnp.log(p) - jnp.log1p(-p)
    mix_gain = 1.0 + nrm((L, D_MIX), 0.02)
    w_out = nrm((L, D_MIX, D_MODEL), D_MIX ** -0.5)
    norm2_g = 1.0 + nrm((L, D_MODEL), 0.02)
    router_w = nrm((L, D_MODEL, N_EXPERTS), D_MODEL ** -0.5)
    router_b = nrm((L, N_EXPERTS), 0.01)
    w_gate_up = nrm((L, N_EXPERTS, D_MODEL, 2 * D_FF), D_MODEL ** -0.5)
    b_gate_up = nrm((L, N_EXPERTS, 2 * D_FF), 0.01)
    w_down = nrm((L, N_EXPERTS, D_FF, D_MODEL), D_FF ** -0.5)
    b_down = nrm((L, N_EXPERTS, D_MODEL), 0.01)
    final_g = 1.0 + nrm((D_MODEL,), 0.02)
    return {"x": x, "norm1_g": norm1_g, "w_in": w_in, "pool_w": pool_w, "pool_scale": pool_scale,
            "s5_lam_re": s5_lam_re, "s5_lam_im": s5_lam_im, "s5_log_step": s5_log_step,
            "s5_b_re": s5_b_re, "s5_b_im": s5_b_im, "s5_c_re": s5_c_re, "s5_c_im": s5_c_im,
            "s5_d": s5_d, "s5_w_glu": s5_w_glu, "s5_b_glu": s5_b_glu,
            "lru_conv_w": lru_conv_w, "lru_conv_b": lru_conv_b, "lru_w_a": lru_w_a, "lru_b_a": lru_b_a,
            "lru_w_x": lru_w_x, "lru_b_x": lru_b_x, "lru_lam": lru_lam,
            "mix_gain": mix_gain, "w_out": w_out, "norm2_g": norm2_g,
            "router_w": router_w, "router_b": router_b, "w_gate_up": w_gate_up, "b_gate_up": b_gate_up,
            "w_down": w_down, "b_down": b_down, "final_g": final_g}


def reference(x, norm1_g, w_in, pool_w, pool_scale, s5_lam_re, s5_lam_im, s5_log_step, s5_b_re, s5_b_im,
              s5_c_re, s5_c_im, s5_d, s5_w_glu, s5_b_glu, lru_conv_w, lru_conv_b, lru_w_a, lru_b_a,
              lru_w_x, lru_b_x, lru_lam, mix_gain, w_out, norm2_g, router_w, router_b, w_gate_up,
              b_gate_up, w_down, b_down, final_g):
    for l in range(DEPTH):
        h = rmsnorm(x, norm1_g[l])
        x = x + token_mixer(h, w_in[l], pool_w[l], pool_scale[l], s5_lam_re[l], s5_lam_im[l], s5_log_step[l],
                            s5_b_re[l], s5_b_im[l], s5_c_re[l], s5_c_im[l], s5_d[l], s5_w_glu[l], s5_b_glu[l],
                            lru_conv_w[l], lru_conv_b[l], lru_w_a[l], lru_b_a[l], lru_w_x[l], lru_b_x[l],
                            lru_lam[l], mix_gain[l], w_out[l])
        h = rmsnorm(x, norm2_g[l])
        x = x + moe_ffn(h, router_w[l], router_b[l], w_gate_up[l], b_gate_up[l], w_down[l], b_down[l])
    return rmsnorm(x, final_g)
```

```cpp
#ifndef HOST_TEST
#include <hip/hip_runtime.h>
#endif
#include <cstdio>
#include <cstdint>
#include <cstring>
#include <cmath>

#ifndef CFG_B
#define CFG_B 4
#endif
#ifndef CFG_S
#define CFG_S 8192
#endif
#ifndef MK_PER_PHASE
#define MK_PER_PHASE 0
#define GSEL 0x1Du
#endif

#ifdef HOST_TEST
#define HD inline
#define DEV inline
#else
#define HD __host__ __device__ __forceinline__
#define DEV __device__ __forceinline__
#endif

typedef unsigned short bf16_t;
constexpr int BATCH = CFG_B, SEQ = CFG_S, T = BATCH * SEQ, D = 1024, DEPTH = 2;
constexpr int D_POOL = 256, D_S5 = 384, D_LRU = 384, D_IN = 1408, D_INP = 1536;
constexpr int NE = 32, TOPK = 4;
constexpr int LC = 128, NT = SEQ / LC;
constexpr int NROWS = T * TOPK + NE * 256;
constexpr int NMB_MAX = NROWS / 256;
constexpr float EPS = 1e-5f;
static_assert(SEQ % LC == 0 && T % 256 == 0, "shape");

constexpr size_t AL(size_t x) { return (x + 255) & ~size_t(255); }
constexpr size_t WS_CTL = 0, CTL_BYTES = 1u << 20;
constexpr size_t WS_WIN = WS_CTL + CTL_BYTES;
constexpr size_t WS_WGLU = WS_WIN + (size_t)2 * D_INP * D * 2;
constexpr size_t WS_WOUT = AL(WS_WGLU + (size_t)2 * 768 * 384 * 2);
constexpr size_t WS_WGU = WS_WOUT + (size_t)2 * D * D * 2;
constexpr size_t WS_WDN = WS_WGU + (size_t)2 * NE * 2048 * 1024 * 2;
constexpr size_t WS_RWT = WS_WDN + (size_t)2 * NE * 1024 * 1024 * 2;
constexpr size_t WS_S5A = WS_RWT + (size_t)2 * NE * 1024 * 4;
constexpr size_t WS_S5A128 = WS_S5A + 6144 * 8;
constexpr size_t WS_S5BB = WS_S5A128 + 6144 * 8;
constexpr size_t WS_S5POW = WS_S5BB + (size_t)6144 * 16 * 8;
constexpr size_t WS_W4T = AL(WS_S5POW + (size_t)6144 * 8 * 4);
constexpr size_t WS_YMAT = WS_W4T + (size_t)2 * 24 * 2 * 128 * 64 * 2;
constexpr size_t WS_LRUWT = AL(WS_YMAT + (size_t)2 * 24 * 64 * 320 * 2);
constexpr size_t WS_POOLWT = WS_LRUWT + (size_t)2 * 2 * 6 * 2 * 4096 * 2;
constexpr size_t WS_HB = AL(WS_POOLWT + (size_t)2 * 4 * 4096 * 2);
constexpr size_t WS_Z = WS_HB + (size_t)T * D * 2;
constexpr size_t WS_X = WS_Z + (size_t)T * D_INP * 2;
constexpr size_t WS_O = WS_X + (size_t)T * D * 4;
constexpr size_t WS_V = WS_O + (size_t)T * D * 2;
constexpr size_t WS_YB = WS_V + (size_t)T * 384 * 2;
constexpr size_t WS_PD = WS_YB + (size_t)T * 384 * 2;
constexpr size_t WS_YA = WS_PD + (size_t)T * 256 * 4;
constexpr size_t WS_XC = WS_YA + (size_t)T * 256 * 4;
constexpr size_t WS_HDIR = WS_XC + (size_t)T * 384 * 4;
constexpr size_t WS_S5E = WS_HDIR + (size_t)T * 768 * 4;
constexpr size_t WS_S5IN = WS_S5E + (size_t)BATCH * NT * 3072 * 8;
constexpr size_t WS_LRUPE = WS_S5IN + (size_t)BATCH * NT * 3072 * 8;
constexpr size_t WS_LRUIN = WS_LRUPE + (size_t)BATCH * NT * 768 * 8;
constexpr size_t WS_TKE = AL(WS_LRUIN + (size_t)BATCH * NT * 768 * 4);
constexpr size_t WS_TKG = WS_TKE + (size_t)T * 16;
constexpr size_t WS_TKP = WS_TKG + (size_t)T * 16;
constexpr size_t WS_TKD = WS_TKP + (size_t)T * 16;
constexpr size_t WS_ROWTOK = WS_TKD + (size_t)T * 16;
constexpr size_t WS_ROWGATE = AL(WS_ROWTOK + (size_t)NROWS * 4);
constexpr size_t WS_BLKE = AL(WS_ROWGATE + (size_t)NROWS * 4);
constexpr size_t WS_SCR = AL(WS_BLKE + (size_t)NMB_MAX * 4);
constexpr size_t WS_XBUF = WS_SCR;
constexpr size_t WS_LRUAB = WS_XBUF + (size_t)T * 3072 * 4;
constexpr size_t WS_ACT = WS_SCR;
constexpr size_t WS_YEXP = WS_ACT + (size_t)NROWS * 1024 * 2;
constexpr size_t SCR_A = (size_t)T * 3072 * 4 + (size_t)T * 768 * 8, SCR_B = (size_t)NROWS * 1024 * 2 * 2;
constexpr size_t WS_END = WS_SCR + (SCR_A > SCR_B ? SCR_A : SCR_B);
constexpr int CW_CNT = 8192, CNT_STRIDE = 64;
constexpr int CW_NMB = 192;
constexpr int CW_BAR = 4096;
constexpr size_t SP8_OFF = 524288;

#if defined(__HIP_DEVICE_COMPILE__) && !defined(HOST_TEST)
typedef __bf16 bf16v2_ __attribute__((ext_vector_type(2))); typedef float f32v2_ __attribute__((ext_vector_type(2)));
HD unsigned pk2(float lo, float hi) { const f32v2_ v = {lo, hi}; return __builtin_bit_cast(unsigned, __builtin_convertvector(v, bf16v2_)); }
HD unsigned f2bf(float f) { return (unsigned)__builtin_bit_cast(unsigned short, (__bf16)f); }
#else
HD unsigned f2bf(float f) { unsigned u; memcpy(&u, &f, 4); return (u + 0x7fffu + ((u >> 16) & 1u)) >> 16; }
HD unsigned pk2(float lo, float hi) { return f2bf(lo) | (f2bf(hi) << 16); }
#endif
HD float bf2f(unsigned b) { unsigned u = (b & 0xffffu) << 16; float f; memcpy(&f, &u, 4); return f; }
HD float sigmoidf_(float x) { return 1.f / (1.f + expf(-x)); }
#ifdef HOST_TEST
HD float sigmoid_fast(float x) { return 1.f / (1.f + expf(-x)); }
#else
__device__ __forceinline__ float sigmoid_fast(float x) { return __builtin_amdgcn_rcpf(1.f + __builtin_amdgcn_exp2f(-1.4426950408889634f * x)); }
__device__ __forceinline__ float expm1_dev(float x, float ex) { const float s = x * (1.f + x * (0.5f + x * (0.16666667f + x * (0.041666668f + x * 0.0083333338f)))); const float e = ex * ex - 1.f; return x > -0.3f ? s : e; }
#endif
#if defined(__HIP_DEVICE_COMPILE__) && !defined(HOST_TEST)
HD float gelu_tanh(float x) { return x * sigmoid_fast(1.5957691216057308f * (x + 0.044715f * x * x * x)); }
#else
HD float gelu_tanh(float x) { return 0.5f * x * (1.f + tanhf(0.7978845608028654f * (x + 0.044715f * x * x * x))); }
#endif

#ifdef HOST_TEST
struct f32x4 { float v[4]; float& operator[](int i) { return v[i]; } const float& operator[](int i) const { return v[i]; } };
#else
typedef float f32x4 __attribute__((ext_vector_type(4)));
#endif

struct Unit { int pm, pn, e; };

struct Ctx {
    const float* const* in;
    float* out;
    unsigned char* ws;
#define WSP(T_, name, off) HD T_* name() const { return (T_*)(ws + (off)); }
    WSP(unsigned, ctl, WS_CTL) WSP(bf16_t, win_t, WS_WIN) WSP(bf16_t, wglu_t, WS_WGLU) WSP(bf16_t, wout_t, WS_WOUT) WSP(bf16_t, wgu_t, WS_WGU) WSP(bf16_t, wdn_t, WS_WDN)
    WSP(unsigned char, hq, WS_O) WSP(unsigned char, act8, WS_ACT) WSP(unsigned char, wgu8, WS_WGU) WSP(unsigned char, wdn8, WS_WDN)
    WSP(bf16_t, lruw_t, WS_LRUWT) WSP(bf16_t, poolw_t, WS_POOLWT) WSP(bf16_t, hl, WS_HDIR) WSP(bf16_t, cp, WS_HDIR + (size_t)T * 768 * 2)
    WSP(float, rwt, WS_RWT) WSP(float, s5a, WS_S5A) WSP(float, s5a128, WS_S5A128) WSP(float, s5bb, WS_S5BB) WSP(float, s5pow, WS_S5POW) WSP(bf16_t, w4t, WS_W4T) WSP(bf16_t, ymat, WS_YMAT)
    WSP(bf16_t, hb, WS_HB) WSP(bf16_t, z, WS_Z) WSP(bf16_t, o, WS_O) WSP(bf16_t, v, WS_V) WSP(bf16_t, yb, WS_YB) WSP(bf16_t, act, WS_ACT) WSP(bf16_t, yexp, WS_YEXP)
    WSP(float, X, WS_X) WSP(float, pd, WS_PD) WSP(float, ya, WS_YA) WSP(float, xc, WS_XC) WSP(float, hdir, WS_HDIR) WSP(float, s5e, WS_S5E) WSP(float, s5in, WS_S5IN)
    WSP(float, lrupe, WS_LRUPE) WSP(float, lruin, WS_LRUIN) WSP(float, tkg, WS_TKG) WSP(float, rowgate, WS_ROWGATE) WSP(float, lruab, WS_LRUAB)
    WSP(int, tke, WS_TKE) WSP(int, tkp, WS_TKP) WSP(int, tkd, WS_TKD) WSP(int, rowtok, WS_ROWTOK) WSP(int, blke, WS_BLKE) WSP(unsigned, xbuf, WS_XBUF)
#undef WSP
};
#ifndef HOST_TEST
struct CtxG {
    const __attribute__((address_space(3))) unsigned long long* tab; __attribute__((address_space(1))) float* outg; __attribute__((address_space(1))) unsigned char* wsg;
    struct InProxy { const __attribute__((address_space(3))) unsigned long long* tab; __device__ __forceinline__ const float* operator[](int i) const { return (const float*)(__attribute__((address_space(1))) const float*)tab[i]; } } in;
    float* out;
    __device__ __forceinline__ explicit CtxG(const Ctx& c) { tab = (const __attribute__((address_space(3))) unsigned long long*)(const unsigned long long*)(const void*)c.in; in.tab = tab; outg = (__attribute__((address_space(1))) float*)(unsigned long long)c.out; wsg = (__attribute__((address_space(1))) unsigned char*)(unsigned long long)c.ws; out = (float*)outg; }
#define WSPG(T_, name, off) __device__ __forceinline__ T_* name() const { return (T_*)(__attribute__((address_space(1))) T_*)(wsg + (off)); }
    WSPG(unsigned, ctl, WS_CTL) WSPG(bf16_t, win_t, WS_WIN) WSPG(bf16_t, wglu_t, WS_WGLU) WSPG(bf16_t, wout_t, WS_WOUT) WSPG(bf16_t, wgu_t, WS_WGU) WSPG(bf16_t, wdn_t, WS_WDN)
    WSPG(unsigned char, hq, WS_O) WSPG(unsigned char, act8, WS_ACT) WSPG(unsigned char, wgu8, WS_WGU) WSPG(unsigned char, wdn8, WS_WDN)
    WSPG(bf16_t, lruw_t, WS_LRUWT) WSPG(bf16_t, poolw_t, WS_POOLWT) WSPG(bf16_t, hl, WS_HDIR) WSPG(bf16_t, cp, WS_HDIR + (size_t)T * 768 * 2)
    WSPG(float, rwt, WS_RWT) WSPG(float, s5a, WS_S5A) WSPG(float, s5a128, WS_S5A128) WSPG(float, s5bb, WS_S5BB) WSPG(float, s5pow, WS_S5POW) WSPG(bf16_t, w4t, WS_W4T) WSPG(bf16_t, ymat, WS_YMAT)
    WSPG(bf16_t, hb, WS_HB) WSPG(bf16_t, z, WS_Z) WSPG(bf16_t, o, WS_O) WSPG(bf16_t, v, WS_V) WSPG(bf16_t, yb, WS_YB) WSPG(bf16_t, act, WS_ACT) WSPG(bf16_t, yexp, WS_YEXP)
    WSPG(float, X, WS_X) WSPG(float, pd, WS_PD) WSPG(float, ya, WS_YA) WSPG(float, xc, WS_XC) WSPG(float, hdir, WS_HDIR) WSPG(float, s5e, WS_S5E) WSPG(float, s5in, WS_S5IN)
    WSPG(float, lrupe, WS_LRUPE) WSPG(float, lruin, WS_LRUIN) WSPG(float, tkg, WS_TKG) WSPG(float, rowgate, WS_ROWGATE) WSPG(float, lruab, WS_LRUAB)
    WSPG(int, tke, WS_TKE) WSPG(int, tkp, WS_TKP) WSPG(int, tkd, WS_TKD) WSPG(int, rowtok, WS_ROWTOK) WSPG(int, blke, WS_BLKE) WSPG(unsigned, xbuf, WS_XBUF)
#undef WSPG
};
#endif
enum { I_X = 0, I_N1G, I_WIN, I_POOLW, I_POOLS, I_LAMRE, I_LAMIM, I_LOGSTEP, I_BRE, I_BIM, I_CRE, I_CIM, I_S5D, I_WGLU, I_BGLU, I_CONVW, I_CONVB, I_WA, I_BA, I_WX, I_BX, I_LAM,
       I_MIXG, I_WOUT, I_N2G, I_RW, I_RB, I_WGU, I_BGU, I_WDN, I_BDN, I_FING };

HD void st_prep_small(long gtid, long gs, const Ctx& c) {
    for (long i = gtid; i < 6144; i += gs) {
        const float lr = c.in[I_LAMRE][i], li = c.in[I_LAMIM][i], dt = expf(c.in[I_LOGSTEP][i / 64]);
        const float mag = expf(lr * dt), ar = mag * cosf(li * dt), ai = mag * sinf(li * dt);
        const float den = lr * lr + li * li, nr = ar - 1.f, ni = ai, qr = (nr * lr + ni * li) / den, qi = (ni * lr - nr * li) / den;
        c.s5a()[2 * i] = ar; c.s5a()[2 * i + 1] = ai;
        float pr = ar, pi = ai;
        for (int k = 0; k < 7; ++k) { const float t = pr * pr - pi * pi; pi = 2.f * pr * pi; pr = t; }
        c.s5a128()[2 * i] = pr; c.s5a128()[2 * i + 1] = pi;
        for (int cc = 0; cc < 16; ++cc) { const float br = c.in[I_BRE][i * 16 + cc], bi = c.in[I_BIM][i * 16 + cc];
            c.s5bb()[(i * 16 + cc) * 2] = qr * br - qi * bi; c.s5bb()[(i * 16 + cc) * 2 + 1] = qr * bi + qi * br; }
    }
    for (long i = gtid; i < 2 * NE * 1024; i += gs) { const int l = (int)(i / (NE * 1024)), e = (int)(i / 1024) % NE, k = (int)(i % 1024);
        const float f_ = c.in[I_N2G][l * 1024 + k] * c.in[I_RW][((size_t)l * 1024 + k) * NE + e];
#ifdef HOST_TEST
        c.rwt()[i] = f_; }
#else
        { bf16_t* rh = (bf16_t*)c.rwt(); const unsigned hi_ = f2bf(f_); const float lo_ = f_ - bf2f(hi_);
          rh[((size_t)(l * 2) * NE + e) * 1024 + k] = (bf16_t)hi_; rh[((size_t)(l * 2 + 1) * NE + e) * 1024 + k] = (bf16_t)f2bf(lo_); } }
#endif
    for (long i = gtid; i < (long)2 * 128 * 1024; i += gs) { const int l = (int)(i / (128 * 1024)); const long r = i % (128 * 1024);
        c.win_t()[(size_t)l * D_INP * D + (size_t)D_IN * D + r] = 0; }
}
HD void cpowi(float ar, float ai, int e, float& pr, float& pi) { pr = 1.f; pi = 0.f; for (int k = 0; k < e; ++k) { const float t = pr * ar - pi * ai; pi = pr * ai + pi * ar; pr = t; } }
HD void st_prep_s5mat(long gtid, long gs, const Ctx& c) {
    const float* cre_ = c.in[I_CRE]; const float* cim_ = c.in[I_CIM]; const float* s5d_ = c.in[I_S5D];
    for (long i = gtid; i < 6144; i += gs) { const float ar = c.s5a()[2 * i], ai = c.s5a()[2 * i + 1]; float pr, pi;
        cpowi(ar, ai, 4, pr, pi); c.s5pow()[i * 8 + 0] = pr; c.s5pow()[i * 8 + 1] = pi;
        cpowi(ar, ai, 16, pr, pi); c.s5pow()[i * 8 + 2] = pr; c.s5pow()[i * 8 + 3] = pi;
        cpowi(ar, ai, 32, pr, pi); c.s5pow()[i * 8 + 4] = pr; c.s5pow()[i * 8 + 5] = pi;
        cpowi(ar, ai, 64, pr, pi); c.s5pow()[i * 8 + 6] = pr; c.s5pow()[i * 8 + 7] = pi; }
    for (long i = gtid; i < (long)2 * 24 * 2 * 128 * 64; i += gs) { const int k = (int)(i % 64), pp = (int)(i / 64) % 128, dir = (int)(i / 8192) % 2, g = (int)(i / 16384) % 24, l = (int)(i / 16384 / 24);
        const int p = pp & 63, j = k >> 4, cc = k & 15, ci = ((l * 2 + dir) * 24 + g) * 64 + p; float pr, pi; cpowi(c.s5a()[2 * ci], c.s5a()[2 * ci + 1], dir ? j : 3 - j, pr, pi);
        const float br = c.s5bb()[(ci * 16 + cc) * 2], bi = c.s5bb()[(ci * 16 + cc) * 2 + 1];
        c.w4t()[i] = (bf16_t)f2bf(pp < 64 ? pr * br - pi * bi : pr * bi + pi * br); }
    for (long i = gtid; i < (long)2 * 24 * 64 * 256; i += gs) { const int k = (int)(i % 256), row = (int)(i / 256) % 64, g = (int)(i / 16384) % 24, l = (int)(i / 16384 / 24); const int j = row >> 4, cc = row & 15;
        const int dir = k >> 7, kk = k & 127, nt = kk < 64 ? 0 : 4, p = kk & 63, ci = ((l * 2 + dir) * 24 + g) * 64 + p; float pr, pi; cpowi(c.s5a()[2 * ci], c.s5a()[2 * ci + 1], dir ? 4 - j : j + 1, pr, pi);
        const size_t co = ((size_t)((l * 2 + dir) * 24 + g) * 16 + cc) * 64 + p; const float cr = cre_[co], cim = cim_[co];
        const float val = nt < 4 ? cr * pr - cim * pi : -(cr * pi + cim * pr);
        c.ymat()[((size_t)(l * 24 + g) * 64 + row) * 320 + k] = (bf16_t)f2bf(val); }
    for (long i = gtid; i < (long)2 * 24 * 7 * 256; i += gs) { const int c2 = (int)(i % 16), cc = (int)(i / 16) % 16, dd = (int)(i / 256) % 7, g = (int)(i / 1792) % 24, l = (int)(i / 1792 / 24); const int d = dd - 3;
        float val = (d == 0 && c2 == cc) ? s5d_[l * 384 + g * 16 + cc] : 0.f;
        for (int dir = 0; dir < 2; ++dir) { if (dir == 0 ? d < 0 : d > 0) continue; const int e = d < 0 ? -d : d;
            for (int p = 0; p < 64; ++p) { const int ci = ((l * 2 + dir) * 24 + g) * 64 + p; float pr, pi; cpowi(c.s5a()[2 * ci], c.s5a()[2 * ci + 1], e, pr, pi);
                const size_t co = ((size_t)((l * 2 + dir) * 24 + g) * 16 + cc) * 64 + p; const float cr = cre_[co], cim = cim_[co]; const float xr = cr * pr - cim * pi, xi = cr * pi + cim * pr;
                val += xr * c.s5bb()[(ci * 16 + c2) * 2] - xi * c.s5bb()[(ci * 16 + c2) * 2 + 1]; } }
        const bf16_t vb = (bf16_t)f2bf(val);
        for (int j = 0; j < 4; ++j) { const int ii = j - d; if (ii < 0 || ii > 3) continue; c.ymat()[((size_t)(l * 24 + g) * 64 + j * 16 + cc) * 320 + 256 + ii * 16 + c2] = vb; } }
}
HD void s5_tile_ref(const Ctx& c, int l, int tile, int g, bool final_pass) {
    const int b = tile / NT, ct = tile % NT, t0 = b * SEQ + ct * LC;
    float U[32][64];
    for (int n = 0; n < 32; ++n) for (int k = 0; k < 64; ++k) U[n][k] = bf2f(c.z()[(size_t)(t0 + 4 * n + (k >> 4)) * D_INP + 256 + 16 * g + (k & 15)]);
    float S[2][33][128];
    for (int dir = 0; dir < 2; ++dir) {
        const bf16_t* w = c.w4t() + (size_t)((l * 24 + g) * 2 + dir) * 128 * 64;
        for (int p = 0; p < 64; ++p) { const int ci = ((l * 2 + dir) * 24 + g) * 64 + p; const float a4r = c.s5pow()[ci * 8], a4i = c.s5pow()[ci * 8 + 1];
            float sr = 0.f, si = 0.f; const size_t io = ((size_t)(b * NT + ct) * 3072 + dir * 1536 + g * 64 + p) * 2;
            if (final_pass) { sr = c.s5in()[io]; si = c.s5in()[io + 1]; }
            if (dir == 0) { S[0][0][p] = sr; S[0][0][64 + p] = si; } else { S[1][32][p] = sr; S[1][32][64 + p] = si; }
            for (int q = 0; q < 32; ++q) { const int n = dir == 0 ? q : 31 - q; float gr = 0.f, gi = 0.f;
                for (int k = 0; k < 64; ++k) { gr += U[n][k] * bf2f(w[p * 64 + k]); gi += U[n][k] * bf2f(w[(64 + p) * 64 + k]); }
                const float nr = a4r * sr - a4i * si + gr, ni = a4r * si + a4i * sr + gi; sr = nr; si = ni;
                const int row = dir == 0 ? n + 1 : n; S[dir][row][p] = sr; S[dir][row][64 + p] = si; }
            if (!final_pass) { c.s5e()[io] = sr; c.s5e()[io + 1] = si; } } }
    if (!final_pass) return;
    const bf16_t* ym = c.ymat() + (size_t)(l * 24 + g) * 64 * 320;
    for (int n = 0; n < 32; ++n) for (int row = 0; row < 64; ++row) { float y = 0.f;
        for (int k = 0; k < 256; ++k) { const int dir = k >> 7, pp = k & 127; const float s = dir == 0 ? S[0][n][pp] : S[1][n + 1][pp];
            y += bf2f(ym[row * 320 + k]) * bf2f(f2bf(s)); }
        for (int k = 0; k < 64; ++k) y += bf2f(ym[row * 320 + 256 + k]) * U[n][k];
        c.v()[(size_t)(t0 + 4 * n + (row >> 4)) * 384 + 16 * g + (row & 15)] = (bf16_t)f2bf(gelu_tanh(y)); }
}
HD void st_mix1(long gtid, long gs, const Ctx& c, int l) {
    for (long i = gtid; i < (long)T * 256; i += gs) { const int t = (int)(i / 256), ch = (int)(i % 256), g = ch / 64, half = 1 << g, s = t % SEQ, b0 = t - s;
        const int lo = s - half < 0 ? 0 : s - half, hi = s + half > SEQ ? SEQ : s + half; float sum = 0.f;
        for (int q = lo; q < hi; ++q) sum += bf2f(c.z()[(size_t)(b0 + q) * D_INP + ch]);
        c.pd()[i] = sum / (float)(hi - lo) - bf2f(c.z()[(size_t)t * D_INP + ch]); }
    const float* cw = c.in[I_CONVW] + l * 4 * 384; const float* cb = c.in[I_CONVB] + l * 384;
    for (long i = gtid; i < (long)T * 384; i += gs) { const int t = (int)(i / 384), ch = (int)(i % 384), s = t % SEQ; float a = cb[ch];
        for (int j = 0; j < 4; ++j) { const int q = s - 1 + j; if (q >= 0 && q < SEQ) a += cw[j * 384 + ch] * bf2f(c.z()[(size_t)(t - 1 + j) * D_INP + 640 + ch]); }
        c.xc()[i] = a; }
}
HD void st_s5_scan(long gtid, long gs, const Ctx& c, int l, bool final_pass) {
    for (long i = gtid; i < (long)BATCH * NT * 3072; i += gs) {
        const int p = (int)(i % 64), g = (int)(i / 64) % 24, dir = (int)(i / 1536) % 2, ct = (int)(i / 3072) % NT, b = (int)(i / 3072 / NT);
        const int ci = ((l * 2 + dir) * 24 + g) * 64 + p;
        const float ar = c.s5a()[2 * ci], ai = c.s5a()[2 * ci + 1];
        float bbr[16], bbi[16];
        for (int cc = 0; cc < 16; ++cc) { bbr[cc] = c.s5bb()[(ci * 16 + cc) * 2]; bbi[cc] = c.s5bb()[(ci * 16 + cc) * 2 + 1]; }
        float xr = 0.f, xi = 0.f;
        if (final_pass) { xr = c.s5in()[2 * i]; xi = c.s5in()[2 * i + 1]; }
        for (int q = 0; q < LC; ++q) { const int tt = b * SEQ + ct * LC + (dir == 0 ? q : LC - 1 - q);
            const bf16_t* u = c.z() + (size_t)tt * D_INP + 256 + 16 * g; float bur = 0.f, bui = 0.f;
            for (int cc = 0; cc < 16; ++cc) { const float uv = bf2f(u[cc]); bur += bbr[cc] * uv; bui += bbi[cc] * uv; }
            const float nr = ar * xr - ai * xi + bur, ni = ar * xi + ai * xr + bui; xr = nr; xi = ni;
            if (final_pass) c.xbuf()[((size_t)tt * 2 + dir) * 1536 + g * 64 + p] = pk2(xr, xi); }
        if (!final_pass) { c.s5e()[2 * i] = xr; c.s5e()[2 * i + 1] = xi; }
    }
}
HD void st_mix2(long gtid, long gs, const Ctx& c, int l) {
    const float* pw = c.in[I_POOLW] + l * 4 * 64 * 64; const float* ps = c.in[I_POOLS] + l * 256;
    for (long i = gtid; i < (long)T * 256; i += gs) { const int t = (int)(i / 256), ch = (int)(i % 256), g = ch / 64, dd = ch % 64; float a = 0.f;
        for (int k = 0; k < 64; ++k) a += c.pd()[(size_t)t * 256 + g * 64 + k] * pw[(g * 64 + k) * 64 + dd];
        c.ya()[i] = a * ps[ch]; }
    for (long i = gtid; i < (long)T * 768; i += gs) { const int t = (int)(i / 768), dir = (int)(i / 384) % 2, ch = (int)(i % 384), h = ch / 64, j = ch % 64;
        const float* wa = c.in[I_WA] + (((size_t)(l * 2 + dir) * 6 + h) * 64) * 64; const float* wx = c.in[I_WX] + (((size_t)(l * 2 + dir) * 6 + h) * 64) * 64;
        float ra = c.in[I_BA][(l * 2 + dir) * 384 + ch], rx = c.in[I_BX][(l * 2 + dir) * 384 + ch];
        const float* xr = c.xc() + (size_t)t * 384 + h * 64;
        for (int k = 0; k < 64; ++k) { const float xv = xr[k]; ra += xv * wa[k * 64 + j]; rx += xv * wx[k * 64 + j]; }
        const float r = sigmoidf_(ra), ig = sigmoidf_(rx), sp = log1pf(expf(-c.in[I_LAM][(l * 2 + dir) * 384 + ch]));
        const float la = -8.f * r * sp, a = expf(la), bt = sqrtf(-expm1f(2.f * la)) * (ig * c.xc()[(size_t)t * 384 + ch]);
        c.lruab()[2 * i] = a; c.lruab()[2 * i + 1] = bt; }
    for (long i = gtid; i < (long)BATCH * 3072; i += gs) { const int r = (int)(i % 3072), b = (int)(i / 3072), dir = r / 1536; const int ci = l * 3072 + r;
        const float ar = c.s5a128()[2 * ci], ai = c.s5a128()[2 * ci + 1]; float sr = 0.f, si = 0.f;
        for (int q = 0; q < NT; ++q) { const int ct = dir == 0 ? q : NT - 1 - q; const size_t o = ((size_t)(b * NT + ct) * 3072 + r) * 2;
            c.s5in()[o] = sr; c.s5in()[o + 1] = si; const float er = c.s5e()[o], ei = c.s5e()[o + 1];
            const float nr = ar * sr - ai * si + er, ni = ar * si + ai * sr + ei; sr = nr; si = ni; } }
}
HD void st_lru_scan(long gtid, long gs, const Ctx& c, bool final_pass) {
    for (long i = gtid; i < (long)BATCH * NT * 768; i += gs) { const int r = (int)(i % 768), dir = r / 384, ch = r % 384, ct = (int)(i / 768) % NT, b = (int)(i / 768 / NT);
        float h = final_pass ? c.lruin()[i] : 0.f, P = 1.f;
        for (int q = 0; q < LC; ++q) { const int tt = b * SEQ + ct * LC + (dir == 0 ? q : LC - 1 - q); const size_t o = ((size_t)tt * 768 + r) * 2;
            const float a = c.lruab()[o], bt = c.lruab()[o + 1]; h = a * h + bt; P *= a;
            if (final_pass) c.hdir()[(size_t)tt * 768 + dir * 384 + ch] = h; }
        if (!final_pass) { c.lrupe()[2 * i] = P; c.lrupe()[2 * i + 1] = h; } }
}
HD void st_mix4(long gtid, long gs, const Ctx& c, int l, bool s5_naive) {
    for (long i = gtid; i < (long)BATCH * 768; i += gs) { const int r = (int)(i % 768), b = (int)(i / 768), dir = r / 384; float h = 0.f;
        for (int q = 0; q < NT; ++q) { const int ct = dir == 0 ? q : NT - 1 - q; const size_t o = (size_t)(b * NT + ct) * 768 + r;
            c.lruin()[o] = h; h = c.lrupe()[2 * o] * h + c.lrupe()[2 * o + 1]; } }
    if (s5_naive) for (long i = gtid; i < (long)T * 384; i += gs) { const int t = (int)(i / 384), ch = (int)(i % 384), g = ch / 16, cc = ch % 16;
        float y = c.in[I_S5D][l * 384 + ch] * bf2f(c.z()[(size_t)t * D_INP + 256 + ch]);
        for (int dir = 0; dir < 2; ++dir) { const float* cr = c.in[I_CRE] + ((size_t)((l * 2 + dir) * 24 + g) * 16 + cc) * 64; const float* cim = c.in[I_CIM] + ((size_t)((l * 2 + dir) * 24 + g) * 16 + cc) * 64;
            const unsigned* xb = c.xbuf() + ((size_t)t * 2 + dir) * 1536 + g * 64;
            for (int p = 0; p < 64; ++p) { const unsigned w = xb[p]; y += cr[p] * bf2f(w & 0xffffu) - cim[p] * bf2f(w >> 16); } }
        c.v()[i] = (bf16_t)f2bf(gelu_tanh(y)); }
}
HD float expm1_small(float x) { return x > -0.3f ? x * (1.f + x * (0.5f + x * (0.16666667f + x * (0.041666668f + x * 0.0083333338f)))) : expf(x) - 1.f; }
HD void st_prep_mixw(long gtid, long gs, const Ctx& c) {
    for (long i = gtid; i < (long)2 * 2 * 6 * 2 * 4096; i += gs) { const int ii = (int)(i % 64), j = (int)(i / 64) % 64, which = (int)(i / 4096) % 2; const long ldh = i / 8192;
        const float* w = (which ? c.in[I_WX] : c.in[I_WA]) + ldh * 4096; c.lruw_t()[i] = (bf16_t)f2bf(w[ii * 64 + j]); }
    for (long i = gtid; i < (long)2 * 4 * 4096; i += gs) { const int cc = (int)(i % 64), dd = (int)(i / 64) % 64; const long lg = i / 4096; c.poolw_t()[i] = (bf16_t)f2bf(c.in[I_POOLW][lg * 4096 + cc * 64 + dd]); }
    for (long i = gtid; i < (long)2 * 2 * 384; i += gs) ((float*)c.ctl() + SP8_OFF / 4)[i] = -8.f * log1pf(expf(-c.in[I_LAM][i]));
}
HD void mixer_tile_ref(const Ctx& c, int l, int tile) {
    const int b = tile / NT, ct = tile % NT, s0 = ct * LC, t0 = b * SEQ + s0;
    for (int t = 0; t < LC; ++t) { float ya[256]; float ss = 0.f;
        for (int ch = 0; ch < 256; ++ch) ya[ch] = 0.f;
        for (int g = 0; g < 4; ++g) { const int half = 1 << g, s = s0 + t, lo = s - half < 0 ? 0 : s - half, hi = s + half > SEQ ? SEQ : s + half; float d[64];
            for (int cc = 0; cc < 64; ++cc) { float sum = 0.f; for (int q = lo; q < hi; ++q) sum += bf2f(c.z()[(size_t)(b * SEQ + q) * D_INP + g * 64 + cc]);
                d[cc] = bf2f(f2bf(sum / (float)(hi - lo) - bf2f(c.z()[(size_t)(t0 + t) * D_INP + g * 64 + cc]))); }
            for (int dd = 0; dd < 64; ++dd) { float a = 0.f; for (int cc = 0; cc < 64; ++cc) a += d[cc] * bf2f(c.poolw_t()[((size_t)(l * 4 + g) * 64 + dd) * 64 + cc]);
                ya[g * 64 + dd] = a * c.in[I_POOLS][l * 256 + g * 64 + dd]; } }
        for (int ch = 0; ch < 256; ++ch) ss += ya[ch] * ya[ch];
        const float rstd = 1.f / sqrtf(ss * (1.f / 256) + EPS);
        for (int ch = 0; ch < 256; ++ch) c.o()[(size_t)(t0 + t) * D + ch] = (bf16_t)f2bf(ya[ch] * rstd); }
    for (int h = 0; h < 6; ++h) {
        float xc[LC][64];
        for (int t = 0; t < LC; ++t) for (int cc = 0; cc < 64; ++cc) { const int ch = h * 64 + cc; float a = c.in[I_CONVB][l * 384 + ch];
            for (int j = 0; j < 4; ++j) { const int q = s0 + t - 1 + j; if (q >= 0 && q < SEQ) a += c.in[I_CONVW][(l * 4 + j) * 384 + ch] * bf2f(c.z()[(size_t)(b * SEQ + q) * D_INP + 640 + ch]); }
            xc[t][cc] = bf2f(f2bf(a)); }
        for (int dir = 0; dir < 2; ++dir) for (int cc = 0; cc < 64; ++cc) { const int ch = h * 64 + cc, pi = (l * 2 + dir) * 384 + ch;
            const bf16_t* wa = c.lruw_t() + ((size_t)(((l * 2 + dir) * 6 + h) * 2 + 0) * 64 + cc) * 64; const bf16_t* wx = wa + 4096;
            const float sp = log1pf(expf(-c.in[I_LAM][pi])); float hh = 0.f, P = 1.f;
            for (int q = 0; q < LC; ++q) { const int t = dir == 0 ? q : LC - 1 - q; float ra = c.in[I_BA][pi], rx = c.in[I_BX][pi];
                for (int k = 0; k < 64; ++k) { ra += xc[t][k] * bf2f(wa[k]); rx += xc[t][k] * bf2f(wx[k]); }
                const float r = sigmoidf_(ra), ig = sigmoidf_(rx), la = -8.f * r * sp, a = expf(la), bt = sqrtf(-expm1_small(2.f * la)) * (ig * xc[t][cc]);
                hh = a * hh + bf2f(f2bf(bt)); P *= a;
                c.hl()[((size_t)(t0 + t) * 2 + dir) * 384 + ch] = (bf16_t)f2bf(hh); c.cp()[((size_t)(t0 + t) * 2 + dir) * 384 + ch] = (bf16_t)f2bf(P); }
            const size_t o = ((size_t)(b * NT + ct) * 768 + dir * 384 + ch) * 2; c.lrupe()[o] = P; c.lrupe()[o + 1] = hh; } }
}
HD void st_carries(long gtid, long gs, const Ctx& c, int l) {
    for (long i = gtid; i < (long)BATCH * 3072; i += gs) { const int r = (int)(i % 3072), b = (int)(i / 3072), dir = r / 1536; const int ci = l * 3072 + r;
        const float ar = c.s5a128()[2 * ci], ai = c.s5a128()[2 * ci + 1]; float sr = 0.f, si = 0.f;
        for (int q = 0; q < NT; ++q) { const int ct = dir == 0 ? q : NT - 1 - q; const size_t o = ((size_t)(b * NT + ct) * 3072 + r) * 2;
            c.s5in()[o] = sr; c.s5in()[o + 1] = si; const float er = c.s5e()[o], ei = c.s5e()[o + 1];
            const float nr = ar * sr - ai * si + er, ni = ar * si + ai * sr + ei; sr = nr; si = ni; } }
    for (long i = gtid; i < (long)BATCH * 768; i += gs) { const int r = (int)(i % 768), b = (int)(i / 768), dir = r / 384; float h = 0.f;
        for (int q = 0; q < NT; ++q) { const int ct = dir == 0 ? q : NT - 1 - q; const size_t o = (size_t)(b * NT + ct) * 768 + r;
            c.lruin()[o] = h; h = c.lrupe()[2 * o] * h + c.lrupe()[2 * o + 1]; } }
}
HD void expert_range(const unsigned* cnt, int e, int& start, int& count) { int s = 0; for (int q = 0; q < e; ++q) s += ((int)cnt[q * CNT_STRIDE] + 255) & ~255; start = s; count = (int)cnt[e * CNT_STRIDE]; }
HD void st_route(long gtid, long gs, const Ctx& c, int l) {
    const unsigned* cnt = c.ctl() + CW_CNT + 32 * l * CNT_STRIDE;
    for (long i = gtid; i < (long)T * 4; i += gs) { const int e = c.tke()[i]; int st, n; expert_range(cnt, e, st, n); const int d = st + c.tkp()[i];
        c.tkd()[i] = d; c.rowtok()[d] = (int)(i / 4); c.rowgate()[d] = c.tkg()[i]; }
    int total = 0; for (int q = 0; q < NE; ++q) total += ((int)cnt[q * CNT_STRIDE] + 255) & ~255;
    for (long r = gtid; r < total; r += gs) { int e = 0, st = 0; for (;;) { const int pe = ((int)cnt[e * CNT_STRIDE] + 255) & ~255; if (r < st + pe) break; st += pe; ++e; }
        if (r - st >= (long)cnt[e * CNT_STRIDE]) { c.rowtok()[r] = 0; c.rowgate()[r] = 0.f; }
        if ((r & 255) == 0) c.blke()[r >> 8] = e; }
    if (gtid == 0) c.ctl()[CW_NMB + l] = (unsigned)(total / 256);
}

#ifdef HOST_TEST
constexpr int NL = 1;
inline float wsum(float v) { return v; }
#else
constexpr int NL = 64;
DEV float wsum(float v) {
#pragma unroll
    for (int o = 1; o < 64; o <<= 1) v += __shfl_xor(v, o);
    return v;
}
#endif
HD void row_norm_bf16(const float* xr, bf16_t* orow, int lane) {
    float ss = 0.f;
    for (int k = lane * 4; k < D; k += NL * 4) { const float a = xr[k], b = xr[k + 1], cc = xr[k + 2], d = xr[k + 3]; ss += a * a + b * b + cc * cc + d * d; }
    const float rstd = 1.f / sqrtf(wsum(ss) * (1.f / D) + EPS);
    for (int k = lane * 4; k < D; k += NL * 4) { unsigned* o = (unsigned*)(orow + k); o[0] = pk2(xr[k] * rstd, xr[k + 1] * rstd); o[1] = pk2(xr[k + 2] * rstd, xr[k + 3] * rstd); }
}
HD void row_mix_norm(const Ctx& c, int t, int lane) {
    bf16_t* orow = c.o() + (size_t)t * D;
    { float ss = 0.f; const float* ya = c.ya() + (size_t)t * 256;
      for (int k = lane; k < 256; k += NL) ss += ya[k] * ya[k];
      const float rstd = 1.f / sqrtf(wsum(ss) * (1.f / 256) + EPS);
      for (int k = lane; k < 256; k += NL) orow[k] = (bf16_t)f2bf(ya[k] * rstd); }
    { float ss = 0.f; const bf16_t* yb = c.yb() + (size_t)t * 384;
      for (int k = lane; k < 384; k += NL) { const float y = bf2f(yb[k]); ss += y * y; }
      const float rstd = 1.f / sqrtf(wsum(ss) * (1.f / 384) + EPS);
      for (int k = lane; k < 384; k += NL) orow[256 + k] = (bf16_t)f2bf(bf2f(yb[k]) * rstd); }
    { float ss = 0.f; const float* hd = c.hdir() + (size_t)t * 768; const bf16_t* gz = c.z() + (size_t)t * D_INP + 1024;
      for (int k = lane; k < 384; k += NL) { const float y = (hd[k] + hd[384 + k]) * gelu_tanh(bf2f(gz[k])); ss += y * y; }
      const float rstd = 1.f / sqrtf(wsum(ss) * (1.f / 384) + EPS);
      for (int k = lane; k < 384; k += NL) { const float y = (hd[k] + hd[384 + k]) * gelu_tanh(bf2f(gz[k])); orow[640 + k] = (bf16_t)f2bf(y * rstd); } }
}
HD void row_mix_norm2(const Ctx& c, int t, int lane) {
    bf16_t* orow = c.o() + (size_t)t * D;
    { float ss = 0.f; const bf16_t* yb = c.yb() + (size_t)t * 384;
      for (int k = lane; k < 384; k += NL) { const float y = bf2f(yb[k]); ss += y * y; }
      const float rstd = 1.f / sqrtf(wsum(ss) * (1.f / 384) + EPS);
      for (int k = lane; k < 384; k += NL) orow[256 + k] = (bf16_t)f2bf(bf2f(yb[k]) * rstd); }
    { float ss = 0.f; const bf16_t* hl = c.hl() + (size_t)t * 768; const bf16_t* cp = c.cp() + (size_t)t * 768; const bf16_t* gz = c.z() + (size_t)t * D_INP + 1024;
      const float* cin = c.lruin() + (size_t)((t / SEQ) * NT + (t % SEQ) / LC) * 768;
      for (int k = lane; k < 384; k += NL) { const float y = (bf2f(hl[k]) + bf2f(cp[k]) * cin[k] + bf2f(hl[384 + k]) + bf2f(cp[384 + k]) * cin[384 + k]) * gelu_tanh(bf2f(gz[k])); ss += y * y; }
      const float rstd = 1.f / sqrtf(wsum(ss) * (1.f / 384) + EPS);
      for (int k = lane; k < 384; k += NL) { const float y = (bf2f(hl[k]) + bf2f(cp[k]) * cin[k] + bf2f(hl[384 + k]) + bf2f(cp[384 + k]) * cin[384 + k]) * gelu_tanh(bf2f(gz[k])); orow[640 + k] = (bf16_t)f2bf(y * rstd); } }
}
HD void row_combine(const Ctx& c, int t, int lane, bool last) {
    float* xr = c.X() + (size_t)t * D; float ss = 0.f;
    const int d0 = c.tkd()[t * 4], d1 = c.tkd()[t * 4 + 1], d2 = c.tkd()[t * 4 + 2], d3 = c.tkd()[t * 4 + 3];
    for (int k = lane * 4; k < D; k += NL * 4) {
        for (int j = 0; j < 4; ++j) { float a = xr[k + j];
            a += bf2f(c.yexp()[(size_t)d0 * 1024 + k + j]); a += bf2f(c.yexp()[(size_t)d1 * 1024 + k + j]); a += bf2f(c.yexp()[(size_t)d2 * 1024 + k + j]); a += bf2f(c.yexp()[(size_t)d3 * 1024 + k + j]);
            xr[k + j] = a; ss += a * a; } }
    const float rstd = 1.f / sqrtf(wsum(ss) * (1.f / D) + EPS);
    if (!last) { bf16_t* orow = c.hb() + (size_t)t * D;
        for (int k = lane * 4; k < D; k += NL * 4) { unsigned* o = (unsigned*)(orow + k); o[0] = pk2(xr[k] * rstd, xr[k + 1] * rstd); o[1] = pk2(xr[k + 2] * rstd, xr[k + 3] * rstd); } }
    else { float* orow = c.out + (size_t)t * D; const float* fg = c.in[I_FING];
        for (int k = lane * 4; k < D; k += NL * 4) for (int j = 0; j < 4; ++j) orow[k + j] = xr[k + j] * rstd * fg[k + j]; }
}

HD void st_bf16x4(bf16_t* p, float a, float b, float cc, float d) { unsigned* o = (unsigned*)p; o[0] = pk2(a, b); o[1] = pk2(cc, d); }
struct EpiIn { static constexpr bool SIDE = false; bf16_t* z; HD void operator()(const Unit&, int row, int col, const f32x4& v) const { st_bf16x4(z + (size_t)row * D_INP + col, v[0], v[1], v[2], v[3]); } };
struct EpiGlu { static constexpr bool SIDE = false; bf16_t* yb; const float* b;
    HD void operator()(const Unit&, int row, int col, const f32x4& v) const { const int j = col >> 1;
        const float y0 = (v[0] + b[j]) * sigmoid_fast(v[1] + b[384 + j]), y1 = (v[2] + b[j + 1]) * sigmoid_fast(v[3] + b[384 + j + 1]);
        *(unsigned*)(yb + (size_t)row * 384 + j) = pk2(y0, y1); } };
struct EpiOut { static constexpr bool SIDE = false; const float* base; float* X;
#ifdef HOST_TEST
    HD void operator()(const Unit&, int row, int col, const f32x4& v) const { const size_t o = (size_t)row * D + col; for (int j = 0; j < 4; ++j) X[o + j] = base[o + j] + v[j]; } };
#else
    __device__ __forceinline__ void operator()(const Unit&, int row, int col, const f32x4& v) const { const size_t o = (size_t)row * D + col; const f32x4 r = *(const __attribute__((address_space(1))) f32x4*)(base + o) + v; *(__attribute__((address_space(1))) f32x4*)(X + o) = r; } };
#endif
#ifndef HOST_TEST
template <bool BASE_F32>
struct EpiOutW { static constexpr bool SIDE = false; const void* base; bf16_t* X;
    __device__ __forceinline__ void wide(const Unit&, int row, int col, const f32x4& a, const f32x4& b) const { typedef unsigned u4_ __attribute__((ext_vector_type(4)));
        const size_t o = (size_t)row * D + col; f32x4 r0, r1;
        if constexpr (BASE_F32) { const __attribute__((address_space(1))) f32x4* p = (const __attribute__((address_space(1))) f32x4*)((const float*)base + o); r0 = p[0]; r1 = p[1]; }
        else { const u4_ w = *(const __attribute__((address_space(1))) u4_*)((const bf16_t*)base + o);
            r0 = (f32x4){__builtin_bit_cast(float, w.x << 16), __builtin_bit_cast(float, w.x & 0xffff0000u), __builtin_bit_cast(float, w.y << 16), __builtin_bit_cast(float, w.y & 0xffff0000u)};
            r1 = (f32x4){__builtin_bit_cast(float, w.z << 16), __builtin_bit_cast(float, w.z & 0xffff0000u), __builtin_bit_cast(float, w.w << 16), __builtin_bit_cast(float, w.w & 0xffff0000u)}; }
        r0 += a; r1 += b;
        u4_ q; q.x = pk2(r0[0], r0[1]); q.y = pk2(r0[2], r0[3]); q.z = pk2(r1[0], r1[1]); q.w = pk2(r1[2], r1[3]);
        *(__attribute__((address_space(1))) u4_*)(X + o) = q; } };
#endif
struct EpiMoe1 { static constexpr bool SIDE = false; bf16_t* act; const float* bgu;
    HD void operator()(const Unit& u, int row, int col, const f32x4& v) const { const float* b = bgu + (size_t)u.e * 2048 + col; float r[2];
        for (int q = 0; q < 2; ++q) { float g = v[2 * q] + b[2 * q], up = v[2 * q + 1] + b[2 * q + 1]; g = g < 7.f ? g : 7.f; up = up < -7.f ? -7.f : (up > 7.f ? 7.f : up);
            r[q] = (up + 1.f) * (g * sigmoid_fast(1.702f * g)); }
        *(unsigned*)(act + (size_t)row * 1024 + (col >> 1)) = pk2(r[0], r[1]); } };
struct EpiMoe2 { static constexpr bool SIDE = false; bf16_t* yexp; const float* bdn; const float* rowgate;
    HD void operator()(const Unit& u, int row, int col, const f32x4& v) const { const float* b = bdn + (size_t)u.e * 1024 + col; const float g = rowgate[row];
        st_bf16x4(yexp + (size_t)row * 1024 + col, (v[0] + b[0]) * g, (v[1] + b[1]) * g, (v[2] + b[2]) * g, (v[3] + b[3]) * g); } };

#ifndef HOST_TEST
#define LAS __attribute__((address_space(3)))
__device__ __forceinline__ unsigned f32x2_to_fp8(float a, float b) { return (unsigned)__builtin_amdgcn_cvt_pk_fp8_f32(a, b, 0, false) & 0xffffu; }
constexpr float W8_SCALE = 64.f, W8_INV = 1.f / 64.f;
struct EpiInW { static constexpr bool SIDE = false; bf16_t* z;
    __device__ __forceinline__ void wide(const Unit&, int row, int col, const f32x4& a, const f32x4& b) const { typedef unsigned u4_ __attribute__((ext_vector_type(4))); u4_ w; w.x = pk2(a[0], a[1]); w.y = pk2(a[2], a[3]); w.z = pk2(b[0], b[1]); w.w = pk2(b[2], b[3]);
        if (col < D_IN) *(__attribute__((address_space(1))) u4_*)(z + (size_t)row * D_INP + col) = w; } };
struct EpiGluW { static constexpr bool SIDE = true; bf16_t* yb; const float* b;
    __device__ __forceinline__ void load_side(const Unit& u, LAS unsigned char* sp, int par, int tid) const { if (tid < 256) { const int col = u.pn * 256 + tid; ((LAS float*)(sp + par * 1024))[tid] = b[(col & 1) * 384 + (col >> 1)]; } }
    __device__ __forceinline__ void wide_side(const Unit&, int row, int col, const f32x4& a, const f32x4& c2, LAS unsigned char* sp, int par) const { const LAS float* bp = (const LAS float*)(sp + par * 1024) + (col & 255); const f32x4 b0 = *(const LAS f32x4*)bp, b1 = *(const LAS f32x4*)(bp + 4);
        const float y0 = (a[0] + b0[0]) * sigmoid_fast(a[1] + b0[1]), y1 = (a[2] + b0[2]) * sigmoid_fast(a[3] + b0[3]), y2 = (c2[0] + b1[0]) * sigmoid_fast(c2[1] + b1[1]), y3 = (c2[2] + b1[2]) * sigmoid_fast(c2[3] + b1[3]);
        typedef unsigned u2_ __attribute__((ext_vector_type(2))); u2_ w; w.x = pk2(y0, y1); w.y = pk2(y2, y3); *(__attribute__((address_space(1))) u2_*)(yb + (size_t)row * 384 + (col >> 1)) = w; } };
struct EpiNullW { static constexpr bool SIDE = false; __device__ __forceinline__ void wide(const Unit&, int, int, const f32x4&, const f32x4&) const {} };
struct EpiMoe1F8 { static constexpr bool SIDE = true; unsigned char* act8; const float* bgu;
    __device__ __forceinline__ void load_side(const Unit& u, LAS unsigned char* sp, int par, int tid) const { if (tid < 256) ((LAS float*)(sp + par * 1024))[tid] = bgu[(size_t)u.e * 2048 + u.pn * 256 + tid]; }
    __device__ __forceinline__ void wide_side(const Unit& u, int row, int col, const f32x4& a, const f32x4& c2, LAS unsigned char* sp, int par) const { const LAS float* bp = (const LAS float*)(sp + par * 1024) + (col & 255); const f32x4 b0 = *(const LAS f32x4*)bp, b1 = *(const LAS f32x4*)(bp + 4); float r[4];
#pragma unroll
        for (int q = 0; q < 4; ++q) { float g = (q < 2 ? a[2 * q] : c2[2 * q - 4]) * W8_INV + (q < 2 ? b0[2 * q] : b1[2 * q - 4]), up = (q < 2 ? a[2 * q + 1] : c2[2 * q - 3]) * W8_INV + (q < 2 ? b0[2 * q + 1] : b1[2 * q - 3]);
            g = __builtin_fminf(g, 7.f); up = __builtin_amdgcn_fmed3f(up, -7.f, 7.f); r[q] = (up + 1.f) * (g * __builtin_amdgcn_rcpf(1.f + __builtin_amdgcn_exp2f(g * -2.4554669595930157f))); }
        *(__attribute__((address_space(1))) unsigned*)(act8 + (size_t)row * 1024 + (col >> 1)) = f32x2_to_fp8(r[0], r[1]) | (f32x2_to_fp8(r[2], r[3]) << 16); }
    __device__ __forceinline__ void wide(const Unit& u, int row, int col, const f32x4& a, const f32x4& c2) const { const float* bp = bgu + (size_t)u.e * 2048 + col; const f32x4 b0 = *(const f32x4*)bp, b1 = *(const f32x4*)(bp + 4); float r[4];
#pragma unroll
        for (int q = 0; q < 4; ++q) { float g = (q < 2 ? a[2 * q] : c2[2 * q - 4]) * W8_INV + (q < 2 ? b0[2 * q] : b1[2 * q - 4]), up = (q < 2 ? a[2 * q + 1] : c2[2 * q - 3]) * W8_INV + (q < 2 ? b0[2 * q + 1] : b1[2 * q - 3]);
            g = __builtin_fminf(g, 7.f); up = __builtin_amdgcn_fmed3f(up, -7.f, 7.f); r[q] = (up + 1.f) * (g * __builtin_amdgcn_rcpf(1.f + __builtin_amdgcn_exp2f(g * -2.4554669595930157f))); }
        *(unsigned*)(act8 + (size_t)row * 1024 + (col >> 1)) = f32x2_to_fp8(r[0], r[1]) | (f32x2_to_fp8(r[2], r[3]) << 16); }
    __device__ __forceinline__ void operator()(const Unit& u, int row, int col, const f32x4& v) const { const float* b = bgu + (size_t)u.e * 2048 + col; float r[2];
        for (int q = 0; q < 2; ++q) { float g = v[2 * q] * W8_INV + b[2 * q], up = v[2 * q + 1] * W8_INV + b[2 * q + 1]; g = g < 7.f ? g : 7.f; up = up < -7.f ? -7.f : (up > 7.f ? 7.f : up);
            r[q] = (up + 1.f) * (g * sigmoid_fast(1.702f * g)); }
        *(unsigned short*)(act8 + (size_t)row * 1024 + (col >> 1)) = (unsigned short)f32x2_to_fp8(r[0], r[1]); } };
struct EpiMoe2F8 { static constexpr bool SIDE = true; bf16_t* yexp; const float* bdn; const float* rowgate;
    __device__ __forceinline__ void load_side(const Unit& u, LAS unsigned char* sp, int par, int tid) const { if (tid < 256) ((LAS float*)(sp + par * 1024))[tid] = bdn[(size_t)u.e * 1024 + u.pn * 256 + tid]; else ((LAS float*)(sp + 2048 + par * 1024))[tid - 256] = rowgate[u.pm * 256 + tid - 256]; }
    __device__ __forceinline__ void wide_side(const Unit& u, int row, int col, const f32x4& a, const f32x4& c2, LAS unsigned char* sp, int par) const { typedef unsigned u4_ __attribute__((ext_vector_type(4))); const LAS float* bp = (const LAS float*)(sp + par * 1024) + (col & 255); const f32x4 b0 = *(const LAS f32x4*)bp, b1 = *(const LAS f32x4*)(bp + 4);
        const float g = ((const LAS float*)(sp + 2048 + par * 1024))[row & 255];
        u4_ w; w.x = pk2((a[0] * W8_INV + b0[0]) * g, (a[1] * W8_INV + b0[1]) * g); w.y = pk2((a[2] * W8_INV + b0[2]) * g, (a[3] * W8_INV + b0[3]) * g); w.z = pk2((c2[0] * W8_INV + b1[0]) * g, (c2[1] * W8_INV + b1[1]) * g); w.w = pk2((c2[2] * W8_INV + b1[2]) * g, (c2[3] * W8_INV + b1[3]) * g);
        *(__attribute__((address_space(1))) u4_*)(yexp + (size_t)row * 1024 + col) = w; }
    __device__ __forceinline__ void wide(const Unit& u, int row, int col, const f32x4& a, const f32x4& c2) const { typedef unsigned u4_ __attribute__((ext_vector_type(4))); const float* bp = bdn + (size_t)u.e * 1024 + col; const f32x4 b0 = *(const f32x4*)bp, b1 = *(const f32x4*)(bp + 4); const float g = rowgate[row];
        u4_ w; w.x = pk2((a[0] * W8_INV + b0[0]) * g, (a[1] * W8_INV + b0[1]) * g); w.y = pk2((a[2] * W8_INV + b0[2]) * g, (a[3] * W8_INV + b0[3]) * g); w.z = pk2((c2[0] * W8_INV + b1[0]) * g, (c2[1] * W8_INV + b1[1]) * g); w.w = pk2((c2[2] * W8_INV + b1[2]) * g, (c2[3] * W8_INV + b1[3]) * g);
        *(u4_*)(yexp + (size_t)row * 1024 + col) = w; }
    __device__ __forceinline__ void operator()(const Unit& u, int row, int col, const f32x4& v) const { const float* b = bdn + (size_t)u.e * 1024 + col; const float g = rowgate[row];
        st_bf16x4(yexp + (size_t)row * 1024 + col, (v[0] * W8_INV + b[0]) * g, (v[1] * W8_INV + b[1]) * g, (v[2] * W8_INV + b[2]) * g, (v[3] * W8_INV + b[3]) * g); } };
#endif
HD int wmap_row(int mode, int n) { return mode == 0 ? n : (n < 384 ? 2 * n : 2 * (n - 384) + 1); }

#ifndef HOST_TEST
#ifndef LAS
#define LAS __attribute__((address_space(3)))
#endif
#define GAS __attribute__((address_space(1)))
typedef short bf16x8 __attribute__((ext_vector_type(8)));
typedef unsigned v4u __attribute__((ext_vector_type(4)));
constexpr int NWAVES = 8;

namespace pg8 {
constexpr int BM = 256, BK = 64, HALF = 128, HTB = HALF * BK * 2, STAGE_BYTES = 8 * HTB, NXCD = 8, WGM = 8;
__host__ __device__ __forceinline__ int lds_byte(int r, int c) { const int st = (r >> 4) * 2 + (c >> 5), rr = r & 15, cc = c & 31, ob = rr * 64 + cc * 2; return st * 1024 + (ob ^ (((ob >> 9) & 1) << 5)); }
__host__ __device__ __forceinline__ void stage_rc(int b, int& R, int& C) { const int st = b / 1024, sb = b % 1024, swz = sb ^ (((sb >> 9) & 1) << 5); R = (st >> 1) * 16 + swz / 64; C = (st & 1) * 32 + (swz % 64) / 2; }
struct StaticOrder {
    int nM, nN, nwg, G, c;
    __device__ __forceinline__ void init(int nM_, int nN_, int G_, int c_) { nM = nM_; nN = nN_; nwg = nM * nN; G = G_; c = c_; }
    __device__ __forceinline__ bool next(int i, Unit& u) const {
        const long L = (long)i * G + c; if (L >= nwg) return false;
        int wgid = (int)L; { const int q = nwg / NXCD, r = nwg % NXCD, xcd = wgid % NXCD, off = wgid / NXCD; wgid = (xcd < r ? xcd * (q + 1) : r * (q + 1) + (xcd - r) * q) + off; }
        const int nig = WGM * nN, gid = wgid / nig, fm = gid * WGM, gsz = (nM - fm) < WGM ? (nM - fm) : WGM;
        u.pm = fm + ((wgid % nig) % gsz); u.pn = (wgid % nig) / gsz; u.e = 0; return true;
    }
};
struct SchedPlain { StaticOrder so; const char* Bt; size_t tstepB; const int* rowtab;
    __device__ __forceinline__ bool next(int i, Unit& u) const { return so.next(i, u); }
    __device__ __forceinline__ const char* bptr(const Unit& u) const { return Bt + (size_t)u.pn * tstepB; } };
struct SchedMoe { StaticOrder so; const char* Bt; size_t tstepB, estride; const int* rowtab; const int* blke; const LAS int* ue;
    __device__ __forceinline__ bool next(int i, Unit& u) const { if (!so.next(i, u)) return false; u.e = ue[i]; return true; }
    __device__ __forceinline__ const char* bptr(const Unit& u) const { return Bt + (size_t)u.e * estride + (size_t)u.pn * tstepB; } };

__host__ __device__ __forceinline__ int perm32(int rho) { const int n = rho >> 4, i = rho & 15; return 8 * (i >> 2) + 4 * n + (i & 3); }
template <class Epi, class Sched, bool GATHER, bool F8 = false, bool PERM = false>
__device__ __forceinline__ void gemm_phase(LAS unsigned char* lds, const int wave_id, const bf16_t* A, const int K, const Sched& S, const Epi& E) {
    int lane_ = (int)__builtin_amdgcn_mbcnt_hi(~0u, __builtin_amdgcn_mbcnt_lo(~0u, 0u)); asm volatile("" : "+v"(lane_));
    const int wid = wave_id, lane = lane_, tid = wid * 64 + lane, wr = wid >> 2, wc = wid & 3, fr = lane & 15, fq = lane >> 4;
    const int nt = K / BK;
    unsigned voffA[2], voffB[2];
#pragma unroll
    for (int i = 0; i < 2; ++i) { int R, C; stage_rc(tid * 16 + i * 8192, R, C); voffA[i] = (unsigned)(R * K + C) * 2u; const int Rb = PERM ? ((R & ~31) + perm32(R & 31)) : R; voffB[i] = (unsigned)(Rb * K + C) * 2u; }
    const size_t kstep = (size_t)(BK * 2);
    const size_t hstep = (size_t)HALF * K * 2;
    const unsigned ldsw = (unsigned)wid * 1024u;
    const int aoff = lds_byte(wr * 64 + fr, fq * 8), boff = lds_byte(wc * 32 + fr, fq * 8);
#define PG8_SA(b, h) (((b) * 2 + (h)) * HTB)
#define PG8_SB(b, h) ((4 + (b) * 2 + (h)) * HTB)
#define PG8_STAGE(bufoff, gbase, voff) do { _Pragma("unroll") for (int _i = 0; _i < 2; ++_i) \
        __builtin_amdgcn_global_load_lds((const unsigned*)((const char*)(gbase) + (voff)[_i]), (LAS unsigned*)(lds + (bufoff) + ldsw + _i * 8192), 16, 0, 0); } while (0)
#define PG8_LDA(dst, b, h) do { _Pragma("unroll") for (int m = 0; m < 4; ++m) _Pragma("unroll") for (int k = 0; k < 2; ++k) dst[m][k] = *(const LAS bf16x8*)(lds + PG8_SA(b, h) + aoff + m * 2048 + k * 1024); } while (0)
#define PG8_LDB(dst, b, h) do { _Pragma("unroll") for (int n = 0; n < 2; ++n) _Pragma("unroll") for (int k = 0; k < 2; ++k) dst[n][k] = *(const LAS bf16x8*)(lds + PG8_SB(b, h) + boff + n * 2048 + k * 1024); } while (0)
#define PG8_MMA(ai, bj, At, Bt) do { __builtin_amdgcn_s_setprio(1); _Pragma("unroll") for (int m = 0; m < 4; ++m) _Pragma("unroll") for (int n = 0; n < 2; ++n) _Pragma("unroll") for (int k = 0; k < 2; ++k) \
        asm volatile("s_nop 1\n\tv_mfma_f32_16x16x32_bf16 %0, %1, %2, %0" : "+v"(acc[ai][bj][m][n]) : "v"(Bt[n][k]), "v"(At[m][k])); __builtin_amdgcn_s_setprio(0); } while (0)
    typedef int v4i_ __attribute__((ext_vector_type(4))); typedef int v8i_ __attribute__((ext_vector_type(8)));
    int sc1 = 0x7f7f7f7f; asm volatile("" : "+v"(sc1));
#define PG8_MMA8(ai, bj, At, Bt) do { __builtin_amdgcn_s_setprio(1); _Pragma("unroll") for (int m = 0; m < 4; ++m) _Pragma("unroll") for (int n = 0; n < 2; ++n) { \
        const v8i_ a8_ = __builtin_shufflevector(__builtin_bit_cast(v4i_, At[m][0]), __builtin_bit_cast(v4i_, At[m][1]), 0, 1, 2, 3, 4, 5, 6, 7), b8_ = __builtin_shufflevector(__builtin_bit_cast(v4i_, Bt[n][0]), __builtin_bit_cast(v4i_, Bt[n][1]), 0, 1, 2, 3, 4, 5, 6, 7); \
        asm volatile("s_nop 1\n\tv_mfma_scale_f32_16x16x128_f8f6f4 %0, %1, %2, %0, %3, %3 op_sel_hi:[0,0,0]" : "+v"(acc[ai][bj][m][n]) : "v"(b8_), "v"(a8_), "v"(sc1)); } __builtin_amdgcn_s_setprio(0); } while (0)
#define PG8_MM(ai, bj, At, Bt) do { if constexpr (F8) PG8_MMA8(ai, bj, At, Bt); else PG8_MMA(ai, bj, At, Bt); } while (0)
#define PG8_WAIT_V(n) asm volatile("s_waitcnt vmcnt(" #n ")" ::: "memory")
#define PG8_WAIT_L(n) asm volatile("s_waitcnt lgkmcnt(" #n ")" ::: "memory")
#define PG8_BAR __builtin_amdgcn_s_barrier()
#define PG8_SCHED __builtin_amdgcn_sched_barrier(0)
#define PG8_ROWS(u, dst) do { _Pragma("unroll") for (int h = 0; h < 2; ++h) _Pragma("unroll") for (int i = 0; i < 2; ++i) { int R, C; stage_rc(tid * 16 + i * 8192, R, C); \
        const int rix = S.rowtab[(u).pm * BM + h * HALF + R]; dst[h][i] = (unsigned)rix * (unsigned)(K * 2) + (unsigned)C * 2u; } } while (0)
#define PG8_STAGE_A(bufoff, h, koff, nx) do { if constexpr (GATHER) { _Pragma("unroll") for (int _i = 0; _i < 2; ++_i) \
            __builtin_amdgcn_global_load_lds((const unsigned*)((const char*)A + (koff) + ((nx) ? vn[h][_i] : vc[h][_i])), (LAS unsigned*)(lds + (bufoff) + ldsw + _i * 8192), 16, 0, 0); } \
        else { const char* _b = ((nx) ? nA : cA) + (h) * hstep + (koff); _Pragma("unroll") for (int _i = 0; _i < 2; ++_i) \
            __builtin_amdgcn_global_load_lds((const unsigned*)(_b + voffA[_i]), (LAS unsigned*)(lds + (bufoff) + ldsw + _i * 8192), 16, 0, 0); } } while (0)
    Unit cur, nxt; int ui = 0;
    if (!S.next(0, cur)) return;
    if constexpr (Epi::SIDE) E.load_side(cur, lds + STAGE_BYTES, 0, tid);
    f32x4 acc[2][2][4][2];
#pragma unroll
    for (int a = 0; a < 2; ++a)
#pragma unroll
        for (int b = 0; b < 2; ++b)
#pragma unroll
            for (int m = 0; m < 4; ++m)
#pragma unroll
                for (int n = 0; n < 2; ++n) acc[a][b][m][n] = (f32x4){0.f, 0.f, 0.f, 0.f};
    bf16x8 At[4][2], B0[2][2], B1[2][2];
    unsigned vc[2][2], vn[2][2];
    const size_t tstepA = 2 * hstep;
    const char* cA = (const char*)A; const char* nA = cA;
    if constexpr (GATHER) { PG8_ROWS(cur, vc); } else { cA = (const char*)A + (size_t)cur.pm * tstepA; }
    const char* cB = S.bptr(cur);
    PG8_STAGE(PG8_SB(0, 0), cB, voffB); PG8_STAGE_A(PG8_SA(0, 0), 0, 0, false); PG8_STAGE(PG8_SB(0, 1), cB + hstep, voffB); PG8_STAGE_A(PG8_SA(0, 1), 1, 0, false);
    if (wr == 1) PG8_BAR;
    PG8_WAIT_V(4); PG8_BAR;
    PG8_STAGE(PG8_SB(1, 0), cB + kstep, voffB); PG8_STAGE_A(PG8_SA(1, 0), 0, kstep, false); PG8_STAGE(PG8_SB(1, 1), cB + hstep + kstep, voffB);
    PG8_WAIT_V(6); PG8_BAR;
    for (;;) {
        const bool has_next = S.next(ui + 1, nxt);
        if constexpr (GATHER) {
            if (has_next) { PG8_ROWS(nxt, vn); } else {
#pragma unroll
                for (int h = 0; h < 2; ++h)
#pragma unroll
                    for (int i = 0; i < 2; ++i) vn[h][i] = vc[h][i]; }
        } else { nA = has_next ? (const char*)A + (size_t)nxt.pm * tstepA : cA; }
        const char* nB = has_next ? S.bptr(nxt) : cB;
        for (int t = 0; t < nt; t += 2) {
            const bool last = (t == nt - 2);
            const size_t k1 = (size_t)(t + 1) * kstep, k2 = last ? 0 : (size_t)(t + 2) * kstep, k3 = k2 + kstep;
            const char* b2 = last ? nB : cB + (size_t)(t + 2) * kstep; const char* b3 = b2 + kstep;
            PG8_LDB(B0, 0, 0); PG8_SCHED; PG8_LDA(At, 0, 0); PG8_STAGE_A(PG8_SA(1, 1), 1, k1, false);
            PG8_WAIT_L(8); PG8_BAR; PG8_WAIT_L(0); PG8_MM(0, 0, At, B0); PG8_BAR; PG8_SCHED;
            PG8_LDB(B1, 0, 1); PG8_STAGE(PG8_SB(0, 0), b2, voffB);
            PG8_BAR; PG8_WAIT_L(0); PG8_MM(0, 1, At, B1); PG8_BAR;
            PG8_LDA(At, 0, 1); PG8_STAGE_A(PG8_SA(0, 0), 0, k2, last);
            PG8_BAR; PG8_WAIT_L(0); PG8_MM(1, 0, At, B0); PG8_BAR; PG8_SCHED;
            PG8_STAGE(PG8_SB(0, 1), b2 + hstep, voffB);
            PG8_WAIT_V(6); PG8_BAR; PG8_MM(1, 1, At, B1); PG8_BAR;
            PG8_LDB(B0, 1, 0); PG8_SCHED; PG8_LDA(At, 1, 0); PG8_STAGE_A(PG8_SA(0, 1), 1, k2, last);
            PG8_WAIT_L(8); PG8_BAR; PG8_WAIT_L(0); PG8_MM(0, 0, At, B0); PG8_BAR; PG8_SCHED;
            PG8_LDB(B1, 1, 1); PG8_STAGE(PG8_SB(1, 0), b3, voffB);
            PG8_BAR; PG8_WAIT_L(0); PG8_MM(0, 1, At, B1); PG8_BAR;
            PG8_LDA(At, 1, 1); PG8_STAGE_A(PG8_SA(1, 0), 0, k3, last);
            PG8_BAR; PG8_WAIT_L(0); PG8_MM(1, 0, At, B0); PG8_BAR; PG8_SCHED;
            PG8_STAGE(PG8_SB(1, 1), b3 + hstep, voffB);
            PG8_WAIT_V(6); PG8_BAR; PG8_MM(1, 1, At, B1); PG8_BAR;
        }
        asm volatile("s_nop 15\n\ts_nop 15" : "+v"(acc[0][0][0][0]), "+v"(acc[1][1][3][1]));
        Unit eu; eu.pm = __builtin_amdgcn_readfirstlane(cur.pm); eu.pn = __builtin_amdgcn_readfirstlane(cur.pn); eu.e = __builtin_amdgcn_readfirstlane(cur.e); int rbase = wr * 64 + fr, cbase = wc * 32 + 4 * fq;
        asm volatile("" : "+s"(eu.pm), "+s"(eu.pn), "+s"(eu.e), "+v"(rbase), "+v"(cbase));
#pragma unroll
        for (int ai = 0; ai < 2; ++ai)
#pragma unroll
            for (int m = 0; m < 4; ++m) { const int row = eu.pm * BM + ai * HALF + m * 16 + rbase;
                if constexpr (PERM) {
#pragma unroll
                    for (int bj = 0; bj < 2; ++bj) { if constexpr (Epi::SIDE) E.wide_side(eu, row, eu.pn * BM + bj * HALF + 2 * cbase - (cbase & ~31), acc[ai][bj][m][0], acc[ai][bj][m][1], lds + STAGE_BYTES, ui & 1);
                        else E.wide(eu, row, eu.pn * BM + bj * HALF + 2 * cbase - (cbase & ~31), acc[ai][bj][m][0], acc[ai][bj][m][1]);
                        if constexpr (Epi::SIDE) asm volatile("" ::: "memory"); }
                } else {
#pragma unroll
                for (int bj = 0; bj < 2; ++bj)
#pragma unroll
                    for (int n = 0; n < 2; ++n) E(eu, row, eu.pn * BM + bj * HALF + n * 16 + cbase, acc[ai][bj][m][n]);
                }
                asm volatile("" ::: "memory"); }
        if (!has_next) break;
#pragma unroll
        for (int a = 0; a < 2; ++a)
#pragma unroll
            for (int b = 0; b < 2; ++b)
#pragma unroll
                for (int m = 0; m < 4; ++m)
#pragma unroll
                    for (int n = 0; n < 2; ++n) acc[a][b][m][n] = (f32x4){0.f, 0.f, 0.f, 0.f};
        cur = nxt; cB = nB; cA = nA; ++ui;
        if constexpr (Epi::SIDE) { int tid_s = tid; asm volatile("" : "+v"(tid_s)); E.load_side(cur, lds + STAGE_BYTES, ui & 1, tid_s); }
        if constexpr (GATHER) {
#pragma unroll
            for (int h = 0; h < 2; ++h)
#pragma unroll
                for (int i = 0; i < 2; ++i) vc[h][i] = vn[h][i]; }
    }
    PG8_WAIT_V(0);
    if (wr == 0) PG8_BAR;
    PG8_BAR;
#undef PG8_SA
#undef PG8_SB
#undef PG8_STAGE
#undef PG8_LDA
#undef PG8_LDB
#undef PG8_MMA
#undef PG8_MMA8
#undef PG8_MM
#undef PG8_WAIT_V
#undef PG8_WAIT_L
#undef PG8_BAR
#undef PG8_SCHED
#undef PG8_ROWS
#undef PG8_STAGE_A
}
}

#define XB_TMO      128
#define XB_XCNT(j)  (256  + 64 * (j))
#define XB_XSUB(j)  (1280 + 64 * (j))
#define XB_XGEN(j)  (2304 + 64 * (j))
#define XB_TOP      3328
#define XB_TOPGEN   3392
#define XCD_BAR_WORDS 3456
#define XB_SPIN_CAP (1u << 18)
__device__ __forceinline__ unsigned xb_ld(unsigned* p)              { return __hip_atomic_load(p, __ATOMIC_RELAXED, __HIP_MEMORY_SCOPE_AGENT); }
__device__ __forceinline__ unsigned xb_add(unsigned* p, unsigned v) { return __hip_atomic_fetch_add(p, v, __ATOMIC_RELAXED, __HIP_MEMORY_SCOPE_AGENT); }
__device__ __forceinline__ unsigned xb_xcc_id() { return (unsigned)__builtin_amdgcn_s_getreg((3 << 11) | 20) & 0xFu; }
#define XB_SPIN(cond, bar) do { unsigned _sp = 0; while (cond) { __builtin_amdgcn_s_sleep(1); \
    if ((++_sp & 255u) == 0u) { if (xb_ld(&(bar)[XB_TMO])) break; if (_sp > XB_SPIN_CAP) { atomicAdd(&(bar)[XB_TMO], 1u); break; } } } } while (0)
struct XcdBarrier { unsigned* bar; unsigned x; volatile LAS unsigned* st; };
__device__ __forceinline__ XcdBarrier xcd_barrier_post(unsigned* bar, volatile LAS unsigned* st) {
    XcdBarrier b; b.bar = bar; b.x = xb_xcc_id(); b.st = st;
    if (threadIdx.x == 0) (void)xb_add(&bar[XB_XCNT(b.x)], 1u);
    return b;
}
__device__ __forceinline__ void xcd_barrier_complete(unsigned* bar, unsigned x, unsigned& nloc, unsigned& nx) {
    const unsigned G = gridDim.x * gridDim.y * gridDim.z;
    unsigned sum, cnt, mine, sp = 0u;
    for (;;) {
        sum = 0u; cnt = 0u; mine = 0u;
#pragma unroll
        for (unsigned j = 0; j < 16; ++j) { const unsigned c = xb_ld(&bar[XB_XCNT(j)]); sum += c; cnt += (c > 0u) ? 1u : 0u; mine = (j == x) ? c : mine; }
        if (sum == G) break;
        __builtin_amdgcn_s_sleep(1);
        if ((++sp & 255u) == 0u) { if (xb_ld(&bar[XB_TMO])) break; if (sp > XB_SPIN_CAP) { atomicAdd(&bar[XB_TMO], 1u); break; } }
    }
    nloc = mine > 0u ? mine : 1u; nx = cnt > 0u ? cnt : 1u;
}
__device__ __forceinline__ void xcd_barrier(const XcdBarrier& b, const bool leader) {
    asm volatile("s_waitcnt vmcnt(0)" ::: "memory");
    __syncthreads();
    if (leader) {
        unsigned* bar = b.bar;
        __builtin_amdgcn_s_waitcnt(0);
        unsigned nloc = b.st[0], nx = b.st[1];
        if (nloc == 0u) { xcd_barrier_complete(bar, b.x, nloc, nx); b.st[0] = nloc; b.st[1] = nx; }
        const unsigned old = xb_add(&bar[XB_XSUB(b.x)], 1u);
        const unsigned gen = old / nloc;
        if (old + 1u == (gen + 1u) * nloc) {
            __builtin_amdgcn_fence(__ATOMIC_RELEASE, "agent");
            asm volatile("s_waitcnt vmcnt(0)" ::: "memory");
            const unsigned og = xb_add(&bar[XB_TOP], 1u);
            const unsigned tg = og / nx;
            if (og + 1u == (tg + 1u) * nx) xb_add(&bar[XB_TOPGEN], 1u);
            else XB_SPIN(xb_ld(&bar[XB_TOPGEN]) == tg, bar);
            __builtin_amdgcn_fence(__ATOMIC_ACQUIRE, "agent");
            xb_add(&bar[XB_XGEN(b.x)], 1u);
            asm volatile("s_waitcnt vmcnt(0)" ::: "memory");
        } else {
            XB_SPIN(xb_ld(&bar[XB_XGEN(b.x)]) == gen, bar);
            __builtin_amdgcn_fence(__ATOMIC_ACQUIRE, "agent");
            asm volatile("s_waitcnt vmcnt(0)" ::: "memory");
        }
    }
    __syncthreads();
}

constexpr int RING_BYTES = 131072, LDSCTL_OFF = 143616, LDS_BYTES = 147456;

__device__ __forceinline__ void transpose_item(const float* W, int K, int N, bf16_t* WT, int mode, const float* scale, LAS float* scr, int item, int lane) {
    const int nblk = N / 64, kb = item / nblk, nb = item % nblk, k0 = 64 * kb, n0 = 64 * nb;
    const int n4 = (lane & 15) * 4, kr = lane >> 4;
#pragma unroll 8
    for (int i = 0; i < 16; ++i) { const int kk = 4 * i + kr; f32x4 w = __builtin_nontemporal_load((const __attribute__((address_space(1))) f32x4*)(W + (size_t)(k0 + kk) * N + n0 + n4)); if (scale) w = w * *(const __attribute__((address_space(1))) float*)(scale + k0 + kk);
        scr[kk * 65 + n4] = w[0]; scr[kk * 65 + n4 + 1] = w[1]; scr[kk * 65 + n4 + 2] = w[2]; scr[kk * 65 + n4 + 3] = w[3]; }
    asm volatile("s_waitcnt lgkmcnt(0)" ::: "memory");
    const int c = lane & 7;
#pragma unroll
    for (int j = 0; j < 8; ++j) { const int n = (lane >> 3) + 8 * j; const LAS float* s = scr + (8 * c) * 65 + n;
        v4u o; o.x = pk2(s[0 * 65], s[1 * 65]); o.y = pk2(s[2 * 65], s[3 * 65]); o.z = pk2(s[4 * 65], s[5 * 65]); o.w = pk2(s[6 * 65], s[7 * 65]);
        *(__attribute__((address_space(1))) v4u*)(WT + (size_t)wmap_row(mode, n0 + n) * K + k0 + 8 * c) = o; }
    asm volatile("s_waitcnt lgkmcnt(0)" ::: "memory");
}

__device__ __forceinline__ void transpose_item8(const float* W, int K, int N, unsigned char* WT, const float* scale, LAS float* scr, int item, int lane) {
    const int nblk = N / 64, kb = item / nblk, nb = item % nblk, k0 = 64 * kb, n0 = 64 * nb;
    const int n4 = (lane & 15) * 4, kr = lane >> 4;
#pragma unroll 8
    for (int i = 0; i < 16; ++i) { const int kk = 4 * i + kr; f32x4 w = __builtin_nontemporal_load((const __attribute__((address_space(1))) f32x4*)(W + (size_t)(k0 + kk) * N + n0 + n4)); w = w * (scale ? *(const __attribute__((address_space(1))) float*)(scale + k0 + kk) * W8_SCALE : W8_SCALE);
        scr[kk * 65 + n4] = w[0]; scr[kk * 65 + n4 + 1] = w[1]; scr[kk * 65 + n4 + 2] = w[2]; scr[kk * 65 + n4 + 3] = w[3]; }
    asm volatile("s_waitcnt lgkmcnt(0)" ::: "memory");
    const int c = lane & 3;
#pragma unroll
    for (int j = 0; j < 4; ++j) { const int n = (lane >> 2) + 16 * j; const LAS float* s = scr + (16 * c) * 65 + n; v4u o;
        o.x = f32x2_to_fp8(s[0 * 65], s[1 * 65]) | (f32x2_to_fp8(s[2 * 65], s[3 * 65]) << 16); o.y = f32x2_to_fp8(s[4 * 65], s[5 * 65]) | (f32x2_to_fp8(s[6 * 65], s[7 * 65]) << 16);
        o.z = f32x2_to_fp8(s[8 * 65], s[9 * 65]) | (f32x2_to_fp8(s[10 * 65], s[11 * 65]) << 16); o.w = f32x2_to_fp8(s[12 * 65], s[13 * 65]) | (f32x2_to_fp8(s[14 * 65], s[15 * 65]) << 16);
        *(__attribute__((address_space(1))) v4u*)(WT + (size_t)(n0 + n) * K + k0 + 16 * c) = o; }
    asm volatile("s_waitcnt lgkmcnt(0)" ::: "memory");
}

template <class CT>
__device__ __forceinline__ void router_logits16(const CT& c, int l, int t0, int lane, LAS float* lgs) {
    const int fr = lane & 15, fq = lane >> 4;
    const bf16_t* xa = (const bf16_t*)c.X() + (size_t)(t0 + fr) * D + 8 * fq;
    const bf16_t* wh = (const bf16_t*)c.rwt() + ((size_t)(l * 2) * NE + fr) * 1024 + 8 * fq;
    f32x4 acc0 = (f32x4){0.f, 0.f, 0.f, 0.f}, acc1 = (f32x4){0.f, 0.f, 0.f, 0.f};
#pragma unroll 8
    for (int ks = 0; ks < 32; ++ks) {
        const bf16x8 a = *(const bf16x8*)(xa + 32 * ks);
        const bf16x8 bh0 = *(const bf16x8*)(wh + 32 * ks), bh1 = *(const bf16x8*)(wh + 16 * 1024 + 32 * ks), bl0 = *(const bf16x8*)(wh + NE * 1024 + 32 * ks), bl1 = *(const bf16x8*)(wh + (NE + 16) * 1024 + 32 * ks);
        asm volatile("s_nop 1\n\tv_mfma_f32_16x16x32_bf16 %0, %1, %2, %0" : "+v"(acc0) : "v"(a), "v"(bh0));
        asm volatile("s_nop 1\n\tv_mfma_f32_16x16x32_bf16 %0, %1, %2, %0" : "+v"(acc1) : "v"(a), "v"(bh1));
        asm volatile("s_nop 1\n\tv_mfma_f32_16x16x32_bf16 %0, %1, %2, %0" : "+v"(acc0) : "v"(a), "v"(bl0));
        asm volatile("s_nop 1\n\tv_mfma_f32_16x16x32_bf16 %0, %1, %2, %0" : "+v"(acc1) : "v"(a), "v"(bl1)); }
    asm volatile("s_nop 15\n\ts_nop 15" : "+v"(acc0), "+v"(acc1));
#pragma unroll
    for (int j = 0; j < 4; ++j) { lgs[(4 * fq + j) * 32 + fr] = acc0[j]; lgs[(4 * fq + j) * 32 + 16 + fr] = acc1[j]; }
    asm volatile("s_waitcnt lgkmcnt(0)" ::: "memory");
}

constexpr int RB = 4;
template <class CT>
__device__ __forceinline__ void router_rows(const CT& c, int l, int t0, int lane, LAS int* park, const LAS float* lgs, const bool dummy = false) {
    float rstd_r[RB];
#pragma unroll
    for (int r = 0; r < RB; ++r) { const bf16_t* xr = (const bf16_t*)c.X() + (size_t)(t0 + r) * D; float ss = 0.f; f32x4 v[4];
#pragma unroll
        for (int j = 0; j < 4; ++j) { const uint2 xw_ = *(const uint2*)(xr + 4 * lane + 256 * j);
            v[j] = (f32x4){__builtin_bit_cast(float, xw_.x << 16), __builtin_bit_cast(float, xw_.x & 0xffff0000u), __builtin_bit_cast(float, xw_.y << 16), __builtin_bit_cast(float, xw_.y & 0xffff0000u)}; ss += v[j][0] * v[j][0] + v[j][1] * v[j][1] + v[j][2] * v[j][2] + v[j][3] * v[j][3]; }
        const float rstd = 1.f / sqrtf(wsum(ss) * (1.f / D) + EPS); rstd_r[r] = rstd;
        unsigned char* orow = (dummy ? (unsigned char*)c.yexp() : c.hq()) + (size_t)(t0 + r) * D;
#pragma unroll
        for (int j = 0; j < 4; ++j) { v[j] = v[j] * rstd; *(unsigned*)(orow + 4 * lane + 256 * j) = f32x2_to_fp8(v[j][0], v[j][1]) | (f32x2_to_fp8(v[j][2], v[j][3]) << 16); } }
    float lg[RB];
#pragma unroll
    for (int r = 0; r < RB; ++r) lg[r] = lgs[r * 32 + (lane & 7) * 4 + (lane >> 4)] * rstd_r[r];
    const int e = (lane & 7) * 4 + (lane >> 4);
    const float rb = c.in[I_RB][l * NE + e];
#pragma unroll
    for (int r = 0; r < RB; ++r) { const int t = t0 + r;
        const float lgr = lg[r] + rb;
        unsigned ub = __builtin_bit_cast(unsigned, lgr); ub ^= (ub >> 31) ? 0xffffffffu : 0x80000000u;
        unsigned long long key = ((unsigned long long)ub << 32) | (unsigned)(31 - e);
        int se[4]; float sv[4];
#pragma unroll
        for (int q = 0; q < 4; ++q) { unsigned long long m = key;
#pragma unroll
            for (int o = 1; o < 64; o <<= 1) { const unsigned long long qq = __shfl_xor(m, o); m = qq > m ? qq : m; }
            const int we = 31 - (int)(m & 31u); unsigned wb = (unsigned)(m >> 32); wb ^= (wb >> 31) ? 0x80000000u : 0xffffffffu;
            se[q] = we; sv[q] = __builtin_bit_cast(float, wb); if (e == we) key = 0ull; }
        const float mx = sv[0]; float ex[4], sum = 0.f;
#pragma unroll
        for (int q = 0; q < 4; ++q) { ex[q] = __builtin_amdgcn_exp2f((sv[q] - mx) * 1.4426950408889634f); sum += ex[q]; }
        const float rsum = __builtin_amdgcn_rcpf(sum);
        if (lane == 0) {
#pragma unroll
            for (int q = 0; q < 4; ++q) { if (!dummy) { c.tke()[t * 4 + q] = se[q]; c.tkg()[t * 4 + q] = ex[q] * rsum; } park[r * 4 + q] = se[q]; } }
    }
}

constexpr int S5_PITCH = 272, S5_ROWS = 33, S5_LDS_WAVE = 2 * S5_ROWS * S5_PITCH;
template <bool FINAL, class CT>
__device__ __forceinline__ void s5_tile_dev(const CT& c, const int l, const int tile, const int g, LAS unsigned char* sl, const int lane) {
    const int fr = lane & 15, fq = lane >> 4;
    const int b = tile / NT, ct = tile % NT, t0 = b * SEQ + ct * LC;
    bf16x8 uf[2][2];
#pragma unroll
    for (int m = 0; m < 2; ++m)
#pragma unroll
        for (int ks = 0; ks < 2; ++ks) uf[m][ks] = *(const bf16x8*)(c.z() + (size_t)(t0 + 4 * (16 * m + fr) + 2 * ks + (fq >> 1)) * D_INP + 256 + 16 * g + 8 * (fq & 1));
#pragma unroll
    for (int dir = 0; dir < 2; ++dir) {
        f32x4 acc[2][8];
#pragma unroll
        for (int m = 0; m < 2; ++m)
#pragma unroll
            for (int nt = 0; nt < 8; ++nt) acc[m][nt] = (f32x4){0.f, 0.f, 0.f, 0.f};
        const bf16_t* w = c.w4t() + (size_t)((l * 24 + g) * 2 + dir) * 128 * 64;
#pragma unroll
        for (int ks = 0; ks < 2; ++ks)
#pragma unroll
            for (int nt = 0; nt < 8; ++nt) { const bf16x8 wf = *(const bf16x8*)(w + (16 * nt + fr) * 64 + 32 * ks + 8 * fq);
#pragma unroll
                for (int m = 0; m < 2; ++m) asm volatile("s_nop 1\n\tv_mfma_f32_16x16x32_bf16 %0, %1, %2, %0" : "+v"(acc[m][nt]) : "v"(wf), "v"(uf[m][ks])); }
        asm volatile("s_nop 15\n\ts_nop 15\n\ts_nop 15\n\ts_nop 15" : "+v"(acc[0][0]), "+v"(acc[0][1]), "+v"(acc[0][2]), "+v"(acc[0][3]), "+v"(acc[0][4]), "+v"(acc[0][5]), "+v"(acc[0][6]), "+v"(acc[0][7]),
                                               "+v"(acc[1][0]), "+v"(acc[1][1]), "+v"(acc[1][2]), "+v"(acc[1][3]), "+v"(acc[1][4]), "+v"(acc[1][5]), "+v"(acc[1][6]), "+v"(acc[1][7]));
#pragma unroll
        for (int m = 0; m < 2; ++m)
#pragma unroll
            for (int nt = 0; nt < 8; ++nt) { const int row = 16 * m + fr + (dir ? 0 : 1);
                unsigned lo = pk2(acc[m][nt][0], acc[m][nt][1]), hi = pk2(acc[m][nt][2], acc[m][nt][3]);
                *(LAS unsigned long long*)(sl + (dir * S5_ROWS + row) * S5_PITCH + (16 * nt + 4 * fq) * 2) = (unsigned long long)lo | ((unsigned long long)hi << 32); }
    }
    asm volatile("s_waitcnt lgkmcnt(0)" ::: "memory");
    {
        const int p = lane;
#pragma unroll
        for (int dir = 0; dir < 2; ++dir) {
            const int ci = ((l * 2 + dir) * 24 + g) * 64 + p;
            const float a4r = c.s5pow()[(size_t)ci * 8], a4i = c.s5pow()[(size_t)ci * 8 + 1];
            const size_t io = ((size_t)(b * NT + ct) * 3072 + dir * 1536 + g * 64 + p) * 2;
            float sr = 0.f, si = 0.f;
            LAS bf16_t* base = (LAS bf16_t*)(sl + dir * S5_ROWS * S5_PITCH);
            if (FINAL) { const float2 cin = *(const float2*)(c.s5in() + io); sr = cin.x; si = cin.y;
                const int crow = dir ? 32 : 0; base[crow * (S5_PITCH / 2) + p] = (bf16_t)f2bf(sr); base[crow * (S5_PITCH / 2) + 64 + p] = (bf16_t)f2bf(si); }
#pragma unroll 8
            for (int q = 0; q < 32; ++q) { const int row = dir ? 31 - q : q + 1;
                const float gr = bf2f(base[row * (S5_PITCH / 2) + p]), gi = bf2f(base[row * (S5_PITCH / 2) + 64 + p]);
                const float nr = a4r * sr - a4i * si + gr, ni = a4r * si + a4i * sr + gi; sr = nr; si = ni;
                if (FINAL) { base[row * (S5_PITCH / 2) + p] = (bf16_t)f2bf(sr); base[row * (S5_PITCH / 2) + 64 + p] = (bf16_t)f2bf(si); } }
            if (!FINAL) { float2 e2; e2.x = sr; e2.y = si; *(float2*)(c.s5e() + io) = e2; }
        }
    }
    if (FINAL) {
        asm volatile("s_waitcnt lgkmcnt(0)" ::: "memory");
        f32x4 ya[4][2];
#pragma unroll
        for (int mj = 0; mj < 4; ++mj)
#pragma unroll
            for (int nt = 0; nt < 2; ++nt) ya[mj][nt] = (f32x4){0.f, 0.f, 0.f, 0.f};
        const bf16_t* ym = c.ymat() + (size_t)(l * 24 + g) * 64 * 320;
#pragma unroll
        for (int ks = 0; ks < 10; ++ks) {
            bf16x8 af[4], bfr[2];
#pragma unroll
            for (int mj = 0; mj < 4; ++mj) af[mj] = *(const bf16x8*)(ym + (16 * mj + fr) * 320 + 32 * ks + 8 * fq);
#pragma unroll
            for (int nt = 0; nt < 2; ++nt) { if (ks < 4) bfr[nt] = *(const LAS bf16x8*)(sl + (16 * nt + fr) * S5_PITCH + (32 * ks + 8 * fq) * 2);
                else if (ks < 8) bfr[nt] = *(const LAS bf16x8*)(sl + (S5_ROWS + 16 * nt + fr + 1) * S5_PITCH + (32 * (ks - 4) + 8 * fq) * 2);
                else bfr[nt] = uf[nt][ks - 8]; }
#pragma unroll
            for (int mj = 0; mj < 4; ++mj)
#pragma unroll
                for (int nt = 0; nt < 2; ++nt) asm volatile("s_nop 1\n\tv_mfma_f32_16x16x32_bf16 %0, %1, %2, %0" : "+v"(ya[mj][nt]) : "v"(af[mj]), "v"(bfr[nt]));
        }
        asm volatile("s_nop 15\n\ts_nop 15\n\ts_nop 15\n\ts_nop 15" : "+v"(ya[0][0]), "+v"(ya[0][1]), "+v"(ya[1][0]), "+v"(ya[1][1]), "+v"(ya[2][0]), "+v"(ya[2][1]), "+v"(ya[3][0]), "+v"(ya[3][1]));
#pragma unroll
        for (int mj = 0; mj < 4; ++mj)
#pragma unroll
            for (int nt = 0; nt < 2; ++nt) { const f32x4 y = ya[mj][nt];
                st_bf16x4(c.v() + (size_t)(t0 + 4 * (16 * nt + fr) + mj) * 384 + 16 * g + 4 * fq, gelu_tanh(y[0]), gelu_tanh(y[1]), gelu_tanh(y[2]), gelu_tanh(y[3])); }
    }
    asm volatile("s_waitcnt lgkmcnt(0)" ::: "memory");
}

#define MFMA16(acc_, a_, b_) asm volatile("s_nop 1\n\tv_mfma_f32_16x16x32_bf16 %0, %1, %2, %0" : "+v"(acc_) : "v"(a_), "v"(b_))
#define MFMA_FENCE8(x_) asm volatile("s_nop 15\n\ts_nop 15" : "+v"(x_[0]), "+v"(x_[1]), "+v"(x_[2]), "+v"(x_[3]), "+v"(x_[4]), "+v"(x_[5]), "+v"(x_[6]), "+v"(x_[7]))
template <class CT>
__device__ __forceinline__ void mixer_tile_dev(const CT& c, const int l, const int tile, LAS unsigned char* lds, const int wave, const int lane) {
    const int tid = wave * 64 + lane, fr = lane & 15, fq = lane >> 4;
    const int b = tile / NT, ct = tile % NT, s0 = ct * LC, t0 = b * SEQ + s0;
    {
        LAS bf16_t* dt = (LAS bf16_t*)lds;
        LAS float* ssqp = (LAS float*)(lds + 67584);
        LAS bf16_t* zp = (LAS bf16_t*)(lds + 71680);
#pragma unroll 1
        for (int g4 = 0; g4 < 4; ++g4) {
            { v4u pz[3];
#pragma unroll
              for (int i = 0; i < 3; ++i) { const int p = tid + 512 * i, q = s0 - 8 + (p >> 3);
                  pz[i] = (p < 1152 && q >= 0 && q < SEQ) ? *(const GAS v4u*)(c.z() + (size_t)(b * SEQ + q) * D_INP + g4 * 64 + (p & 7) * 8) : (v4u){0u, 0u, 0u, 0u}; }
#pragma unroll
              for (int i = 0; i < 3; ++i) { const int p = tid + 512 * i; if (p < 1152) *(LAS v4u*)(zp + (p >> 3) * 72 + (p & 7) * 8) = pz[i]; } }
            __syncthreads();
            { const int cc = tid & 63, tq = tid >> 6, half = 1 << g4, tb = tq * 16, sb = s0 + tb;
              int lo = sb - half < 0 ? 0 : sb - half, hi = sb + half > SEQ ? SEQ : sb + half; float sum = 0.f;
              for (int q = lo; q < hi; ++q) sum += bf2f(zp[(q - s0 + 8) * 72 + cc]);
#pragma unroll 4
              for (int t = tb; t < tb + 16; ++t) { const int s = s0 + t;
                  dt[t * 264 + g4 * 64 + cc] = (bf16_t)f2bf(sum * __builtin_amdgcn_rcpf((float)(hi - lo)) - bf2f(zp[(t + 8) * 72 + cc]));
                  const int nlo = s + 1 - half < 0 ? 0 : s + 1 - half, nhi = s + 1 + half > SEQ ? SEQ : s + 1 + half;
                  if (nhi > hi) sum += bf2f(zp[(hi - s0 + 8) * 72 + cc]);
                  if (nlo > lo) sum -= bf2f(zp[(lo - s0 + 8) * 72 + cc]);
                  lo = nlo; hi = nhi; } }
            __syncthreads();
        }
        const int g = wave >> 1, nbase = (wave & 1) * 32;
        f32x4 acc0[8], acc1[8];
#pragma unroll
        for (int m = 0; m < 8; ++m) { acc0[m] = (f32x4){0.f, 0.f, 0.f, 0.f}; acc1[m] = (f32x4){0.f, 0.f, 0.f, 0.f}; }
#pragma unroll
        for (int ks = 0; ks < 2; ++ks) {
            const bf16x8 w0 = *(const bf16x8*)(c.poolw_t() + ((size_t)(l * 4 + g) * 64 + nbase + fr) * 64 + 32 * ks + 8 * fq);
            const bf16x8 w1 = *(const bf16x8*)(c.poolw_t() + ((size_t)(l * 4 + g) * 64 + nbase + 16 + fr) * 64 + 32 * ks + 8 * fq);
#pragma unroll
            for (int m = 0; m < 8; ++m) { const bf16x8 df = *(const LAS bf16x8*)(lds + (16 * m + fr) * 528 + (g * 64 + 32 * ks + 8 * fq) * 2);
                MFMA16(acc0[m], w0, df); MFMA16(acc1[m], w1, df); } }
        MFMA_FENCE8(acc0); MFMA_FENCE8(acc1);
        const int ch0 = g * 64 + nbase + 4 * fq;
        const f32x4 sc0 = *(const f32x4*)(c.in[I_POOLS] + l * 256 + ch0), sc1 = *(const f32x4*)(c.in[I_POOLS] + l * 256 + ch0 + 16);
#pragma unroll
        for (int m = 0; m < 8; ++m) { acc0[m] = acc0[m] * sc0; acc1[m] = acc1[m] * sc1;
            float s = acc0[m][0] * acc0[m][0] + acc0[m][1] * acc0[m][1] + acc0[m][2] * acc0[m][2] + acc0[m][3] * acc0[m][3] + acc1[m][0] * acc1[m][0] + acc1[m][1] * acc1[m][1] + acc1[m][2] * acc1[m][2] + acc1[m][3] * acc1[m][3];
            s += __shfl_xor(s, 16); s += __shfl_xor(s, 32);
            if (fq == 0) ssqp[(16 * m + fr) * 8 + wave] = s; }
        __syncthreads();
#pragma unroll
        for (int m = 0; m < 8; ++m) { const f32x4 pa = *(const LAS f32x4*)(ssqp + (16 * m + fr) * 8), pb = *(const LAS f32x4*)(ssqp + (16 * m + fr) * 8 + 4);
            const float rstd = 1.f / sqrtf(((pa[0] + pa[1]) + (pa[2] + pa[3]) + (pb[0] + pb[1]) + (pb[2] + pb[3])) * (1.f / 256) + EPS);
            bf16_t* orow = c.o() + (size_t)(t0 + 16 * m + fr) * D + ch0;
            st_bf16x4(orow, acc0[m][0] * rstd, acc0[m][1] * rstd, acc0[m][2] * rstd, acc0[m][3] * rstd);
            st_bf16x4(orow + 16, acc1[m][0] * rstd, acc1[m][1] * rstd, acc1[m][2] * rstd, acc1[m][3] * rstd); }
        __syncthreads();
    }
    LAS bf16_t* xcs = (LAS bf16_t*)lds;
    LAS float* As = (LAS float*)(lds + 18432);
    LAS bf16_t* Bs = (LAS bf16_t*)(lds + 88064);
    LAS float* Seg = (LAS float*)(lds + 124928);
    bf16_t tz[17];
#define LRU_SLAB_LOAD(h_) do { int tq_ = tid; asm volatile("" : "+v"(tq_)); _Pragma("unroll") for (int i_ = 0; i_ < 17; ++i_) { const int e2_ = tq_ + 512 * i_, q_ = s0 - 1 + (e2_ >> 6); \
        tz[i_] = ((i_ < 16 || e2_ < 131 * 64) && q_ >= 0 && q_ < SEQ) ? c.z()[(size_t)(b * SEQ + q_) * D_INP + 640 + (h_) * 64 + (e2_ & 63)] : (bf16_t)0; } } while (0)
    LRU_SLAB_LOAD(0);
#pragma unroll 1
    for (int h = 0; h < 6; ++h) {
        int cc; float cb, w0, w1, w2, w3; bf16x8 gwa[2], gwx[2]; f32x4 gba, gbx, glam;
        { LAS bf16_t* zs = (LAS bf16_t*)As;
          { int tq = tid; asm volatile("" : "+v"(tq));
            cc = tq & 63; { const int ch = h * 64 + cc; const float* cwp = c.in[I_CONVW] + l * 4 * 384 + ch; cb = c.in[I_CONVB][l * 384 + ch]; w0 = cwp[0]; w1 = cwp[384]; w2 = cwp[768]; w3 = cwp[1152]; }
            { const bf16_t* wbase = c.lruw_t() + ((size_t)(((l * 2 + (wave >> 2)) * 6 + h) * 2) * 64 + (wave & 3) * 16 + (tq & 15)) * 64 + 8 * ((tq >> 4) & 3);
#pragma unroll
              for (int ks = 0; ks < 2; ++ks) { gwa[ks] = *(const bf16x8*)(wbase + 32 * ks); gwx[ks] = *(const bf16x8*)(wbase + 4096 + 32 * ks); }
              const int pi = (l * 2 + (wave >> 2)) * 384 + h * 64 + (wave & 3) * 16 + 4 * ((tq >> 4) & 3);
              gba = *(const f32x4*)(c.in[I_BA] + pi); gbx = *(const f32x4*)(c.in[I_BX] + pi); glam = *(const f32x4*)((const float*)c.ctl() + SP8_OFF / 4 + pi); }
#pragma unroll
            for (int i = 0; i < 17; ++i) { const int e2 = tq + 512 * i; if (i < 16 || e2 < 131 * 64) zs[(e2 >> 6) * 72 + (e2 & 63)] = tz[i]; } }
          __syncthreads();
#pragma unroll 4
          for (int i = 0; i < 16; ++i) { const int t = (tid >> 6) + 8 * i;
              const float a = cb + w0 * bf2f(zs[t * 72 + cc]) + w1 * bf2f(zs[(t + 1) * 72 + cc]) + w2 * bf2f(zs[(t + 2) * 72 + cc]) + w3 * bf2f(zs[(t + 3) * 72 + cc]);
              xcs[t * 72 + cc] = (bf16_t)f2bf(a); } }
        if (h < 5) LRU_SLAB_LOAD(h + 1);
        __syncthreads();
        {
            const int dir = wave >> 2, c16 = (wave & 3) * 16;
            f32x4 accA[8], accX[8];
#pragma unroll
            for (int m = 0; m < 8; ++m) { accA[m] = (f32x4){0.f, 0.f, 0.f, 0.f}; accX[m] = (f32x4){0.f, 0.f, 0.f, 0.f}; }
#pragma unroll
            for (int ks = 0; ks < 2; ++ks) { const bf16x8 wa = gwa[ks], wx = gwx[ks];
#pragma unroll
                for (int m = 0; m < 8; ++m) { const bf16x8 xf = *(const LAS bf16x8*)(lds + (16 * m + fr) * 144 + (32 * ks + 8 * fq) * 2);
                    MFMA16(accA[m], wa, xf); MFMA16(accX[m], wx, xf); } }
            MFMA_FENCE8(accA); MFMA_FENCE8(accX);
            const int cc0 = c16 + 4 * fq;
            const f32x4 ba = gba, bx = gbx, lam = glam;
            f32x4 sp8;
#pragma unroll
            for (int j = 0; j < 4; ++j) sp8[j] = lam[j];
#pragma unroll
            for (int m = 0; m < 8; ++m) { const int t = 16 * m + fr;
                const unsigned long long xw = *(const LAS unsigned long long*)(lds + t * 144 + cc0 * 2);
                f32x4 av; float btv[4];
#pragma unroll
                for (int j = 0; j < 4; ++j) { const float xcv = bf2f((unsigned)(xw >> (16 * j)) & 0xffffu);
                    const float r = sigmoid_fast(accA[m][j] + ba[j]), ig = sigmoid_fast(accX[m][j] + bx[j]), la = r * sp8[j];
                    av[j] = __builtin_amdgcn_exp2f(1.4426950408889634f * la); btv[j] = __builtin_amdgcn_sqrtf(-expm1_dev(2.f * la, av[j])) * (ig * xcv); }
                *(LAS f32x4*)(As + (dir * 128 + t) * 68 + cc0) = av;
                *(LAS unsigned long long*)(Bs + (dir * 128 + t) * 72 + cc0) = (unsigned long long)pk2(btv[0], btv[1]) | ((unsigned long long)pk2(btv[2], btv[3]) << 32); }
        }
        __syncthreads();
        {
            const int dir = tid >> 8, seg = (tid >> 6) & 3, cc = tid & 63, ch = h * 64 + cc;
            const int tfirst = dir ? 127 - seg * 32 : seg * 32, tstep = dir ? -1 : 1;
            const LAS float* ap = As + (dir * 128 + tfirst) * 68 + cc; const LAS bf16_t* bp = Bs + (dir * 128 + tfirst) * 72 + cc;
            float hh = 0.f, P = 1.f;
#pragma unroll 8
            for (int q = 0; q < 32; ++q) { const float a = ap[q * tstep * 68], bt = bf2f(bp[q * tstep * 72]); hh = a * hh + bt; P *= a; }
            Seg[((dir * 64 + cc) * 4 + seg) * 2] = P; Seg[((dir * 64 + cc) * 4 + seg) * 2 + 1] = hh;
            __syncthreads();
            float carry = 0.f, cpre = 1.f;
#pragma unroll
            for (int s2 = 0; s2 < 3; ++s2) if (s2 < seg) { const float P2 = Seg[((dir * 64 + cc) * 4 + s2) * 2], h2 = Seg[((dir * 64 + cc) * 4 + s2) * 2 + 1]; carry = P2 * carry + h2; cpre *= P2; }
            bf16_t* hp = c.hl() + ((size_t)(t0 + tfirst) * 2 + dir) * 384 + ch; bf16_t* cpp = c.cp() + ((size_t)(t0 + tfirst) * 2 + dir) * 384 + ch;
            hh = carry; P = cpre;
#pragma unroll 4
            for (int q = 0; q < 32; ++q) { const float a = ap[q * tstep * 68], bt = bf2f(bp[q * tstep * 72]); hh = a * hh + bt; P *= a;
                hp[(long)q * tstep * 768] = (bf16_t)f2bf(hh); cpp[(long)q * tstep * 768] = (bf16_t)f2bf(P); }
            if (seg == 3) { float2 pe; pe.x = P; pe.y = hh; *(float2*)(c.lrupe() + ((size_t)(b * NT + ct) * 768 + dir * 384 + ch) * 2) = pe; }
        }
        __syncthreads();
    }
}

template <class CT>
__device__ __forceinline__ void row_mix_norm2_dev(const CT& c, const int t, const int lane) {
    bf16_t* orow = c.o() + (size_t)t * D;
    { const unsigned* yb = (const unsigned*)(c.yb() + (size_t)t * 384); unsigned w[3]; float ss = 0.f;
#pragma unroll
      for (int i = 0; i < 3; ++i) { w[i] = yb[lane + 64 * i]; const float a = bf2f(w[i] & 0xffffu), b2 = bf2f(w[i] >> 16); ss += a * a + b2 * b2; }
      const float rstd = 1.f / sqrtf(wsum(ss) * (1.f / 384) + EPS);
#pragma unroll
      for (int i = 0; i < 3; ++i) ((unsigned*)(orow + 256))[lane + 64 * i] = pk2(bf2f(w[i] & 0xffffu) * rstd, bf2f(w[i] >> 16) * rstd); }
    { const unsigned* hl = (const unsigned*)(c.hl() + (size_t)t * 768); const unsigned* cp = (const unsigned*)(c.cp() + (size_t)t * 768); const unsigned* gz = (const unsigned*)(c.z() + (size_t)t * D_INP + 1024);
      const float2* cin = (const float2*)(c.lruin() + (size_t)((t / SEQ) * NT + (t % SEQ) / LC) * 768);
      float y0[3], y1[3]; float ss = 0.f;
#pragma unroll
      for (int i = 0; i < 3; ++i) { const int k2 = lane + 64 * i; const unsigned hf = hl[k2], hb2 = hl[192 + k2], cf = cp[k2], cb2 = cp[192 + k2], gg = gz[k2]; const float2 nf = cin[k2], nb = cin[192 + k2];
          y0[i] = (bf2f(hf & 0xffffu) + bf2f(cf & 0xffffu) * nf.x + bf2f(hb2 & 0xffffu) + bf2f(cb2 & 0xffffu) * nb.x) * gelu_tanh(bf2f(gg & 0xffffu));
          y1[i] = (bf2f(hf >> 16) + bf2f(cf >> 16) * nf.y + bf2f(hb2 >> 16) + bf2f(cb2 >> 16) * nb.y) * gelu_tanh(bf2f(gg >> 16)); ss += y0[i] * y0[i] + y1[i] * y1[i]; }
      const float rstd = 1.f / sqrtf(wsum(ss) * (1.f / 384) + EPS);
#pragma unroll
      for (int i = 0; i < 3; ++i) ((unsigned*)(orow + 640))[lane + 64 * i] = pk2(y0[i] * rstd, y1[i] * rstd); }
}
template <class CT>
__device__ __forceinline__ void row_combine_dev(const CT& c, const int t, const int lane, const bool last, const bool dummy = false) {
    bf16_t* xr = (bf16_t*)c.X() + (size_t)t * D; float ss = 0.f; bf16_t* xw = dummy ? (bf16_t*)c.out + (size_t)t * D : xr; bf16_t* hbw = dummy ? c.o() : c.hb();
    const int d0 = c.tkd()[t * 4], d1 = c.tkd()[t * 4 + 1], d2 = c.tkd()[t * 4 + 2], d3 = c.tkd()[t * 4 + 3];
    const bf16_t* y0 = c.yexp() + (size_t)d0 * 1024; const bf16_t* y1 = c.yexp() + (size_t)d1 * 1024; const bf16_t* y2 = c.yexp() + (size_t)d2 * 1024; const bf16_t* y3 = c.yexp() + (size_t)d3 * 1024;
    f32x4 v[4];
#pragma unroll
    for (int j = 0; j < 4; ++j) { const int k = 4 * lane + 256 * j; { const uint2 xw_ = *(const uint2*)(xr + k);
            v[j] = (f32x4){__builtin_bit_cast(float, xw_.x << 16), __builtin_bit_cast(float, xw_.x & 0xffff0000u), __builtin_bit_cast(float, xw_.y << 16), __builtin_bit_cast(float, xw_.y & 0xffff0000u)}; }
        const uint2 a = *(const uint2*)(y0 + k), b2 = *(const uint2*)(y1 + k), c2 = *(const uint2*)(y2 + k), e2 = *(const uint2*)(y3 + k);
        v[j][0] += bf2f(a.x & 0xffffu); v[j][0] += bf2f(b2.x & 0xffffu); v[j][0] += bf2f(c2.x & 0xffffu); v[j][0] += bf2f(e2.x & 0xffffu);
        v[j][1] += bf2f(a.x >> 16); v[j][1] += bf2f(b2.x >> 16); v[j][1] += bf2f(c2.x >> 16); v[j][1] += bf2f(e2.x >> 16);
        v[j][2] += bf2f(a.y & 0xffffu); v[j][2] += bf2f(b2.y & 0xffffu); v[j][2] += bf2f(c2.y & 0xffffu); v[j][2] += bf2f(e2.y & 0xffffu);
        v[j][3] += bf2f(a.y >> 16); v[j][3] += bf2f(b2.y >> 16); v[j][3] += bf2f(c2.y >> 16); v[j][3] += bf2f(e2.y >> 16);
        ss += v[j][0] * v[j][0] + v[j][1] * v[j][1] + v[j][2] * v[j][2] + v[j][3] * v[j][3]; }
    const float rstd = 1.f / sqrtf(wsum(ss) * (1.f / D) + EPS);
    if (!last) {
#pragma unroll
        for (int j = 0; j < 4; ++j) { const int k = 4 * lane + 256 * j; { uint2 xo; xo.x = pk2(v[j][0], v[j][1]); xo.y = pk2(v[j][2], v[j][3]); *(uint2*)(xw + k) = xo; } uint2 o; o.x = pk2(v[j][0] * rstd, v[j][1] * rstd); o.y = pk2(v[j][2] * rstd, v[j][3] * rstd); *(uint2*)(hbw + (size_t)t * D + k) = o; }
    } else { const float* fg = c.in[I_FING];
#pragma unroll
        for (int j = 0; j < 4; ++j) { const int k = 4 * lane + 256 * j; const f32x4 g = *(const f32x4*)(fg + k); *(f32x4*)((float*)c.out + (size_t)t * D + k) = v[j] * rstd * g; } }
}

constexpr int NPL = 12, NPH = 1 + DEPTH * NPL;
struct Args { const float* in[32]; float* out; unsigned char* ws; int ph_lo, ph_hi; };

__device__ __forceinline__ void st_route_dev(long gtid, long gs, const Ctx& c, int l, LAS int* pre, int tid) {
    LAS int* cn = pre + 64;
    const unsigned* cnt = c.ctl() + CW_CNT + 32 * l * CNT_STRIDE;
    if (tid < NE) cn[tid] = (int)cnt[tid * CNT_STRIDE];
    __syncthreads();
    if (tid == 0) { int s = 0; for (int q = 0; q < NE; ++q) { pre[q] = s; s += (cn[q] + 255) & ~255; } pre[NE] = s; }
    __syncthreads();
    for (long i = gtid; i < (long)T * 4; i += gs) { const int e = c.tke()[i]; const int d = pre[e] + c.tkp()[i];
        c.tkd()[i] = d; c.rowtok()[d] = (int)(i / 4); c.rowgate()[d] = c.tkg()[i]; }
    const int total = pre[NE];
    for (long r = gtid; r < total; r += gs) { int e = 0;
#pragma unroll
        for (int s2 = 16; s2 > 0; s2 >>= 1) e += (pre[e + s2] <= (int)r) ? s2 : 0;
        if ((int)r - pre[e] >= cn[e]) { c.rowtok()[r] = 0; c.rowgate()[r] = 0.f; }
        if ((r & 255) == 0) c.blke()[r >> 8] = e; }
    if (gtid == 0) c.ctl()[CW_NMB + l] = (unsigned)(total / 256);
}
__device__ __forceinline__ void st_carries_dev(long gtid, long gs, const Ctx& c, int l) {
    constexpr int CB = 16;
    const long tl = gtid % (NWAVES * 64), bx = gtid / (NWAVES * 64), Gn = gs / (NWAVES * 64), first = (tl & 63) + 64 * (bx + Gn * (tl >> 6)), step = 64 * Gn * NWAVES;
    for (long i = first; i < (long)BATCH * 3072; i += step) { const int r = (int)(i % 3072), b = (int)(i / 3072), dir = r / 1536; const int ci = l * 3072 + r;
        const float2 a = *(const float2*)(c.s5a128() + 2 * ci); float sr = 0.f, si = 0.f;
        const float* eb = c.s5e() + ((size_t)(b * NT) * 3072 + r) * 2; float* ib = c.s5in() + ((size_t)(b * NT) * 3072 + r) * 2;
#pragma unroll 1
        for (int q0 = 0; q0 < NT; q0 += CB) { float2 e[CB];
#pragma unroll
            for (int q = 0; q < CB; ++q) { const int ct = dir == 0 ? q0 + q : NT - 1 - q0 - q; e[q] = *(const float2*)(eb + (size_t)ct * 6144); }
#pragma unroll
            for (int q = 0; q < CB; ++q) { const int ct = dir == 0 ? q0 + q : NT - 1 - q0 - q; float2 s2; s2.x = sr; s2.y = si; *(float2*)(ib + (size_t)ct * 6144) = s2;
                const float nr = a.x * sr - a.y * si + e[q].x, ni = a.x * si + a.y * sr + e[q].y; sr = nr; si = ni; } } }
    for (long i = first; i < (long)BATCH * 768; i += step) { const int r = (int)(i % 768), b = (int)(i / 768), dir = r / 384; float h = 0.f;
        const float* pb = c.lrupe() + 2 * ((size_t)(b * NT) * 768 + r); float* hb_ = c.lruin() + (size_t)(b * NT) * 768 + r;
#pragma unroll 1
        for (int q0 = 0; q0 < NT; q0 += CB) { float2 pe[CB];
#pragma unroll
            for (int q = 0; q < CB; ++q) { const int ct = dir == 0 ? q0 + q : NT - 1 - q0 - q; pe[q] = *(const float2*)(pb + (size_t)ct * 1536); }
#pragma unroll
            for (int q = 0; q < CB; ++q) { const int ct = dir == 0 ? q0 + q : NT - 1 - q0 - q; hb_[(size_t)ct * 768] = h; h = pe[q].x * h + pe[q].y; } } }
}
template <class Tp> __device__ __forceinline__ Tp* uniform_ptr(Tp* p) { const unsigned long long v = (unsigned long long)p;
    return (Tp*)(((unsigned long long)(unsigned)__builtin_amdgcn_readfirstlane((int)(v >> 32)) << 32) | (unsigned)__builtin_amdgcn_readfirstlane((int)v)); }
template <int PH>
__device__ __forceinline__ void run_phase(const Ctx& c0, LAS unsigned char* lds, const int wave, const int G) {
    int lane_o = (int)__builtin_amdgcn_mbcnt_hi(~0u, __builtin_amdgcn_mbcnt_lo(~0u, 0u)); asm volatile("" : "+v"(lane_o));
    const int lane = lane_o, tid_o = wave * 64 + lane_o; const long gtid = (long)blockIdx.x * (NWAVES * 64) + tid_o, gs = (long)G * (NWAVES * 64);
    const int gw = blockIdx.x * NWAVES + wave, NGW = G * NWAVES;
    Ctx c = c0; { unsigned long long a_ = (unsigned long long)c0.ws, b_ = (unsigned long long)c0.out, d_ = (unsigned long long)c0.in; asm volatile("" : "+s"(a_), "+s"(b_), "+s"(d_));
        c.ws = (unsigned char*)a_; c.out = (float*)b_; c.in = (const float* const*)d_; }
#ifndef GSEL
#define GSEL 0x1Fu
#endif
    const CtxG cg(c);
    if constexpr (PH == 0) {
        LAS float* scr = (LAS float*)(lds + wave * 16640);
        constexpr int I_IN = 16 * 22, I_GLU = 6 * 12, I_OUT = 16 * 16, I_GU = 16 * 32, I_DN = 16 * 16;
        constexpr int NITEMS = 2 * (I_IN + I_GLU + I_OUT) + 64 * (I_GU + I_DN);
        for (int it = gw; it < NITEMS; it += NGW) { int r = it;
            if (r < 2 * I_IN) { const int l = r / I_IN; transpose_item(c.in[I_WIN] + (size_t)l * D * D_IN, D, D_IN, c.win_t() + (size_t)l * D_INP * D, 0, c.in[I_N1G] + l * D, scr, r % I_IN, lane); continue; } r -= 2 * I_IN;
            if (r < 2 * I_GLU) { const int l = r / I_GLU; transpose_item(c.in[I_WGLU] + (size_t)l * 384 * 768, 384, 768, c.wglu_t() + (size_t)l * 768 * 384, 1, nullptr, scr, r % I_GLU, lane); continue; } r -= 2 * I_GLU;
            if (r < 2 * I_OUT) { const int l = r / I_OUT; transpose_item(c.in[I_WOUT] + (size_t)l * D * D, D, D, c.wout_t() + (size_t)l * D * D, 0, c.in[I_MIXG] + l * D, scr, r % I_OUT, lane); continue; } r -= 2 * I_OUT;
            if (r < 64 * I_GU) { const int le = r / I_GU; transpose_item8(c.in[I_WGU] + (size_t)le * 1024 * 2048, 1024, 2048, c.wgu8() + (size_t)le * 2048 * 1024, c.in[I_N2G] + (le / 32) * D, scr, r % I_GU, lane); continue; } r -= 64 * I_GU;
            { const int le = r / I_DN; transpose_item8(c.in[I_WDN] + (size_t)le * 1024 * 1024, 1024, 1024, c.wdn8() + (size_t)le * 1024 * 1024, nullptr, scr, r % I_DN, lane); }
        }
        st_prep_small(gtid, gs, c); st_prep_mixw(gtid, gs, c);
        for (int t = gw; t < T; t += NGW) row_norm_bf16(c.in[I_X] + (size_t)t * D, c.hb() + (size_t)t * D, lane);
    } else {
        constexpr int l = (PH - 1) / NPL, q = (PH - 1) % NPL;
        if constexpr (q == 0) {
            if constexpr (l == 0) st_prep_s5mat(gtid, gs, c);
            pg8::SchedPlain S; S.so.init(T / 256, D_INP / 256, G, blockIdx.x); S.Bt = (const char*)(c.win_t() + (size_t)l * D_INP * D); S.tstepB = (size_t)256 * D * 2; S.rowtab = nullptr;
            EpiInW E{c.z()}; pg8::gemm_phase<EpiInW, pg8::SchedPlain, false, false, true>(lds, wave, c.hb(), D, S, E);
        } else if constexpr (q == 1) {
            for (int tile = blockIdx.x; tile < BATCH * NT; tile += G) { if constexpr ((GSEL & 1u) != 0) mixer_tile_dev(cg, l, tile, lds, wave, lane); else mixer_tile_dev(c, l, tile, lds, wave, lane); }
            for (int it = gw; it < BATCH * NT * 24; it += NGW) { if constexpr ((GSEL & 2u) != 0) s5_tile_dev<false>(cg, l, it / 24, it % 24, lds + wave * S5_LDS_WAVE, lane); else s5_tile_dev<false>(c, l, it / 24, it % 24, lds + wave * S5_LDS_WAVE, lane); }
        } else if constexpr (q == 2) { st_carries_dev(gtid, gs, c, l);
        } else if constexpr (q == 3) {
            for (int it = gw; it < BATCH * NT * 24; it += NGW) { if constexpr ((GSEL & 2u) != 0) s5_tile_dev<true>(cg, l, it / 24, it % 24, lds + wave * S5_LDS_WAVE, lane); else s5_tile_dev<true>(c, l, it / 24, it % 24, lds + wave * S5_LDS_WAVE, lane); }
        } else if constexpr (q == 4) {
            pg8::SchedPlain S; S.so.init(T / 256, 3, G, blockIdx.x); S.Bt = (const char*)(c.wglu_t() + (size_t)l * 768 * 384); S.tstepB = (size_t)256 * 384 * 2; S.rowtab = nullptr;
            EpiGluW E{c.yb(), uniform_ptr(c.in[I_BGLU]) + l * 768}; pg8::gemm_phase<EpiGluW, pg8::SchedPlain, false, false, true>(lds, wave, c.v(), 384, S, E);
        } else if constexpr (q == 5) { for (int t = gw; t < T; t += NGW) { if constexpr ((GSEL & 4u) != 0) row_mix_norm2_dev(cg, t, lane); else row_mix_norm2_dev(c, t, lane); }
        } else if constexpr (q == 6) {
            pg8::SchedPlain S; S.so.init(T / 256, 4, G, blockIdx.x); S.Bt = (const char*)(c.wout_t() + (size_t)l * D * D); S.tstepB = (size_t)256 * D * 2; S.rowtab = nullptr;
            EpiOutW<l == 0> E{l == 0 ? (const void*)uniform_ptr(c.in[I_X]) : (const void*)c.X(), (bf16_t*)c.X()}; pg8::gemm_phase<EpiOutW<l == 0>, pg8::SchedPlain, false, false, true>(lds, wave, c.o(), D, S, E);
        } else if constexpr (q == 7) {
            static_assert(T % (NWAVES * RB * 4) == 0, "router: 128 rows per workgroup pass");
            LAS int* park = (LAS int*)lds;
            LAS int* hist = (LAS int*)(lds + 2048);
            for (int tb = blockIdx.x * 128; tb < T; tb += G * 128) {
                if (tid_o < 64) hist[tid_o] = 0;
                LAS float* lgs = (LAS float*)(lds + 4096 + wave * 2048);
                router_logits16(cg, l, tb + wave * 16, lane, lgs);
#pragma unroll 1
                for (int i = 0; i < 4; ++i) { if constexpr ((GSEL & 16u) != 0) router_rows(cg, l, tb + wave * 16 + i * RB, lane, park + wave * 64 + i * RB * 4, lgs + i * RB * 32); else router_rows(c, l, tb + wave * 16 + i * RB, lane, park + wave * 64 + i * RB * 4, lgs + i * RB * 32); }
                __syncthreads();
                const int ex_ = park[tid_o]; const int rank = __hip_atomic_fetch_add(hist + ex_, 1, __ATOMIC_RELAXED, __HIP_MEMORY_SCOPE_WORKGROUP);
                __syncthreads();
                if (tid_o < 32) hist[32 + tid_o] = (int)atomicAdd(c.ctl() + CW_CNT + (32 * l + tid_o) * CNT_STRIDE, (unsigned)hist[tid_o]);
                __syncthreads();
                c.tkp()[tb * 4 + tid_o] = hist[32 + ex_] + rank;
                __syncthreads(); }
        } else if constexpr (q == 8) { st_route_dev(gtid, gs, c, l, (LAS int*)lds, tid_o);
        } else if constexpr (q == 9) {
            const int nmb = (int)c.ctl()[CW_NMB + l];
            pg8::SchedMoe S; S.so.init(nmb, 8, G, blockIdx.x); S.Bt = (const char*)(c.wgu8() + (size_t)l * NE * 2048 * 1024); S.tstepB = (size_t)256 * 1024; S.estride = (size_t)2048 * 1024; S.rowtab = c.rowtok(); S.blke = c.blke();
            { LAS int* ue = (LAS int*)(lds + pg8::STAGE_BYTES + 4096); if (tid_o < 32) { Unit u_; ue[tid_o] = S.so.next(tid_o, u_) ? c.blke()[u_.pm] : 0; } __syncthreads(); S.ue = ue; }
            EpiMoe1F8 E{c.act8(), uniform_ptr(c.in[I_BGU]) + (size_t)l * NE * 2048}; pg8::gemm_phase<EpiMoe1F8, pg8::SchedMoe, true, true, true>(lds, wave, (const bf16_t*)c.hq(), 512, S, E);
#ifdef PROBE_MOENULL
            { __syncthreads(); EpiNullW E2; pg8::gemm_phase<EpiNullW, pg8::SchedMoe, true, true, true>(lds, wave, (const bf16_t*)c.hq(), 512, S, E2); }
#endif
        } else if constexpr (q == 10) {
            const int nmb = (int)c.ctl()[CW_NMB + l];
            pg8::SchedMoe S; S.so.init(nmb, 4, G, blockIdx.x); S.Bt = (const char*)(c.wdn8() + (size_t)l * NE * 1024 * 1024); S.tstepB = (size_t)256 * 1024; S.estride = (size_t)1024 * 1024; S.rowtab = nullptr; S.blke = c.blke();
            { LAS int* ue = (LAS int*)(lds + pg8::STAGE_BYTES + 4096); if (tid_o < 32) { Unit u_; ue[tid_o] = S.so.next(tid_o, u_) ? c.blke()[u_.pm] : 0; } __syncthreads(); S.ue = ue; }
            EpiMoe2F8 E{c.yexp(), uniform_ptr(c.in[I_BDN]) + (size_t)l * NE * 1024, c.rowgate()}; pg8::gemm_phase<EpiMoe2F8, pg8::SchedMoe, false, true, true>(lds, wave, (const bf16_t*)c.act8(), 512, S, E);
#ifdef PROBE_MOENULL
            { __syncthreads(); EpiNullW E2; pg8::gemm_phase<EpiNullW, pg8::SchedMoe, false, true, true>(lds, wave, (const bf16_t*)c.act8(), 512, S, E2); }
#endif
        } else {
#ifdef PROBE_COMBINE
            if (l == 0) { for (int t = gw; t < T; t += NGW) row_combine_dev(c, t, lane, false, true); __syncthreads(); }
#endif
            for (int t = gw; t < T; t += NGW) { if constexpr ((GSEL & 8u) != 0) row_combine_dev(cg, t, lane, l == DEPTH - 1); else row_combine_dev(c, t, lane, l == DEPTH - 1); } }
    }
}
template <int PH>
__device__ __forceinline__ void run_from(const Ctx& c0, LAS unsigned char* lds, const int wave, const int G, const int lo, const int hi, const XcdBarrier& bar) {
    if (lo <= PH && PH < hi) {
        run_phase<PH>(c0, lds, wave, G);
#ifdef PROBE_REP
        if constexpr (((PROBE_REP >> (PH == 0 ? 0 : 1 + (PH - 1) % NPL)) & 1u) != 0) { __syncthreads(); run_phase<PH>(c0, lds, wave, G); }
#endif
        if (PH + 1 < hi) { const int lane = (int)__builtin_amdgcn_mbcnt_hi(~0u, __builtin_amdgcn_mbcnt_lo(~0u, 0u)); xcd_barrier(bar, wave == 0 && lane == 0); }
    }
    if constexpr (PH + 1 < NPH) run_from<PH + 1>(c0, lds, wave, G, lo, hi, bar);
}

__global__ void __launch_bounds__(NWAVES * 64, 2) mk_fwd(Args args) {
    extern __shared__ __attribute__((aligned(16))) unsigned char lds_raw[];
    LAS unsigned char* lds = (LAS unsigned char*)lds_raw;
    const int tid = threadIdx.x, wave = __builtin_amdgcn_readfirstlane(tid >> 6), G = gridDim.x;
    LAS unsigned long long* ptab = (LAS unsigned long long*)(lds + LDSCTL_OFF + 1024);
    volatile LAS unsigned* MISC = (volatile LAS unsigned*)(lds + LDSCTL_OFF);
    for (int u = tid; u < 256; u += NWAVES * 64) ((LAS unsigned*)(lds + LDSCTL_OFF))[u] = 0u;
    if (tid < 32) ptab[tid] = (unsigned long long)args.in[tid];
    if (tid == 32) ptab[32] = (unsigned long long)args.out;
    if (tid == 33) ptab[33] = (unsigned long long)args.ws;
    __syncthreads();
    Ctx c0; c0.in = (const float* const*)(const void*)(lds_raw + LDSCTL_OFF + 1024);
    { unsigned long long o = ptab[32], w = ptab[33];
      c0.out = (float*)(((unsigned long long)(unsigned)__builtin_amdgcn_readfirstlane((int)(o >> 32)) << 32) | (unsigned)__builtin_amdgcn_readfirstlane((int)o));
      c0.ws = (unsigned char*)(((unsigned long long)(unsigned)__builtin_amdgcn_readfirstlane((int)(w >> 32)) << 32) | (unsigned)__builtin_amdgcn_readfirstlane((int)w)); }
    XcdBarrier bar; bar.bar = (unsigned*)(args.ws + WS_CTL) + CW_BAR; bar.x = 0; bar.st = nullptr;
    if (args.ph_hi - args.ph_lo > 1) bar = xcd_barrier_post((unsigned*)(args.ws + WS_CTL) + CW_BAR, MISC + 8);
    run_from<0>(c0, lds, wave, G, args.ph_lo, args.ph_hi, bar);
}

extern "C" void kernel_launch(void* const* d_in, const int* in_sizes, int n_in, void* d_out, int out_size, void* d_ws, size_t ws_size, hipStream_t stream) {
    static int grid = 0;
    if (grid == 0) {
        if (n_in != 32 || in_sizes[0] != T * D || out_size != T * D || ws_size < WS_END) { fprintf(stderr, "kernel_launch: unexpected shapes (n_in %d in0 %d out %d ws %zu need %zu)\n", n_in, n_in > 0 ? in_sizes[0] : -1, out_size, ws_size, (size_t)WS_END); grid = -1; return; }
        int dev = 0, cus = 0, per_cu = 0;
        if (hipGetDevice(&dev) != hipSuccess || hipDeviceGetAttribute(&cus, hipDeviceAttributeMultiprocessorCount, dev) != hipSuccess) { grid = -1; return; }
        if (hipFuncSetAttribute((const void*)mk_fwd, hipFuncAttributeMaxDynamicSharedMemorySize, LDS_BYTES) != hipSuccess) { fprintf(stderr, "kernel_launch: hipFuncSetAttribute failed\n"); grid = -1; return; }
        if (hipOccupancyMaxActiveBlocksPerMultiprocessor(&per_cu, (const void*)mk_fwd, NWAVES * 64, LDS_BYTES) != hipSuccess || per_cu < 1) { fprintf(stderr, "kernel_launch: occupancy query reports %d blocks per CU\n", per_cu); per_cu = 1; }
        (void)hipGetLastError();
        grid = cus;
    }
    if (grid < 0) return;
    (void)hipMemsetAsync((char*)d_ws + WS_CTL, 0, CTL_BYTES, stream);
    Args a; memset(&a, 0, sizeof(a));
    for (int i = 0; i < 32; ++i) a.in[i] = (const float*)d_in[i];
    a.out = (float*)d_out; a.ws = (unsigned char*)d_ws;
#if MK_PER_PHASE
    for (int ph = 0; ph < NPH; ++ph) { a.ph_lo = ph; a.ph_hi = ph + 1; hipLaunchKernelGGL(mk_fwd, dim3(grid), dim3(NWAVES * 64), LDS_BYTES, stream, a); }
#else
    a.ph_lo = 0; a.ph_hi = NPH;
    void* kargs[] = {&a};
    hipError_t e = hipLaunchCooperativeKernel((const void*)mk_fwd, dim3(grid), dim3(NWAVES * 64), kargs, LDS_BYTES, stream);
    if (e != hipSuccess) fprintf(stderr, "kernel_launch: cooperative launch failed: %s\n", hipGetErrorString(e));
#endif
}
#endif
```

```cpp
#ifndef HOST_TEST
#include <hip/hip_runtime.h>
#endif
#include <cstdio>
#include <cstdint>
#include <cstring>
#include <cmath>

#ifndef CFG_B
#define CFG_B 4
#endif
#ifndef CFG_S
#define CFG_S 8192
#endif
#ifndef MK_PER_PHASE
#define MK_PER_PHASE 0
#define GSEL 0x1Du
#endif

#ifdef HOST_TEST
#define HD inline
#define DEV inline
#else
#define HD __host__ __device__ __forceinline__
#define DEV __device__ __forceinline__
#endif

typedef unsigned short bf16_t;
constexpr int BATCH = CFG_B, SEQ = CFG_S, T = BATCH * SEQ, D = 1024, DEPTH = 2;
constexpr int D_POOL = 256, D_S5 = 384, D_LRU = 384, D_IN = 1408, D_INP = 1536;
constexpr int NE = 32, TOPK = 4;
constexpr int LC = 128, NT = SEQ / LC;
constexpr int NROWS = T * TOPK + NE * 256;
constexpr int NMB_MAX = NROWS / 256;
constexpr float EPS = 1e-5f;
static_assert(SEQ % LC == 0 && T % 256 == 0, "shape");

constexpr size_t AL(size_t x) { return (x + 255) & ~size_t(255); }
constexpr size_t WS_CTL = 0, CTL_BYTES = 1u << 20;
constexpr size_t WS_WIN = WS_CTL + CTL_BYTES;
constexpr size_t WS_WGLU = WS_WIN + (size_t)2 * D_INP * D * 2;
constexpr size_t WS_WOUT = AL(WS_WGLU + (size_t)2 * 768 * 384 * 2);
constexpr size_t WS_WGU = WS_WOUT + (size_t)2 * D * D * 2;
constexpr size_t WS_WDN = WS_WGU + (size_t)2 * NE * 2048 * 1024 * 2;
constexpr size_t WS_RWT = WS_WDN + (size_t)2 * NE * 1024 * 1024 * 2;
constexpr size_t WS_S5A = WS_RWT + (size_t)2 * NE * 1024 * 4;
constexpr size_t WS_S5A128 = WS_S5A + 6144 * 8;
constexpr size_t WS_S5BB = WS_S5A128 + 6144 * 8;
constexpr size_t WS_S5POW = WS_S5BB + (size_t)6144 * 16 * 8;
constexpr size_t WS_W4T = AL(WS_S5POW + (size_t)6144 * 8 * 4);
constexpr size_t WS_YMAT = WS_W4T + (size_t)2 * 24 * 2 * 128 * 64 * 2;
constexpr size_t WS_LRUWT = AL(WS_YMAT + (size_t)2 * 24 * 64 * 320 * 2);
constexpr size_t WS_POOLWT = WS_LRUWT + (size_t)2 * 2 * 6 * 2 * 4096 * 2;
constexpr size_t WS_HB = AL(WS_POOLWT + (size_t)2 * 4 * 4096 * 2);
constexpr size_t WS_Z = WS_HB + (size_t)T * D * 2;
constexpr size_t WS_X = WS_Z + (size_t)T * D_INP * 2;
constexpr size_t WS_O = WS_X + (size_t)T * D * 4;
constexpr size_t WS_V = WS_O + (size_t)T * D * 2;
constexpr size_t WS_YB = WS_V + (size_t)T * 384 * 2;
constexpr size_t WS_PD = WS_YB + (size_t)T * 384 * 2;
constexpr size_t WS_YA = WS_PD + (size_t)T * 256 * 4;
constexpr size_t WS_XC = WS_YA + (size_t)T * 256 * 4;
constexpr size_t WS_HDIR = WS_XC + (size_t)T * 384 * 4;
constexpr size_t WS_S5E = WS_HDIR + (size_t)T * 768 * 4;
constexpr size_t WS_S5IN = WS_S5E + (size_t)BATCH * NT * 3072 * 8;
constexpr size_t WS_LRUPE = WS_S5IN + (size_t)BATCH * NT * 3072 * 8;
constexpr size_t WS_LRUIN = WS_LRUPE + (size_t)BATCH * NT * 768 * 8;
constexpr size_t WS_TKE = AL(WS_LRUIN + (size_t)BATCH * NT * 768 * 4);
constexpr size_t WS_TKG = WS_TKE + (size_t)T * 16;
constexpr size_t WS_TKP = WS_TKG + (size_t)T * 16;
constexpr size_t WS_TKD = WS_TKP + (size_t)T * 16;
constexpr size_t WS_ROWTOK = WS_TKD + (size_t)T * 16;
constexpr size_t WS_ROWGATE = AL(WS_ROWTOK + (size_t)NROWS * 4);
constexpr size_t WS_BLKE = AL(WS_ROWGATE + (size_t)NROWS * 4);
constexpr size_t WS_SCR = AL(WS_BLKE + (size_t)NMB_MAX * 4);
constexpr size_t WS_XBUF = WS_SCR;
constexpr size_t WS_LRUAB = WS_XBUF + (size_t)T * 3072 * 4;
constexpr size_t WS_ACT = WS_SCR;
constexpr size_t WS_YEXP = WS_ACT + (size_t)NROWS * 1024 * 2;
constexpr size_t SCR_A = (size_t)T * 3072 * 4 + (size_t)T * 768 * 8, SCR_B = (size_t)NROWS * 1024 * 2 * 2;
constexpr size_t WS_END = WS_SCR + (SCR_A > SCR_B ? SCR_A : SCR_B);
constexpr int CW_CNT = 8192, CNT_STRIDE = 64;
constexpr int CW_NMB = 192;
constexpr int CW_BAR = 4096;
constexpr size_t SP8_OFF = 524288;

#if defined(__HIP_DEVICE_COMPILE__) && !defined(HOST_TEST)
typedef __bf16 bf16v2_ __attribute__((ext_vector_type(2))); typedef float f32v2_ __attribute__((ext_vector_type(2)));
HD unsigned pk2(float lo, float hi) { const f32v2_ v = {lo, hi}; return __builtin_bit_cast(unsigned, __builtin_convertvector(v, bf16v2_)); }
HD unsigned f2bf(float f) { return (unsigned)__builtin_bit_cast(unsigned short, (__bf16)f); }
#else
HD unsigned f2bf(float f) { unsigned u; memcpy(&u, &f, 4); return (u + 0x7fffu + ((u >> 16) & 1u)) >> 16; }
HD unsigned pk2(float lo, float hi) { return f2bf(lo) | (f2bf(hi) << 16); }
#endif
HD float bf2f(unsigned b) { unsigned u = (b & 0xffffu) << 16; float f; memcpy(&f, &u, 4); return f; }
HD float sigmoidf_(float x) { return 1.f / (1.f + expf(-x)); }
#ifdef HOST_TEST
HD float sigmoid_fast(float x) { return 1.f / (1.f + expf(-x)); }
#else
__device__ __forceinline__ float sigmoid_fast(float x) { return __builtin_amdgcn_rcpf(1.f + __builtin_amdgcn_exp2f(-1.4426950408889634f * x)); }
__device__ __forceinline__ float expm1_dev(float x, float ex) { const float s = x * (1.f + x * (0.5f + x * (0.16666667f + x * (0.041666668f + x * 0.0083333338f)))); const float e = ex * ex - 1.f; return x > -0.3f ? s : e; }
#endif
#if defined(__HIP_DEVICE_COMPILE__) && !defined(HOST_TEST)
HD float gelu_tanh(float x) { return x * sigmoid_fast(1.5957691216057308f * (x + 0.044715f * x * x * x)); }
#else
HD float gelu_tanh(float x) { return 0.5f * x * (1.f + tanhf(0.7978845608028654f * (x + 0.044715f * x * x * x))); }
#endif

#ifdef HOST_TEST
struct f32x4 { float v[4]; float& operator[](int i) { return v[i]; } const float& operator[](int i) const { return v[i]; } };
#else
typedef float f32x4 __attribute__((ext_vector_type(4)));
#endif

struct Unit { int pm, pn, e; };

struct Ctx {
    const float* const* in;
    float* out;
    unsigned char* ws;
#define WSP(T_, name, off) HD T_* name() const { return (T_*)(ws + (off)); }
    WSP(unsigned, ctl, WS_CTL) WSP(bf16_t, win_t, WS_WIN) WSP(bf16_t, wglu_t, WS_WGLU) WSP(bf16_t, wout_t, WS_WOUT) WSP(bf16_t, wgu_t, WS_WGU) WSP(bf16_t, wdn_t, WS_WDN)
    WSP(unsigned char, hq, WS_O) WSP(unsigned char, act8, WS_ACT) WSP(unsigned char, wgu8, WS_WGU) WSP(unsigned char, wdn8, WS_WDN)
    WSP(bf16_t, lruw_t, WS_LRUWT) WSP(bf16_t, poolw_t, WS_POOLWT) WSP(bf16_t, hl, WS_HDIR) WSP(bf16_t, cp, WS_HDIR + (size_t)T * 768 * 2)
    WSP(float, rwt, WS_RWT) WSP(float, s5a, WS_S5A) WSP(float, s5a128, WS_S5A128) WSP(float, s5bb, WS_S5BB) WSP(float, s5pow, WS_S5POW) WSP(bf16_t, w4t, WS_W4T) WSP(bf16_t, ymat, WS_YMAT)
    WSP(bf16_t, hb, WS_HB) WSP(bf16_t, z, WS_Z) WSP(bf16_t, o, WS_O) WSP(bf16_t, v, WS_V) WSP(bf16_t, yb, WS_YB) WSP(bf16_t, act, WS_ACT) WSP(bf16_t, yexp, WS_YEXP)
    WSP(float, X, WS_X) WSP(float, pd, WS_PD) WSP(float, ya, WS_YA) WSP(float, xc, WS_XC) WSP(float, hdir, WS_HDIR) WSP(float, s5e, WS_S5E) WSP(float, s5in, WS_S5IN)
    WSP(float, lrupe, WS_LRUPE) WSP(float, lruin, WS_LRUIN) WSP(float, tkg, WS_TKG) WSP(float, rowgate, WS_ROWGATE) WSP(float, lruab, WS_LRUAB)
    WSP(int, tke, WS_TKE) WSP(int, tkp, WS_TKP) WSP(int, tkd, WS_TKD) WSP(int, rowtok, WS_ROWTOK) WSP(int, blke, WS_BLKE) WSP(unsigned, xbuf, WS_XBUF)
#undef WSP
};
#ifndef HOST_TEST
struct CtxG {
    const __attribute__((address_space(3))) unsigned long long* tab; __attribute__((address_space(1))) float* outg; __attribute__((address_space(1))) unsigned char* wsg;
    struct InProxy { const __attribute__((address_space(3))) unsigned long long* tab; __device__ __forceinline__ const float* operator[](int i) const { return (const float*)(__attribute__((address_space(1))) const float*)tab[i]; } } in;
    float* out;
    __device__ __forceinline__ explicit CtxG(const Ctx& c) { tab = (const __attribute__((address_space(3))) unsigned long long*)(const unsigned long long*)(const void*)c.in; in.tab = tab; outg = (__attribute__((address_space(1))) float*)(unsigned long long)c.out; wsg = (__attribute__((address_space(1))) unsigned char*)(unsigned long long)c.ws; out = (float*)outg; }
#define WSPG(T_, name, off) __device__ __forceinline__ T_* name() const { return (T_*)(__attribute__((address_space(1))) T_*)(wsg + (off)); }
    WSPG(unsigned, ctl, WS_CTL) WSPG(bf16_t, win_t, WS_WIN) WSPG(bf16_t, wglu_t, WS_WGLU) WSPG(bf16_t, wout_t, WS_WOUT) WSPG(bf16_t, wgu_t, WS_WGU) WSPG(bf16_t, wdn_t, WS_WDN)
    WSPG(unsigned char, hq, WS_O) WSPG(unsigned char, act8, WS_ACT) WSPG(unsigned char, wgu8, WS_WGU) WSPG(unsigned char, wdn8, WS_WDN)
    WSPG(bf16_t, lruw_t, WS_LRUWT) WSPG(bf16_t, poolw_t, WS_POOLWT) WSPG(bf16_t, hl, WS_HDIR) WSPG(bf16_t, cp, WS_HDIR + (size_t)T * 768 * 2)
    WSPG(float, rwt, WS_RWT) WSPG(float, s5a, WS_S5A) WSPG(float, s5a128, WS_S5A128) WSPG(float, s5bb, WS_S5BB) WSPG(float, s5pow, WS_S5POW) WSPG(bf16_t, w4t, WS_W4T) WSPG(bf16_t, ymat, WS_YMAT)
    WSPG(bf16_t, hb, WS_HB) WSPG(bf16_t, z, WS_Z) WSPG(bf16_t, o, WS_O) WSPG(bf16_t, v, WS_V) WSPG(bf16_t, yb, WS_YB) WSPG(bf16_t, act, WS_ACT) WSPG(bf16_t, yexp, WS_YEXP)
    WSPG(float, X, WS_X) WSPG(float, pd, WS_PD) WSPG(float, ya, WS_YA) WSPG(float, xc, WS_XC) WSPG(float, hdir, WS_HDIR) WSPG(float, s5e, WS_S5E) WSPG(float, s5in, WS_S5IN)
    WSPG(float, lrupe, WS_LRUPE) WSPG(float, lruin, WS_LRUIN) WSPG(float, tkg, WS_TKG) WSPG(float, rowgate, WS_ROWGATE) WSPG(float, lruab, WS_LRUAB)
    WSPG(int, tke, WS_TKE) WSPG(int, tkp, WS_TKP) WSPG(int, tkd, WS_TKD) WSPG(int, rowtok, WS_ROWTOK) WSPG(int, blke, WS_BLKE) WSPG(unsigned, xbuf, WS_XBUF)
#undef WSPG
};
#endif
enum { I_X = 0, I_N1G, I_WIN, I_POOLW, I_POOLS, I_LAMRE, I_LAMIM, I_LOGSTEP, I_BRE, I_BIM, I_CRE, I_CIM, I_S5D, I_WGLU, I_BGLU, I_CONVW, I_CONVB, I_WA, I_BA, I_WX, I_BX, I_LAM,
       I_MIXG, I_WOUT, I_N2G, I_RW, I_RB, I_WGU, I_BGU, I_WDN, I_BDN, I_FING };

HD void st_prep_small(long gtid, long gs, const Ctx& c) {
    for (long i = gtid; i < 6144; i += gs) {
        const float lr = c.in[I_LAMRE][i], li = c.in[I_LAMIM][i], dt = expf(c.in[I_LOGSTEP][i / 64]);
        const float mag = expf(lr * dt), ar = mag * cosf(li * dt), ai = mag * sinf(li * dt);
        const float den = lr * lr + li * li, nr = ar - 1.f, ni = ai, qr = (nr * lr + ni * li) / den, qi = (ni * lr - nr * li) / den;
        c.s5a()[2 * i] = ar; c.s5a()[2 * i + 1] = ai;
        float pr = ar, pi = ai;
        for (int k = 0; k < 7; ++k) { const float t = pr * pr - pi * pi; pi = 2.f * pr * pi; pr = t; }
        c.s5a128()[2 * i] = pr; c.s5a128()[2 * i + 1] = pi;
        for (int cc = 0; cc < 16; ++cc) { const float br = c.in[I_BRE][i * 16 + cc], bi = c.in[I_BIM][i * 16 + cc];
            c.s5bb()[(i * 16 + cc) * 2] = qr * br - qi * bi; c.s5bb()[(i * 16 + cc) * 2 + 1] = qr * bi + qi * br; }
    }
    for (long i = gtid; i < 2 * NE * 1024; i += gs) { const int l = (int)(i / (NE * 1024)), e = (int)(i / 1024) % NE, k = (int)(i % 1024);
        const float f_ = c.in[I_N2G][l * 1024 + k] * c.in[I_RW][((size_t)l * 1024 + k) * NE + e];
#ifdef HOST_TEST
        c.rwt()[i] = f_; }
#else
        { bf16_t* rh = (bf16_t*)c.rwt(); const unsigned hi_ = f2bf(f_); const float lo_ = f_ - bf2f(hi_);
          rh[((size_t)(l * 2) * NE + e) * 1024 + k] = (bf16_t)hi_; rh[((size_t)(l * 2 + 1) * NE + e) * 1024 + k] = (bf16_t)f2bf(lo_); } }
#endif
    for (long i = gtid; i < (long)2 * 128 * 1024; i += gs) { const int l = (int)(i / (128 * 1024)); const long r = i % (128 * 1024);
        c.win_t()[(size_t)l * D_INP * D + (size_t)D_IN * D + r] = 0; }
}
HD void cpowi(float ar, float ai, int e, float& pr, float& pi) { pr = 1.f; pi = 0.f; for (int k = 0; k < e; ++k) { const float t = pr * ar - pi * ai; pi = pr * ai + pi * ar; pr = t; } }
HD void st_prep_s5mat(long gtid, long gs, const Ctx& c) {
    const float* cre_ = c.in[I_CRE]; const float* cim_ = c.in[I_CIM]; const float* s5d_ = c.in[I_S5D];
    for (long i = gtid; i < 6144; i += gs) { const float ar = c.s5a()[2 * i], ai = c.s5a()[2 * i + 1]; float pr, pi;
        cpowi(ar, ai, 4, pr, pi); c.s5pow()[i * 8 + 0] = pr; c.s5pow()[i * 8 + 1] = pi;
        cpowi(ar, ai, 16, pr, pi); c.s5pow()[i * 8 + 2] = pr; c.s5pow()[i * 8 + 3] = pi;
        cpowi(ar, ai, 32, pr, pi); c.s5pow()[i * 8 + 4] = pr; c.s5pow()[i * 8 + 5] = pi;
        cpowi(ar, ai, 64, pr, pi); c.s5pow()[i * 8 + 6] = pr; c.s5pow()[i * 8 + 7] = pi; }
    for (long i = gtid; i < (long)2 * 24 * 2 * 128 * 64; i += gs) { const int k = (int)(i % 64), pp = (int)(i / 64) % 128, dir = (int)(i / 8192) % 2, g = (int)(i / 16384) % 24, l = (int)(i / 16384 / 24);
        const int p = pp & 63, j = k >> 4, cc = k & 15, ci = ((l * 2 + dir) * 24 + g) * 64 + p; float pr, pi; cpowi(c.s5a()[2 * ci], c.s5a()[2 * ci + 1], dir ? j : 3 - j, pr, pi);
        const float br = c.s5bb()[(ci * 16 + cc) * 2], bi = c.s5bb()[(ci * 16 + cc) * 2 + 1];
        c.w4t()[i] = (bf16_t)f2bf(pp < 64 ? pr * br - pi * bi : pr * bi + pi * br); }
    for (long i = gtid; i < (long)2 * 24 * 64 * 256; i += gs) { const int k = (int)(i % 256), row = (int)(i / 256) % 64, g = (int)(i / 16384) % 24, l = (int)(i / 16384 / 24); const int j = row >> 4, cc = row & 15;
        const int dir = k >> 7, kk = k & 127, nt = kk < 64 ? 0 : 4, p = kk & 63, ci = ((l * 2 + dir) * 24 + g) * 64 + p; float pr, pi; cpowi(c.s5a()[2 * ci], c.s5a()[2 * ci + 1], dir ? 4 - j : j + 1, pr, pi);
        const size_t co = ((size_t)((l * 2 + dir) * 24 + g) * 16 + cc) * 64 + p; const float cr = cre_[co], cim = cim_[co];
        const float val = nt < 4 ? cr * pr - cim * pi : -(cr * pi + cim * pr);
        c.ymat()[((size_t)(l * 24 + g) * 64 + row) * 320 + k] = (bf16_t)f2bf(val); }
    for (long i = gtid; i < (long)2 * 24 * 7 * 256; i += gs) { const int c2 = (int)(i % 16), cc = (int)(i / 16) % 16, dd = (int)(i / 256) % 7, g = (int)(i / 1792) % 24, l = (int)(i / 1792 / 24); const int d = dd - 3;
        float val = (d == 0 && c2 == cc) ? s5d_[l * 384 + g * 16 + cc] : 0.f;
        for (int dir = 0; dir < 2; ++dir) { if (dir == 0 ? d < 0 : d > 0) continue; const int e = d < 0 ? -d : d;
            for (int p = 0; p < 64; ++p) { const int ci = ((l * 2 + dir) * 24 + g) * 64 + p; float pr, pi; cpowi(c.s5a()[2 * ci], c.s5a()[2 * ci + 1], e, pr, pi);
                const size_t co = ((size_t)((l * 2 + dir) * 24 + g) * 16 + cc) * 64 + p; const float cr = cre_[co], cim = cim_[co]; const float xr = cr * pr - cim * pi, xi = cr * pi + cim * pr;
                val += xr * c.s5bb()[(ci * 16 + c2) * 2] - xi * c.s5bb()[(ci * 16 + c2) * 2 + 1]; } }
        const bf16_t vb = (bf16_t)f2bf(val);
        for (int j = 0; j < 4; ++j) { const int ii = j - d; if (ii < 0 || ii > 3) continue; c.ymat()[((size_t)(l * 24 + g) * 64 + j * 16 + cc) * 320 + 256 + ii * 16 + c2] = vb; } }
}
HD void s5_tile_ref(const Ctx& c, int l, int tile, int g, bool final_pass) {
    const int b = tile / NT, ct = tile % NT, t0 = b * SEQ + ct * LC;
    float U[32][64];
    for (int n = 0; n < 32; ++n) for (int k = 0; k < 64; ++k) U[n][k] = bf2f(c.z()[(size_t)(t0 + 4 * n + (k >> 4)) * D_INP + 256 + 16 * g + (k & 15)]);
    float S[2][33][128];
    for (int dir = 0; dir < 2; ++dir) {
        const bf16_t* w = c.w4t() + (size_t)((l * 24 + g) * 2 + dir) * 128 * 64;
        for (int p = 0; p < 64; ++p) { const int ci = ((l * 2 + dir) * 24 + g) * 64 + p; const float a4r = c.s5pow()[ci * 8], a4i = c.s5pow()[ci * 8 + 1];
            float sr = 0.f, si = 0.f; const size_t io = ((size_t)(b * NT + ct) * 3072 + dir * 1536 + g * 64 + p) * 2;
            if (final_pass) { sr = c.s5in()[io]; si = c.s5in()[io + 1]; }
            if (dir == 0) { S[0][0][p] = sr; S[0][0][64 + p] = si; } else { S[1][32][p] = sr; S[1][32][64 + p] = si; }
            for (int q = 0; q < 32; ++q) { const int n = dir == 0 ? q : 31 - q; float gr = 0.f, gi = 0.f;
                for (int k = 0; k < 64; ++k) { gr += U[n][k] * bf2f(w[p * 64 + k]); gi += U[n][k] * bf2f(w[(64 + p) * 64 + k]); }
                const float nr = a4r * sr - a4i * si + gr, ni = a4r * si + a4i * sr + gi; sr = nr; si = ni;
                const int row = dir == 0 ? n + 1 : n; S[dir][row][p] = sr; S[dir][row][64 + p] = si; }
            if (!final_pass) { c.s5e()[io] = sr; c.s5e()[io + 1] = si; } } }
    if (!final_pass) return;
    const bf16_t* ym = c.ymat() + (size_t)(l * 24 + g) * 64 * 320;
    for (int n = 0; n < 32; ++n) for (int row = 0; row < 64; ++row) { float y = 0.f;
        for (int k = 0; k < 256; ++k) { const int dir = k >> 7, pp = k & 127; const float s = dir == 0 ? S[0][n][pp] : S[1][n + 1][pp];
            y += bf2f(ym[row * 320 + k]) * bf2f(f2bf(s)); }
        for (int k = 0; k < 64; ++k) y += bf2f(ym[row * 320 + 256 + k]) * U[n][k];
        c.v()[(size_t)(t0 + 4 * n + (row >> 4)) * 384 + 16 * g + (row & 15)] = (bf16_t)f2bf(gelu_tanh(y)); }
}
HD void st_mix1(long gtid, long gs, const Ctx& c, int l) {
    for (long i = gtid; i < (long)T * 256; i += gs) { const int t = (int)(i / 256), ch = (int)(i % 256), g = ch / 64, half = 1 << g, s = t % SEQ, b0 = t - s;
        const int lo = s - half < 0 ? 0 : s - half, hi = s + half > SEQ ? SEQ : s + half; float sum = 0.f;
        for (int q = lo; q < hi; ++q) sum += bf2f(c.z()[(size_t)(b0 + q) * D_INP + ch]);
        c.pd()[i] = sum / (float)(hi - lo) - bf2f(c.z()[(size_t)t * D_INP + ch]); }
    const float* cw = c.in[I_CONVW] + l * 4 * 384; const float* cb = c.in[I_CONVB] + l * 384;
    for (long i = gtid; i < (long)T * 384; i += gs) { const int t = (int)(i / 384), ch = (int)(i % 384), s = t % SEQ; float a = cb[ch];
        for (int j = 0; j < 4; ++j) { const int q = s - 1 + j; if (q >= 0 && q < SEQ) a += cw[j * 384 + ch] * bf2f(c.z()[(size_t)(t - 1 + j) * D_INP + 640 + ch]); }
        c.xc()[i] = a; }
}
HD void st_s5_scan(long gtid, long gs, const Ctx& c, int l, bool final_pass) {
    for (long i = gtid; i < (long)BATCH * NT * 3072; i += gs) {
        const int p = (int)(i % 64), g = (int)(i / 64) % 24, dir = (int)(i / 1536) % 2, ct = (int)(i / 3072) % NT, b = (int)(i / 3072 / NT);
        const int ci = ((l * 2 + dir) * 24 + g) * 64 + p;
        const float ar = c.s5a()[2 * ci], ai = c.s5a()[2 * ci + 1];
        float bbr[16], bbi[16];
        for (int cc = 0; cc < 16; ++cc) { bbr[cc] = c.s5bb()[(ci * 16 + cc) * 2]; bbi[cc] = c.s5bb()[(ci * 16 + cc) * 2 + 1]; }
        float xr = 0.f, xi = 0.f;
        if (final_pass) { xr = c.s5in()[2 * i]; xi = c.s5in()[2 * i + 1]; }
        for (int q = 0; q < LC; ++q) { const int tt = b * SEQ + ct * LC + (dir == 0 ? q : LC - 1 - q);
            const bf16_t* u = c.z() + (size_t)tt * D_INP + 256 + 16 * g; float bur = 0.f, bui = 0.f;
            for (int cc = 0; cc < 16; ++cc) { const float uv = bf2f(u[cc]); bur += bbr[cc] * uv; bui += bbi[cc] * uv; }
            const float nr = ar * xr - ai * xi + bur, ni = ar * xi + ai * xr + bui; xr = nr; xi = ni;
            if (final_pass) c.xbuf()[((size_t)tt * 2 + dir) * 1536 + g * 64 + p] = pk2(xr, xi); }
        if (!final_pass) { c.s5e()[2 * i] = xr; c.s5e()[2 * i + 1] = xi; }
    }
}
HD void st_mix2(long gtid, long gs, const Ctx& c, int l) {
    const float* pw = c.in[I_POOLW] + l * 4 * 64 * 64; const float* ps = c.in[I_POOLS] + l * 256;
    for (long i = gtid; i < (long)T * 256; i += gs) { const int t = (int)(i / 256), ch = (int)(i % 256), g = ch / 64, dd = ch % 64; float a = 0.f;
        for (int k = 0; k < 64; ++k) a += c.pd()[(size_t)t * 256 + g * 64 + k] * pw[(g * 64 + k) * 64 + dd];
        c.ya()[i] = a * ps[ch]; }
    for (long i = gtid; i < (long)T * 768; i += gs) { const int t = (int)(i / 768), dir = (int)(i / 384) % 2, ch = (int)(i % 384), h = ch / 64, j = ch % 64;
        const float* wa = c.in[I_WA] + (((size_t)(l * 2 + dir) * 6 + h) * 64) * 64; const float* wx = c.in[I_WX] + (((size_t)(l * 2 + dir) * 6 + h) * 64) * 64;
        float ra = c.in[I_BA][(l * 2 + dir) * 384 + ch], rx = c.in[I_BX][(l * 2 + dir) * 384 + ch];
        const float* xr = c.xc() + (size_t)t * 384 + h * 64;
        for (int k = 0; k < 64; ++k) { const float xv = xr[k]; ra += xv * wa[k * 64 + j]; rx += xv * wx[k * 64 + j]; }
        const float r = sigmoidf_(ra), ig = sigmoidf_(rx), sp = log1pf(expf(-c.in[I_LAM][(l * 2 + dir) * 384 + ch]));
        const float la = -8.f * r * sp, a = expf(la), bt = sqrtf(-expm1f(2.f * la)) * (ig * c.xc()[(size_t)t * 384 + ch]);
        c.lruab()[2 * i] = a; c.lruab()[2 * i + 1] = bt; }
    for (long i = gtid; i < (long)BATCH * 3072; i += gs) { const int r = (int)(i % 3072), b = (int)(i / 3072), dir = r / 1536; const int ci = l * 3072 + r;
        const float ar = c.s5a128()[2 * ci], ai = c.s5a128()[2 * ci + 1]; float sr = 0.f, si = 0.f;
        for (int q = 0; q < NT; ++q) { const int ct = dir == 0 ? q : NT - 1 - q; const size_t o = ((size_t)(b * NT + ct) * 3072 + r) * 2;
            c.s5in()[o] = sr; c.s5in()[o + 1] = si; const float er = c.s5e()[o], ei = c.s5e()[o + 1];
            const float nr = ar * sr - ai * si + er, ni = ar * si + ai * sr + ei; sr = nr; si = ni; } }
}
HD void st_lru_scan(long gtid, long gs, const Ctx& c, bool final_pass) {
    for (long i = gtid; i < (long)BATCH * NT * 768; i += gs) { const int r = (int)(i % 768), dir = r / 384, ch = r % 384, ct = (int)(i / 768) % NT, b = (int)(i / 768 / NT);
        float h = final_pass ? c.lruin()[i] : 0.f, P = 1.f;
        for (int q = 0; q < LC; ++q) { const int tt = b * SEQ + ct * LC + (dir == 0 ? q : LC - 1 - q); const size_t o = ((size_t)tt * 768 + r) * 2;
            const float a = c.lruab()[o], bt = c.lruab()[o + 1]; h = a * h + bt; P *= a;
            if (final_pass) c.hdir()[(size_t)tt * 768 + dir * 384 + ch] = h; }
        if (!final_pass) { c.lrupe()[2 * i] = P; c.lrupe()[2 * i + 1] = h; } }
}
HD void st_mix4(long gtid, long gs, const Ctx& c, int l, bool s5_naive) {
    for (long i = gtid; i < (long)BATCH * 768; i += gs) { const int r = (int)(i % 768), b = (int)(i / 768), dir = r / 384; float h = 0.f;
        for (int q = 0; q < NT; ++q) { const int ct = dir == 0 ? q : NT - 1 - q; const size_t o = (size_t)(b * NT + ct) * 768 + r;
            c.lruin()[o] = h; h = c.lrupe()[2 * o] * h + c.lrupe()[2 * o + 1]; } }
    if (s5_naive) for (long i = gtid; i < (long)T * 384; i += gs) { const int t = (int)(i / 384), ch = (int)(i % 384), g = ch / 16, cc = ch % 16;
        float y = c.in[I_S5D][l * 384 + ch] * bf2f(c.z()[(size_t)t * D_INP + 256 + ch]);
        for (int dir = 0; dir < 2; ++dir) { const float* cr = c.in[I_CRE] + ((size_t)((l * 2 + dir) * 24 + g) * 16 + cc) * 64; const float* cim = c.in[I_CIM] + ((size_t)((l * 2 + dir) * 24 + g) * 16 + cc) * 64;
            const unsigned* xb = c.xbuf() + ((size_t)t * 2 + dir) * 1536 + g * 64;
            for (int p = 0; p < 64; ++p) { const unsigned w = xb[p]; y += cr[p] * bf2f(w & 0xffffu) - cim[p] * bf2f(w >> 16); } }
        c.v()[i] = (bf16_t)f2bf(gelu_tanh(y)); }
}
HD float expm1_small(float x) { return x > -0.3f ? x * (1.f + x * (0.5f + x * (0.16666667f + x * (0.041666668f + x * 0.0083333338f)))) : expf(x) - 1.f; }
HD void st_prep_mixw(long gtid, long gs, const Ctx& c) {
    for (long i = gtid; i < (long)2 * 2 * 6 * 2 * 4096; i += gs) { const int ii = (int)(i % 64), j = (int)(i / 64) % 64, which = (int)(i / 4096) % 2; const long ldh = i / 8192;
        const float* w = (which ? c.in[I_WX] : c.in[I_WA]) + ldh * 4096; c.lruw_t()[i] = (bf16_t)f2bf(w[ii * 64 + j]); }
    for (long i = gtid; i < (long)2 * 4 * 4096; i += gs) { const int cc = (int)(i % 64), dd = (int)(i / 64) % 64; const long lg = i / 4096; c.poolw_t()[i] = (bf16_t)f2bf(c.in[I_POOLW][lg * 4096 + cc * 64 + dd]); }
    for (long i = gtid; i < (long)2 * 2 * 384; i += gs) ((float*)c.ctl() + SP8_OFF / 4)[i] = -8.f * log1pf(expf(-c.in[I_LAM][i]));
}
HD void mixer_tile_ref(const Ctx& c, int l, int tile) {
    const int b = tile / NT, ct = tile % NT, s0 = ct * LC, t0 = b * SEQ + s0;
    for (int t = 0; t < LC; ++t) { float ya[256]; float ss = 0.f;
        for (int ch = 0; ch < 256; ++ch) ya[ch] = 0.f;
        for (int g = 0; g < 4; ++g) { const int half = 1 << g, s = s0 + t, lo = s - half < 0 ? 0 : s - half, hi = s + half > SEQ ? SEQ : s + half; float d[64];
            for (int cc = 0; cc < 64; ++cc) { float sum = 0.f; for (int q = lo; q < hi; ++q) sum += bf2f(c.z()[(size_t)(b * SEQ + q) * D_INP + g * 64 + cc]);
                d[cc] = bf2f(f2bf(sum / (float)(hi - lo) - bf2f(c.z()[(size_t)(t0 + t) * D_INP + g * 64 + cc]))); }
            for (int dd = 0; dd < 64; ++dd) { float a = 0.f; for (int cc = 0; cc < 64; ++cc) a += d[cc] * bf2f(c.poolw_t()[((size_t)(l * 4 + g) * 64 + dd) * 64 + cc]);
                ya[g * 64 + dd] = a * c.in[I_POOLS][l * 256 + g * 64 + dd]; } }
        for (int ch = 0; ch < 256; ++ch) ss += ya[ch] * ya[ch];
        const float rstd = 1.f / sqrtf(ss * (1.f / 256) + EPS);
        for (int ch = 0; ch < 256; ++ch) c.o()[(size_t)(t0 + t) * D + ch] = (bf16_t)f2bf(ya[ch] * rstd); }
    for (int h = 0; h < 6; ++h) {
        float xc[LC][64];
        for (int t = 0; t < LC; ++t) for (int cc = 0; cc < 64; ++cc) { const int ch = h * 64 + cc; float a = c.in[I_CONVB][l * 384 + ch];
            for (int j = 0; j < 4; ++j) { const int q = s0 + t - 1 + j; if (q >= 0 && q < SEQ) a += c.in[I_CONVW][(l * 4 + j) * 384 + ch] * bf2f(c.z()[(size_t)(b * SEQ + q) * D_INP + 640 + ch]); }
            xc[t][cc] = bf2f(f2bf(a)); }
        for (int dir = 0; dir < 2; ++dir) for (int cc = 0; cc < 64; ++cc) { const int ch = h * 64 + cc, pi = (l * 2 + dir) * 384 + ch;
            const bf16_t* wa = c.lruw_t() + ((size_t)(((l * 2 + dir) * 6 + h) * 2 + 0) * 64 + cc) * 64; const bf16_t* wx = wa + 4096;
            const float sp = log1pf(expf(-c.in[I_LAM][pi])); float hh = 0.f, P = 1.f;
            for (int q = 0; q < LC; ++q) { const int t = dir == 0 ? q : LC - 1 - q; float ra = c.in[I_BA][pi], rx = c.in[I_BX][pi];
                for (int k = 0; k < 64; ++k) { ra += xc[t][k] * bf2f(wa[k]); rx += xc[t][k] * bf2f(wx[k]); }
                const float r = sigmoidf_(ra), ig = sigmoidf_(rx), la = -8.f * r * sp, a = expf(la), bt = sqrtf(-expm1_small(2.f * la)) * (ig * xc[t][cc]);
                hh = a * hh + bf2f(f2bf(bt)); P *= a;
                c.hl()[((size_t)(t0 + t) * 2 + dir) * 384 + ch] = (bf16_t)f2bf(hh); c.cp()[((size_t)(t0 + t) * 2 + dir) * 384 + ch] = (bf16_t)f2bf(P); }
            const size_t o = ((size_t)(b * NT + ct) * 768 + dir * 384 + ch) * 2; c.lrupe()[o] = P; c.lrupe()[o + 1] = hh; } }
}
HD void st_carries(long gtid, long gs, const Ctx& c, int l) {
    for (long i = gtid; i < (long)BATCH * 3072; i += gs) { const int r = (int)(i % 3072), b = (int)(i / 3072), dir = r / 1536; const int ci = l * 3072 + r;
        const float ar = c.s5a128()[2 * ci], ai = c.s5a128()[2 * ci + 1]; float sr = 0.f, si = 0.f;
        for (int q = 0; q < NT; ++q) { const int ct = dir == 0 ? q : NT - 1 - q; const size_t o = ((size_t)(b * NT + ct) * 3072 + r) * 2;
            c.s5in()[o] = sr; c.s5in()[o + 1] = si; const float er = c.s5e()[o], ei = c.s5e()[o + 1];
            const float nr = ar * sr - ai * si + er, ni = ar * si + ai * sr + ei; sr = nr; si = ni; } }
    for (long i = gtid; i < (long)BATCH * 768; i += gs) { const int r = (int)(i % 768), b = (int)(i / 768), dir = r / 384; float h = 0.f;
        for (int q = 0; q < NT; ++q) { const int ct = dir == 0 ? q : NT - 1 - q; const size_t o = (size_t)(b * NT + ct) * 768 + r;
            c.lruin()[o] = h; h = c.lrupe()[2 * o] * h + c.lrupe()[2 * o + 1]; } }
}
HD void expert_range(const unsigned* cnt, int e, int& start, int& count) { int s = 0; for (int q = 0; q < e; ++q) s += ((int)cnt[q * CNT_STRIDE] + 255) & ~255; start = s; count = (int)cnt[e * CNT_STRIDE]; }
HD void st_route(long gtid, long gs, const Ctx& c, int l) {
    const unsigned* cnt = c.ctl() + CW_CNT + 32 * l * CNT_STRIDE;
    for (long i = gtid; i < (long)T * 4; i += gs) { const int e = c.tke()[i]; int st, n; expert_range(cnt, e, st, n); const int d = st + c.tkp()[i];
        c.tkd()[i] = d; c.rowtok()[d] = (int)(i / 4); c.rowgate()[d] = c.tkg()[i]; }
    int total = 0; for (int q = 0; q < NE; ++q) total += ((int)cnt[q * CNT_STRIDE] + 255) & ~255;
    for (long r = gtid; r < total; r += gs) { int e = 0, st = 0; for (;;) { const int pe = ((int)cnt[e * CNT_STRIDE] + 255) & ~255; if (r < st + pe) break; st += pe; ++e; }
        if (r - st >= (long)cnt[e * CNT_STRIDE]) { c.rowtok()[r] = 0; c.rowgate()[r] = 0.f; }
        if ((r & 255) == 0) c.blke()[r >> 8] = e; }
    if (gtid == 0) c.ctl()[CW_NMB + l] = (unsigned)(total / 256);
}

#ifdef HOST_TEST
constexpr int NL = 1;
inline float wsum(float v) { return v; }
#else
constexpr int NL = 64;
DEV float wsum(float v) {
#pragma unroll
    for (int o = 1; o < 64; o <<= 1) v += __shfl_xor(v, o);
    return v;
}
#endif
HD void row_norm_bf16(const float* xr, bf16_t* orow, int lane) {
    float ss = 0.f;
    for (int k = lane * 4; k < D; k += NL * 4) { const float a = xr[k], b = xr[k + 1], cc = xr[k + 2], d = xr[k + 3]; ss += a * a + b * b + cc * cc + d * d; }
    const float rstd = 1.f / sqrtf(wsum(ss) * (1.f / D) + EPS);
    for (int k = lane * 4; k < D; k += NL * 4) { unsigned* o = (unsigned*)(orow + k); o[0] = pk2(xr[k] * rstd, xr[k + 1] * rstd); o[1] = pk2(xr[k + 2] * rstd, xr[k + 3] * rstd); }
}
HD void row_mix_norm(const Ctx& c, int t, int lane) {
    bf16_t* orow = c.o() + (size_t)t * D;
    { float ss = 0.f; const float* ya = c.ya() + (size_t)t * 256;
      for (int k = lane; k < 256; k += NL) ss += ya[k] * ya[k];
      const float rstd = 1.f / sqrtf(wsum(ss) * (1.f / 256) + EPS);
      for (int k = lane; k < 256; k += NL) orow[k] = (bf16_t)f2bf(ya[k] * rstd); }
    { float ss = 0.f; const bf16_t* yb = c.yb() + (size_t)t * 384;
      for (int k = lane; k < 384; k += NL) { const float y = bf2f(yb[k]); ss += y * y; }
      const float rstd = 1.f / sqrtf(wsum(ss) * (1.f / 384) + EPS);
      for (int k = lane; k < 384; k += NL) orow[256 + k] = (bf16_t)f2bf(bf2f(yb[k]) * rstd); }
    { float ss = 0.f; const float* hd = c.hdir() + (size_t)t * 768; const bf16_t* gz = c.z() + (size_t)t * D_INP + 1024;
      for (int k = lane; k < 384; k += NL) { const float y = (hd[k] + hd[384 + k]) * gelu_tanh(bf2f(gz[k])); ss += y * y; }
      const float rstd = 1.f / sqrtf(wsum(ss) * (1.f / 384) + EPS);
      for (int k = lane; k < 384; k += NL) { const float y = (hd[k] + hd[384 + k]) * gelu_tanh(bf2f(gz[k])); orow[640 + k] = (bf16_t)f2bf(y * rstd); } }
}
HD void row_mix_norm2(const Ctx& c, int t, int lane) {
    bf16_t* orow = c.o() + (size_t)t * D;
    { float ss = 0.f; const bf16_t* yb = c.yb() + (size_t)t * 384;
      for (int k = lane; k < 384; k += NL) { const float y = bf2f(yb[k]); ss += y * y; }
      const float rstd = 1.f / sqrtf(wsum(ss) * (1.f / 384) + EPS);
      for (int k = lane; k < 384; k += NL) orow[256 + k] = (bf16_t)f2bf(bf2f(yb[k]) * rstd); }
    { float ss = 0.f; const bf16_t* hl = c.hl() + (size_t)t * 768; const bf16_t* cp = c.cp() + (size_t)t * 768; const bf16_t* gz = c.z() + (size_t)t * D_INP + 1024;
      const float* cin = c.lruin() + (size_t)((t / SEQ) * NT + (t % SEQ) / LC) * 768;
      for (int k = lane; k < 384; k += NL) { const float y = (bf2f(hl[k]) + bf2f(cp[k]) * cin[k] + bf2f(hl[384 + k]) + bf2f(cp[384 + k]) * cin[384 + k]) * gelu_tanh(bf2f(gz[k])); ss += y * y; }
      const float rstd = 1.f / sqrtf(wsum(ss) * (1.f / 384) + EPS);
      for (int k = lane; k < 384; k += NL) { const float y = (bf2f(hl[k]) + bf2f(cp[k]) * cin[k] + bf2f(hl[384 + k]) + bf2f(cp[384 + k]) * cin[384 + k]) * gelu_tanh(bf2f(gz[k])); orow[640 + k] = (bf16_t)f2bf(y * rstd); } }
}
HD void row_combine(const Ctx& c, int t, int lane, bool last) {
    float* xr = c.X() + (size_t)t * D; float ss = 0.f;
    const int d0 = c.tkd()[t * 4], d1 = c.tkd()[t * 4 + 1], d2 = c.tkd()[t * 4 + 2], d3 = c.tkd()[t * 4 + 3];
    for (int k = lane * 4; k < D; k += NL * 4) {
        for (int j = 0; j < 4; ++j) { float a = xr[k + j];
            a += bf2f(c.yexp()[(size_t)d0 * 1024 + k + j]); a += bf2f(c.yexp()[(size_t)d1 * 1024 + k + j]); a += bf2f(c.yexp()[(size_t)d2 * 1024 + k + j]); a += bf2f(c.yexp()[(size_t)d3 * 1024 + k + j]);
            xr[k + j] = a; ss += a * a; } }
    const float rstd = 1.f / sqrtf(wsum(ss) * (1.f / D) + EPS);
    if (!last) { bf16_t* orow = c.hb() + (size_t)t * D;
        for (int k = lane * 4; k < D; k += NL * 4) { unsigned* o = (unsigned*)(orow + k); o[0] = pk2(xr[k] * rstd, xr[k + 1] * rstd); o[1] = pk2(xr[k + 2] * rstd, xr[k + 3] * rstd); } }
    else { float* orow = c.out + (size_t)t * D; const float* fg = c.in[I_FING];
        for (int k = lane * 4; k < D; k += NL * 4) for (int j = 0; j < 4; ++j) orow[k + j] = xr[k + j] * rstd * fg[k + j]; }
}

HD void st_bf16x4(bf16_t* p, float a, float b, float cc, float d) { unsigned* o = (unsigned*)p; o[0] = pk2(a, b); o[1] = pk2(cc, d); }
struct EpiIn { static constexpr bool SIDE = false; bf16_t* z; HD void operator()(const Unit&, int row, int col, const f32x4& v) const { st_bf16x4(z + (size_t)row * D_INP + col, v[0], v[1], v[2], v[3]); } };
struct EpiGlu { static constexpr bool SIDE = false; bf16_t* yb; const float* b;
    HD void operator()(const Unit&, int row, int col, const f32x4& v) const { const int j = col >> 1;
        const float y0 = (v[0] + b[j]) * sigmoid_fast(v[1] + b[384 + j]), y1 = (v[2] + b[j + 1]) * sigmoid_fast(v[3] + b[384 + j + 1]);
        *(unsigned*)(yb + (size_t)row * 384 + j) = pk2(y0, y1); } };
struct EpiOut { static constexpr bool SIDE = false; const float* base; float* X;
#ifdef HOST_TEST
    HD void operator()(const Unit&, int row, int col, const f32x4& v) const { const size_t o = (size_t)row * D + col; for (int j = 0; j < 4; ++j) X[o + j] = base[o + j] + v[j]; } };
#else
    __device__ __forceinline__ void operator()(const Unit&, int row, int col, const f32x4& v) const { const size_t o = (size_t)row * D + col; const f32x4 r = *(const __attribute__((address_space(1))) f32x4*)(base + o) + v; *(__attribute__((address_space(1))) f32x4*)(X + o) = r; } };
#endif
#ifndef HOST_TEST
template <bool BASE_F32>
struct EpiOutW { static constexpr bool SIDE = false; const void* base; bf16_t* X;
    __device__ __forceinline__ void wide(const Unit&, int row, int col, const f32x4& a, const f32x4& b) const { typedef unsigned u4_ __attribute__((ext_vector_type(4)));
        const size_t o = (size_t)row * D + col; f32x4 r0, r1;
        if constexpr (BASE_F32) { const __attribute__((address_space(1))) f32x4* p = (const __attribute__((address_space(1))) f32x4*)((const float*)base + o); r0 = p[0]; r1 = p[1]; }
        else { const u4_ w = *(const __attribute__((address_space(1))) u4_*)((const bf16_t*)base + o);
            r0 = (f32x4){__builtin_bit_cast(float, w.x << 16), __builtin_bit_cast(float, w.x & 0xffff0000u), __builtin_bit_cast(float, w.y << 16), __builtin_bit_cast(float, w.y & 0xffff0000u)};
            r1 = (f32x4){__builtin_bit_cast(float, w.z << 16), __builtin_bit_cast(float, w.z & 0xffff0000u), __builtin_bit_cast(float, w.w << 16), __builtin_bit_cast(float, w.w & 0xffff0000u)}; }
        r0 += a; r1 += b;
        u4_ q; q.x = pk2(r0[0], r0[1]); q.y = pk2(r0[2], r0[3]); q.z = pk2(r1[0], r1[1]); q.w = pk2(r1[2], r1[3]);
        *(__attribute__((address_space(1))) u4_*)(X + o) = q; } };
#endif
struct EpiMoe1 { static constexpr bool SIDE = false; bf16_t* act; const float* bgu;
    HD void operator()(const Unit& u, int row, int col, const f32x4& v) const { const float* b = bgu + (size_t)u.e * 2048 + col; float r[2];
        for (int q = 0; q < 2; ++q) { float g = v[2 * q] + b[2 * q], up = v[2 * q + 1] + b[2 * q + 1]; g = g < 7.f ? g : 7.f; up = up < -7.f ? -7.f : (up > 7.f ? 7.f : up);
            r[q] = (up + 1.f) * (g * sigmoid_fast(1.702f * g)); }
        *(unsigned*)(act + (size_t)row * 1024 + (col >> 1)) = pk2(r[0], r[1]); } };
struct EpiMoe2 { static constexpr bool SIDE = false; bf16_t* yexp; const float* bdn; const float* rowgate;
    HD void operator()(const Unit& u, int row, int col, const f32x4& v) const { const float* b = bdn + (size_t)u.e * 1024 + col; const float g = rowgate[row];
        st_bf16x4(yexp + (size_t)row * 1024 + col, (v[0] + b[0]) * g, (v[1] + b[1]) * g, (v[2] + b[2]) * g, (v[3] + b[3]) * g); } };

#ifndef HOST_TEST
#define LAS __attribute__((address_space(3)))
__device__ __forceinline__ unsigned f32x2_to_fp8(float a, float b) { return (unsigned)__builtin_amdgcn_cvt_pk_fp8_f32(a, b, 0, false) & 0xffffu; }
constexpr float W8_SCALE = 64.f, W8_INV = 1.f / 64.f;
struct EpiInW { static constexpr bool SIDE = false; bf16_t* z;
    __device__ __forceinline__ void wide(const Unit&, int row, int col, const f32x4& a, const f32x4& b) const { typedef unsigned u4_ __attribute__((ext_vector_type(4))); u4_ w; w.x = pk2(a[0], a[1]); w.y = pk2(a[2], a[3]); w.z = pk2(b[0], b[1]); w.w = pk2(b[2], b[3]);
        if (col < D_IN) *(__attribute__((address_space(1))) u4_*)(z + (size_t)row * D_INP + col) = w; } };
struct EpiGluW { static constexpr bool SIDE = true; bf16_t* yb; const float* b;
    __device__ __forceinline__ void load_side(const Unit& u, LAS unsigned char* sp, int par, int tid) const { if (tid < 256) { const int col = u.pn * 256 + tid; ((LAS float*)(sp + par * 1024))[tid] = b[(col & 1) * 384 + (col >> 1)]; } }
    __device__ __forceinline__ void wide_side(const Unit&, int row, int col, const f32x4& a, const f32x4& c2, LAS unsigned char* sp, int par) const { const LAS float* bp = (const LAS float*)(sp + par * 1024) + (col & 255); const f32x4 b0 = *(const LAS f32x4*)bp, b1 = *(const LAS f32x4*)(bp + 4);
        const float y0 = (a[0] + b0[0]) * sigmoid_fast(a[1] + b0[1]), y1 = (a[2] + b0[2]) * sigmoid_fast(a[3] + b0[3]), y2 = (c2[0] + b1[0]) * sigmoid_fast(c2[1] + b1[1]), y3 = (c2[2] + b1[2]) * sigmoid_fast(c2[3] + b1[3]);
        typedef unsigned u2_ __attribute__((ext_vector_type(2))); u2_ w; w.x = pk2(y0, y1); w.y = pk2(y2, y3); *(__attribute__((address_space(1))) u2_*)(yb + (size_t)row * 384 + (col >> 1)) = w; } };
struct EpiNullW { static constexpr bool SIDE = false; __device__ __forceinline__ void wide(const Unit&, int, int, const f32x4&, const f32x4&) const {} };
struct EpiMoe1F8 { static constexpr bool SIDE = true; unsigned char* act8; const float* bgu;
    __device__ __forceinline__ void load_side(const Unit& u, LAS unsigned char* sp, int par, int tid) const { if (tid < 256) ((LAS float*)(sp + par * 1024))[tid] = bgu[(size_t)u.e * 2048 + u.pn * 256 + tid]; }
    __device__ __forceinline__ void wide_side(const Unit& u, int row, int col, const f32x4& a, const f32x4& c2, LAS unsigned char* sp, int par) const { const LAS float* bp = (const LAS float*)(sp + par * 1024) + (col & 255); const f32x4 b0 = *(const LAS f32x4*)bp, b1 = *(const LAS f32x4*)(bp + 4); float r[4];
#pragma unroll
        for (int q = 0; q < 4; ++q) { float g = (q < 2 ? a[2 * q] : c2[2 * q - 4]) * W8_INV + (q < 2 ? b0[2 * q] : b1[2 * q - 4]), up = (q < 2 ? a[2 * q + 1] : c2[2 * q - 3]) * W8_INV + (q < 2 ? b0[2 * q + 1] : b1[2 * q - 3]);
            g = __builtin_fminf(g, 7.f); up = __builtin_amdgcn_fmed3f(up, -7.f, 7.f); r[q] = (up + 1.f) * (g * __builtin_amdgcn_rcpf(1.f + __builtin_amdgcn_exp2f(g * -2.4554669595930157f))); }
        *(__attribute__((address_space(1))) unsigned*)(act8 + (size_t)row * 1024 + (col >> 1)) = f32x2_to_fp8(r[0], r[1]) | (f32x2_to_fp8(r[2], r[3]) << 16); }
    __device__ __forceinline__ void wide(const Unit& u, int row, int col, const f32x4& a, const f32x4& c2) const { const float* bp = bgu + (size_t)u.e * 2048 + col; const f32x4 b0 = *(const f32x4*)bp, b1 = *(const f32x4*)(bp + 4); float r[4];
#pragma unroll
        for (int q = 0; q < 4; ++q) { float g = (q < 2 ? a[2 * q] : c2[2 * q - 4]) * W8_INV + (q < 2 ? b0[2 * q] : b1[2 * q - 4]), up = (q < 2 ? a[2 * q + 1] : c2[2 * q - 3]) * W8_INV + (q < 2 ? b0[2 * q + 1] : b1[2 * q - 3]);
            g = __builtin_fminf(g, 7.f); up = __builtin_amdgcn_fmed3f(up, -7.f, 7.f); r[q] = (up + 1.f) * (g * __builtin_amdgcn_rcpf(1.f + __builtin_amdgcn_exp2f(g * -2.4554669595930157f))); }
        *(unsigned*)(act8 + (size_t)row * 1024 + (col >> 1)) = f32x2_to_fp8(r[0], r[1]) | (f32x2_to_fp8(r[2], r[3]) << 16); }
    __device__ __forceinline__ void operator()(const Unit& u, int row, int col, const f32x4& v) const { const float* b = bgu + (size_t)u.e * 2048 + col; float r[2];
        for (int q = 0; q < 2; ++q) { float g = v[2 * q] * W8_INV + b[2 * q], up = v[2 * q + 1] * W8_INV + b[2 * q + 1]; g = g < 7.f ? g : 7.f; up = up < -7.f ? -7.f : (up > 7.f ? 7.f : up);
            r[q] = (up + 1.f) * (g * sigmoid_fast(1.702f * g)); }
        *(unsigned short*)(act8 + (size_t)row * 1024 + (col >> 1)) = (unsigned short)f32x2_to_fp8(r[0], r[1]); } };
struct EpiMoe2F8 { static constexpr bool SIDE = true; bf16_t* yexp; const float* bdn; const float* rowgate;
    __device__ __forceinline__ void load_side(const Unit& u, LAS unsigned char* sp, int par, int tid) const { if (tid < 256) ((LAS float*)(sp + par * 1024))[tid] = bdn[(size_t)u.e * 1024 + u.pn * 256 + tid]; else ((LAS float*)(sp + 2048 + par * 1024))[tid - 256] = rowgate[u.pm * 256 + tid - 256]; }
    __device__ __forceinline__ void wide_side(const Unit& u, int row, int col, const f32x4& a, const f32x4& c2, LAS unsigned char* sp, int par) const { typedef unsigned u4_ __attribute__((ext_vector_type(4))); const LAS float* bp = (const LAS float*)(sp + par * 1024) + (col & 255); const f32x4 b0 = *(const LAS f32x4*)bp, b1 = *(const LAS f32x4*)(bp + 4);
        const float g = ((const LAS float*)(sp + 2048 + par * 1024))[row & 255];
        u4_ w; w.x = pk2((a[0] * W8_INV + b0[0]) * g, (a[1] * W8_INV + b0[1]) * g); w.y = pk2((a[2] * W8_INV + b0[2]) * g, (a[3] * W8_INV + b0[3]) * g); w.z = pk2((c2[0] * W8_INV + b1[0]) * g, (c2[1] * W8_INV + b1[1]) * g); w.w = pk2((c2[2] * W8_INV + b1[2]) * g, (c2[3] * W8_INV + b1[3]) * g);
        *(__attribute__((address_space(1))) u4_*)(yexp + (size_t)row * 1024 + col) = w; }
    __device__ __forceinline__ void wide(const Unit& u, int row, int col, const f32x4& a, const f32x4& c2) const { typedef unsigned u4_ __attribute__((ext_vector_type(4))); const float* bp = bdn + (size_t)u.e * 1024 + col; const f32x4 b0 = *(const f32x4*)bp, b1 = *(const f32x4*)(bp + 4); const float g = rowgate[row];
        u4_ w; w.x = pk2((a[0] * W8_INV + b0[0]) * g, (a[1] * W8_INV + b0[1]) * g); w.y = pk2((a[2] * W8_INV + b0[2]) * g, (a[3] * W8_INV + b0[3]) * g); w.z = pk2((c2[0] * W8_INV + b1[0]) * g, (c2[1] * W8_INV + b1[1]) * g); w.w = pk2((c2[2] * W8_INV + b1[2]) * g, (c2[3] * W8_INV + b1[3]) * g);
        *(u4_*)(yexp + (size_t)row * 1024 + col) = w; }
    __device__ __forceinline__ void operator()(const Unit& u, int row, int col, const f32x4& v) const { const float* b = bdn + (size_t)u.e * 1024 + col; const float g = rowgate[row];
        st_bf16x4(yexp + (size_t)row * 1024 + col, (v[0] * W8_INV + b[0]) * g, (v[1] * W8_INV + b[1]) * g, (v[2] * W8_INV + b[2]) * g, (v[3] * W8_INV + b[3]) * g); } };
#endif
HD int wmap_row(int mode, int n) { return mode == 0 ? n : (n < 384 ? 2 * n : 2 * (n - 384) + 1); }

#ifndef HOST_TEST
#ifndef LAS
#define LAS __attribute__((address_space(3)))
#endif
#define GAS __attribute__((address_space(1)))
typedef short bf16x8 __attribute__((ext_vector_type(8)));
typedef unsigned v4u __attribute__((ext_vector_type(4)));
constexpr int NWAVES = 8;

namespace pg8 {
constexpr int BM = 256, BK = 64, HALF = 128, HTB = HALF * BK * 2, STAGE_BYTES = 8 * HTB, NXCD = 8, WGM = 8;
__host__ __device__ __forceinline__ int lds_byte(int r, int c) { const int st = (r >> 4) * 2 + (c >> 5), rr = r & 15, cc = c & 31, ob = rr * 64 + cc * 2; return st * 1024 + (ob ^ (((ob >> 9) & 1) << 5)); }
__host__ __device__ __forceinline__ void stage_rc(int b, int& R, int& C) { const int st = b / 1024, sb = b % 1024, swz = sb ^ (((sb >> 9) & 1) << 5); R = (st >> 1) * 16 + swz / 64; C = (st & 1) * 32 + (swz % 64) / 2; }
struct StaticOrder {
    int nM, nN, nwg, G, c;
    __device__ __forceinline__ void init(int nM_, int nN_, int G_, int c_) { nM = nM_; nN = nN_; nwg = nM * nN; G = G_; c = c_; }
    __device__ __forceinline__ bool next(int i, Unit& u) const {
        const long L = (long)i * G + c; if (L >= nwg) return false;
        int wgid = (int)L; { const int q = nwg / NXCD, r = nwg % NXCD, xcd = wgid % NXCD, off = wgid / NXCD; wgid = (xcd < r ? xcd * (q + 1) : r * (q + 1) + (xcd - r) * q) + off; }
        const int nig = WGM * nN, gid = wgid / nig, fm = gid * WGM, gsz = (nM - fm) < WGM ? (nM - fm) : WGM;
        u.pm = fm + ((wgid % nig) % gsz); u.pn = (wgid % nig) / gsz; u.e = 0; return true;
    }
};
struct SchedPlain { StaticOrder so; const char* Bt; size_t tstepB; const int* rowtab;
    __device__ __forceinline__ bool next(int i, Unit& u) const { return so.next(i, u); }
    __device__ __forceinline__ const char* bptr(const Unit& u) const { return Bt + (size_t)u.pn * tstepB; } };
struct SchedMoe { StaticOrder so; const char* Bt; size_t tstepB, estride; const int* rowtab; const int* blke;
    __device__ __forceinline__ bool next(int i, Unit& u) const { if (!so.next(i, u)) return false; u.e = blke[u.pm]; return true; }
    __device__ __forceinline__ const char* bptr(const Unit& u) const { return Bt + (size_t)u.e * estride + (size_t)u.pn * tstepB; } };

__host__ __device__ __forceinline__ int perm32(int rho) { const int n = rho >> 4, i = rho & 15; return 8 * (i >> 2) + 4 * n + (i & 3); }
template <class Epi, class Sched, bool GATHER, bool F8 = false, bool PERM = false>
__device__ __forceinline__ void gemm_phase(LAS unsigned char* lds, const int wave_id, const bf16_t* A, const int K, const Sched& S, const Epi& E) {
    int lane_ = (int)__builtin_amdgcn_mbcnt_hi(~0u, __builtin_amdgcn_mbcnt_lo(~0u, 0u)); asm volatile("" : "+v"(lane_));
    const int wid = wave_id, lane = lane_, tid = wid * 64 + lane, wr = wid >> 2, wc = wid & 3, fr = lane & 15, fq = lane >> 4;
    const int nt = K / BK;
    unsigned voffA[2], voffB[2];
#pragma unroll
    for (int i = 0; i < 2; ++i) { int R, C; stage_rc(tid * 16 + i * 8192, R, C); voffA[i] = (unsigned)(R * K + C) * 2u; const int Rb = PERM ? ((R & ~31) + perm32(R & 31)) : R; voffB[i] = (unsigned)(Rb * K + C) * 2u; }
    const size_t kstep = (size_t)(BK * 2);
    const size_t hstep = (size_t)HALF * K * 2;
    const unsigned ldsw = (unsigned)wid * 1024u;
    const int aoff = lds_byte(wr * 64 + fr, fq * 8), boff = lds_byte(wc * 32 + fr, fq * 8);
#define PG8_SA(b, h) (((b) * 2 + (h)) * HTB)
#define PG8_SB(b, h) ((4 + (b) * 2 + (h)) * HTB)
#define PG8_STAGE(bufoff, gbase, voff) do { _Pragma("unroll") for (int _i = 0; _i < 2; ++_i) \
        __builtin_amdgcn_global_load_lds((const unsigned*)((const char*)(gbase) + (voff)[_i]), (LAS unsigned*)(lds + (bufoff) + ldsw + _i * 8192), 16, 0, 0); } while (0)
#define PG8_LDA(dst, b, h) do { _Pragma("unroll") for (int m = 0; m < 4; ++m) _Pragma("unroll") for (int k = 0; k < 2; ++k) dst[m][k] = *(const LAS bf16x8*)(lds + PG8_SA(b, h) + aoff + m * 2048 + k * 1024); } while (0)
#define PG8_LDB(dst, b, h) do { _Pragma("unroll") for (int n = 0; n < 2; ++n) _Pragma("unroll") for (int k = 0; k < 2; ++k) dst[n][k] = *(const LAS bf16x8*)(lds + PG8_SB(b, h) + boff + n * 2048 + k * 1024); } while (0)
#define PG8_MMA(ai, bj, At, Bt) do { __builtin_amdgcn_s_setprio(1); _Pragma("unroll") for (int m = 0; m < 4; ++m) _Pragma("unroll") for (int n = 0; n < 2; ++n) _Pragma("unroll") for (int k = 0; k < 2; ++k) \
        asm volatile("s_nop 1\n\tv_mfma_f32_16x16x32_bf16 %0, %1, %2, %0" : "+v"(acc[ai][bj][m][n]) : "v"(Bt[n][k]), "v"(At[m][k])); __builtin_amdgcn_s_setprio(0); } while (0)
    typedef int v4i_ __attribute__((ext_vector_type(4))); typedef int v8i_ __attribute__((ext_vector_type(8)));
    int sc1 = 0x7f7f7f7f; asm volatile("" : "+v"(sc1));
#define PG8_MMA8(ai, bj, At, Bt) do { __builtin_amdgcn_s_setprio(1); _Pragma("unroll") for (int m = 0; m < 4; ++m) _Pragma("unroll") for (int n = 0; n < 2; ++n) { \
        const v8i_ a8_ = __builtin_shufflevector(__builtin_bit_cast(v4i_, At[m][0]), __builtin_bit_cast(v4i_, At[m][1]), 0, 1, 2, 3, 4, 5, 6, 7), b8_ = __builtin_shufflevector(__builtin_bit_cast(v4i_, Bt[n][0]), __builtin_bit_cast(v4i_, Bt[n][1]), 0, 1, 2, 3, 4, 5, 6, 7); \
        asm volatile("s_nop 1\n\tv_mfma_scale_f32_16x16x128_f8f6f4 %0, %1, %2, %0, %3, %3 op_sel_hi:[0,0,0]" : "+v"(acc[ai][bj][m][n]) : "v"(b8_), "v"(a8_), "v"(sc1)); } __builtin_amdgcn_s_setprio(0); } while (0)
#define PG8_MM(ai, bj, At, Bt) do { if constexpr (F8) PG8_MMA8(ai, bj, At, Bt); else PG8_MMA(ai, bj, At, Bt); } while (0)
#define PG8_WAIT_V(n) asm volatile("s_waitcnt vmcnt(" #n ")" ::: "memory")
#define PG8_WAIT_L(n) asm volatile("s_waitcnt lgkmcnt(" #n ")" ::: "memory")
#define PG8_BAR __builtin_amdgcn_s_barrier()
#define PG8_SCHED __builtin_amdgcn_sched_barrier(0)
#define PG8_ROWS(u, dst) do { _Pragma("unroll") for (int h = 0; h < 2; ++h) _Pragma("unroll") for (int i = 0; i < 2; ++i) { int R, C; stage_rc(tid * 16 + i * 8192, R, C); \
        const int rix = S.rowtab[(u).pm * BM + h * HALF + R]; dst[h][i] = (unsigned)rix * (unsigned)(K * 2) + (unsigned)C * 2u; } } while (0)
#define PG8_STAGE_A(bufoff, h, koff, nx) do { if constexpr (GATHER) { _Pragma("unroll") for (int _i = 0; _i < 2; ++_i) \
            __builtin_amdgcn_global_load_lds((const unsigned*)((const char*)A + (koff) + ((nx) ? vn[h][_i] : vc[h][_i])), (LAS unsigned*)(lds + (bufoff) + ldsw + _i * 8192), 16, 0, 0); } \
        else { const char* _b = ((nx) ? nA : cA) + (h) * hstep + (koff); _Pragma("unroll") for (int _i = 0; _i < 2; ++_i) \
            __builtin_amdgcn_global_load_lds((const unsigned*)(_b + voffA[_i]), (LAS unsigned*)(lds + (bufoff) + ldsw + _i * 8192), 16, 0, 0); } } while (0)
    Unit cur, nxt; int ui = 0;
    if (!S.next(0, cur)) return;
    if constexpr (Epi::SIDE) E.load_side(cur, lds + STAGE_BYTES, 0, tid);
    f32x4 acc[2][2][4][2];
#pragma unroll
    for (int a = 0; a < 2; ++a)
#pragma unroll
        for (int b = 0; b < 2; ++b)
#pragma unroll
            for (int m = 0; m < 4; ++m)
#pragma unroll
                for (int n = 0; n < 2; ++n) acc[a][b][m][n] = (f32x4){0.f, 0.f, 0.f, 0.f};
    bf16x8 At[4][2], B0[2][2], B1[2][2];
    unsigned vc[2][2], vn[2][2];
    const size_t tstepA = 2 * hstep;
    const char* cA = (const char*)A; const char* nA = cA;
    if constexpr (GATHER) { PG8_ROWS(cur, vc); } else { cA = (const char*)A + (size_t)cur.pm * tstepA; }
    const char* cB = S.bptr(cur);
    PG8_STAGE(PG8_SB(0, 0), cB, voffB); PG8_STAGE_A(PG8_SA(0, 0), 0, 0, false); PG8_STAGE(PG8_SB(0, 1), cB + hstep, voffB); PG8_STAGE_A(PG8_SA(0, 1), 1, 0, false);
    if (wr == 1) PG8_BAR;
    PG8_WAIT_V(4); PG8_BAR;
    PG8_STAGE(PG8_SB(1, 0), cB + kstep, voffB); PG8_STAGE_A(PG8_SA(1, 0), 0, kstep, false); PG8_STAGE(PG8_SB(1, 1), cB + hstep + kstep, voffB);
    PG8_WAIT_V(6); PG8_BAR;
    for (;;) {
        const bool has_next = S.next(ui + 1, nxt);
        if constexpr (GATHER) {
            if (has_next) { PG8_ROWS(nxt, vn); } else {
#pragma unroll
                for (int h = 0; h < 2; ++h)
#pragma unroll
                    for (int i = 0; i < 2; ++i) vn[h][i] = vc[h][i]; }
        } else { nA = has_next ? (const char*)A + (size_t)nxt.pm * tstepA : cA; }
        const char* nB = has_next ? S.bptr(nxt) : cB;
        for (int t = 0; t < nt; t += 2) {
            const bool last = (t == nt - 2);
            const size_t k1 = (size_t)(t + 1) * kstep, k2 = last ? 0 : (size_t)(t + 2) * kstep, k3 = k2 + kstep;
            const char* b2 = last ? nB : cB + (size_t)(t + 2) * kstep; const char* b3 = b2 + kstep;
            PG8_LDB(B0, 0, 0); PG8_SCHED; PG8_LDA(At, 0, 0); PG8_STAGE_A(PG8_SA(1, 1), 1, k1, false);
            PG8_WAIT_L(8); PG8_BAR; PG8_WAIT_L(0); PG8_MM(0, 0, At, B0); PG8_BAR; PG8_SCHED;
            PG8_LDB(B1, 0, 1); PG8_STAGE(PG8_SB(0, 0), b2, voffB);
            PG8_BAR; PG8_WAIT_L(0); PG8_MM(0, 1, At, B1); PG8_BAR;
            PG8_LDA(At, 0, 1); PG8_STAGE_A(PG8_SA(0, 0), 0, k2, last);
            PG8_BAR; PG8_WAIT_L(0); PG8_MM(1, 0, At, B0); PG8_BAR; PG8_SCHED;
            PG8_STAGE(PG8_SB(0, 1), b2 + hstep, voffB);
            PG8_WAIT_V(6); PG8_BAR; PG8_MM(1, 1, At, B1); PG8_BAR;
            PG8_LDB(B0, 1, 0); PG8_SCHED; PG8_LDA(At, 1, 0); PG8_STAGE_A(PG8_SA(0, 1), 1, k2, last);
            PG8_WAIT_L(8); PG8_BAR; PG8_WAIT_L(0); PG8_MM(0, 0, At, B0); PG8_BAR; PG8_SCHED;
            PG8_LDB(B1, 1, 1); PG8_STAGE(PG8_SB(1, 0), b3, voffB);
            PG8_BAR; PG8_WAIT_L(0); PG8_MM(0, 1, At, B1); PG8_BAR;
            PG8_LDA(At, 1, 1); PG8_STAGE_A(PG8_SA(1, 0), 0, k3, last);
            PG8_BAR; PG8_WAIT_L(0); PG8_MM(1, 0, At, B0); PG8_BAR; PG8_SCHED;
            PG8_STAGE(PG8_SB(1, 1), b3 + hstep, voffB);
            PG8_WAIT_V(6); PG8_BAR; PG8_MM(1, 1, At, B1); PG8_BAR;
        }
        asm volatile("s_nop 15\n\ts_nop 15" : "+v"(acc[0][0][0][0]), "+v"(acc[1][1][3][1]));
        Unit eu; eu.pm = __builtin_amdgcn_readfirstlane(cur.pm); eu.pn = __builtin_amdgcn_readfirstlane(cur.pn); eu.e = __builtin_amdgcn_readfirstlane(cur.e); int rbase = wr * 64 + fr, cbase = wc * 32 + 4 * fq;
        asm volatile("" : "+s"(eu.pm), "+s"(eu.pn), "+s"(eu.e), "+v"(rbase), "+v"(cbase));
#pragma unroll
        for (int ai = 0; ai < 2; ++ai)
#pragma unroll
            for (int m = 0; m < 4; ++m) { const int row = eu.pm * BM + ai * HALF + m * 16 + rbase;
                if constexpr (PERM) {
#pragma unroll
                    for (int bj = 0; bj < 2; ++bj) { if constexpr (Epi::SIDE) E.wide_side(eu, row, eu.pn * BM + bj * HALF + 2 * cbase - (cbase & ~31), acc[ai][bj][m][0], acc[ai][bj][m][1], lds + STAGE_BYTES, ui & 1);
                        else E.wide(eu, row, eu.pn * BM + bj * HALF + 2 * cbase - (cbase & ~31), acc[ai][bj][m][0], acc[ai][bj][m][1]);
                        if constexpr (Epi::SIDE) asm volatile("" ::: "memory"); }
                } else {
#pragma unroll
                for (int bj = 0; bj < 2; ++bj)
#pragma unroll
                    for (int n = 0; n < 2; ++n) E(eu, row, eu.pn * BM + bj * HALF + n * 16 + cbase, acc[ai][bj][m][n]);
                }
                asm volatile("" ::: "memory"); }
        if (!has_next) break;
#pragma unroll
        for (int a = 0; a < 2; ++a)
#pragma unroll
            for (int b = 0; b < 2; ++b)
#pragma unroll
                for (int m = 0; m < 4; ++m)
#pragma unroll
                    for (int n = 0; n < 2; ++n) acc[a][b][m][n] = (f32x4){0.f, 0.f, 0.f, 0.f};
        cur = nxt; cB = nB; cA = nA; ++ui;
        if constexpr (Epi::SIDE) { int tid_s = tid; asm volatile("" : "+v"(tid_s)); E.load_side(cur, lds + STAGE_BYTES, ui & 1, tid_s); }
        if constexpr (GATHER) {
#pragma unroll
            for (int h = 0; h < 2; ++h)
#pragma unroll
                for (int i = 0; i < 2; ++i) vc[h][i] = vn[h][i]; }
    }
    PG8_WAIT_V(0);
    if (wr == 0) PG8_BAR;
    PG8_BAR;
#undef PG8_SA
#undef PG8_SB
#undef PG8_STAGE
#undef PG8_LDA
#undef PG8_LDB
#undef PG8_MMA
#undef PG8_MMA8
#undef PG8_MM
#undef PG8_WAIT_V
#undef PG8_WAIT_L
#undef PG8_BAR
#undef PG8_SCHED
#undef PG8_ROWS
#undef PG8_STAGE_A
}
}

#define XB_TMO      128
#define XB_XCNT(j)  (256  + 64 * (j))
#define XB_XSUB(j)  (1280 + 64 * (j))
#define XB_XGEN(j)  (2304 + 64 * (j))
#define XB_TOP      3328
#define XB_TOPGEN   3392
#define XCD_BAR_WORDS 3456
#define XB_SPIN_CAP (1u << 18)
__device__ __forceinline__ unsigned xb_ld(unsigned* p)              { return __hip_atomic_load(p, __ATOMIC_RELAXED, __HIP_MEMORY_SCOPE_AGENT); }
__device__ __forceinline__ unsigned xb_add(unsigned* p, unsigned v) { return __hip_atomic_fetch_add(p, v, __ATOMIC_RELAXED, __HIP_MEMORY_SCOPE_AGENT); }
__device__ __forceinline__ unsigned xb_xcc_id() { return (unsigned)__builtin_amdgcn_s_getreg((3 << 11) | 20) & 0xFu; }
#define XB_SPIN(cond, bar) do { unsigned _sp = 0; while (cond) { __builtin_amdgcn_s_sleep(1); \
    if ((++_sp & 255u) == 0u) { if (xb_ld(&(bar)[XB_TMO])) break; if (_sp > XB_SPIN_CAP) { atomicAdd(&(bar)[XB_TMO], 1u); break; } } } } while (0)
struct XcdBarrier { unsigned* bar; unsigned x; volatile LAS unsigned* st; };
__device__ __forceinline__ XcdBarrier xcd_barrier_post(unsigned* bar, volatile LAS unsigned* st) {
    XcdBarrier b; b.bar = bar; b.x = xb_xcc_id(); b.st = st;
    if (threadIdx.x == 0) (void)xb_add(&bar[XB_XCNT(b.x)], 1u);
    return b;
}
__device__ __forceinline__ void xcd_barrier_complete(unsigned* bar, unsigned x, unsigned& nloc, unsigned& nx) {
    const unsigned G = gridDim.x * gridDim.y * gridDim.z;
    unsigned sum, cnt, mine, sp = 0u;
    for (;;) {
        sum = 0u; cnt = 0u; mine = 0u;
#pragma unroll
        for (unsigned j = 0; j < 16; ++j) { const unsigned c = xb_ld(&bar[XB_XCNT(j)]); sum += c; cnt += (c > 0u) ? 1u : 0u; mine = (j == x) ? c : mine; }
        if (sum == G) break;
        __builtin_amdgcn_s_sleep(1);
        if ((++sp & 255u) == 0u) { if (xb_ld(&bar[XB_TMO])) break; if (sp > XB_SPIN_CAP) { atomicAdd(&bar[XB_TMO], 1u); break; } }
    }
    nloc = mine > 0u ? mine : 1u; nx = cnt > 0u ? cnt : 1u;
}
__device__ __forceinline__ void xcd_barrier(const XcdBarrier& b, const bool leader) {
    asm volatile("s_waitcnt vmcnt(0)" ::: "memory");
    __syncthreads();
    if (leader) {
        unsigned* bar = b.bar;
        __builtin_amdgcn_s_waitcnt(0);
        unsigned nloc = b.st[0], nx = b.st[1];
        if (nloc == 0u) { xcd_barrier_complete(bar, b.x, nloc, nx); b.st[0] = nloc; b.st[1] = nx; }
        const unsigned old = xb_add(&bar[XB_XSUB(b.x)], 1u);
        const unsigned gen = old / nloc;
        if (old + 1u == (gen + 1u) * nloc) {
            __builtin_amdgcn_fence(__ATOMIC_RELEASE, "agent");
            asm volatile("s_waitcnt vmcnt(0)" ::: "memory");
            const unsigned og = xb_add(&bar[XB_TOP], 1u);
            const unsigned tg = og / nx;
            if (og + 1u == (tg + 1u) * nx) xb_add(&bar[XB_TOPGEN], 1u);
            else XB_SPIN(xb_ld(&bar[XB_TOPGEN]) == tg, bar);
            __builtin_amdgcn_fence(__ATOMIC_ACQUIRE, "agent");
            xb_add(&bar[XB_XGEN(b.x)], 1u);
            asm volatile("s_waitcnt vmcnt(0)" ::: "memory");
        } else {
            XB_SPIN(xb_ld(&bar[XB_XGEN(b.x)]) == gen, bar);
            __builtin_amdgcn_fence(__ATOMIC_ACQUIRE, "agent");
            asm volatile("s_waitcnt vmcnt(0)" ::: "memory");
        }
    }
    __syncthreads();
}

constexpr int RING_BYTES = 131072, LDSCTL_OFF = 143616, LDS_BYTES = 147456;

__device__ __forceinline__ void transpose_item(const float* W, int K, int N, bf16_t* WT, int mode, const float* scale, LAS float* scr, int item, int lane) {
    const int nblk = N / 64, kb = item / nblk, nb = item % nblk, k0 = 64 * kb, n0 = 64 * nb;
    const int n4 = (lane & 15) * 4, kr = lane >> 4;
#pragma unroll 8
    for (int i = 0; i < 16; ++i) { const int kk = 4 * i + kr; f32x4 w = __builtin_nontemporal_load((const __attribute__((address_space(1))) f32x4*)(W + (size_t)(k0 + kk) * N + n0 + n4)); if (scale) w = w * *(const __attribute__((address_space(1))) float*)(scale + k0 + kk);
        scr[kk * 65 + n4] = w[0]; scr[kk * 65 + n4 + 1] = w[1]; scr[kk * 65 + n4 + 2] = w[2]; scr[kk * 65 + n4 + 3] = w[3]; }
    asm volatile("s_waitcnt lgkmcnt(0)" ::: "memory");
    const int c = lane & 7;
#pragma unroll
    for (int j = 0; j < 8; ++j) { const int n = (lane >> 3) + 8 * j; const LAS float* s = scr + (8 * c) * 65 + n;
        v4u o; o.x = pk2(s[0 * 65], s[1 * 65]); o.y = pk2(s[2 * 65], s[3 * 65]); o.z = pk2(s[4 * 65], s[5 * 65]); o.w = pk2(s[6 * 65], s[7 * 65]);
        *(__attribute__((address_space(1))) v4u*)(WT + (size_t)wmap_row(mode, n0 + n) * K + k0 + 8 * c) = o; }
    asm volatile("s_waitcnt lgkmcnt(0)" ::: "memory");
}

__device__ __forceinline__ void transpose_item8(const float* W, int K, int N, unsigned char* WT, const float* scale, LAS float* scr, int item, int lane) {
    const int nblk = N / 64, kb = item / nblk, nb = item % nblk, k0 = 64 * kb, n0 = 64 * nb;
    const int n4 = (lane & 15) * 4, kr = lane >> 4;
#pragma unroll 8
    for (int i = 0; i < 16; ++i) { const int kk = 4 * i + kr; f32x4 w = __builtin_nontemporal_load((const __attribute__((address_space(1))) f32x4*)(W + (size_t)(k0 + kk) * N + n0 + n4)); w = w * (scale ? *(const __attribute__((address_space(1))) float*)(scale + k0 + kk) * W8_SCALE : W8_SCALE);
        scr[kk * 65 + n4] = w[0]; scr[kk * 65 + n4 + 1] = w[1]; scr[kk * 65 + n4 + 2] = w[2]; scr[kk * 65 + n4 + 3] = w[3]; }
    asm volatile("s_waitcnt lgkmcnt(0)" ::: "memory");
    const int c = lane & 3;
#pragma unroll
    for (int j = 0; j < 4; ++j) { const int n = (lane >> 2) + 16 * j; const LAS float* s = scr + (16 * c) * 65 + n; v4u o;
        o.x = f32x2_to_fp8(s[0 * 65], s[1 * 65]) | (f32x2_to_fp8(s[2 * 65], s[3 * 65]) << 16); o.y = f32x2_to_fp8(s[4 * 65], s[5 * 65]) | (f32x2_to_fp8(s[6 * 65], s[7 * 65]) << 16);
        o.z = f32x2_to_fp8(s[8 * 65], s[9 * 65]) | (f32x2_to_fp8(s[10 * 65], s[11 * 65]) << 16); o.w = f32x2_to_fp8(s[12 * 65], s[13 * 65]) | (f32x2_to_fp8(s[14 * 65], s[15 * 65]) << 16);
        *(__attribute__((address_space(1))) v4u*)(WT + (size_t)(n0 + n) * K + k0 + 16 * c) = o; }
    asm volatile("s_waitcnt lgkmcnt(0)" ::: "memory");
}

template <class CT>
__device__ __forceinline__ void router_logits16(const CT& c, int l, int t0, int lane, LAS float* lgs) {
    const int fr = lane & 15, fq = lane >> 4;
    const bf16_t* xa = (const bf16_t*)c.X() + (size_t)(t0 + fr) * D + 8 * fq;
    const bf16_t* wh = (const bf16_t*)c.rwt() + ((size_t)(l * 2) * NE + fr) * 1024 + 8 * fq;
    f32x4 acc0 = (f32x4){0.f, 0.f, 0.f, 0.f}, acc1 = (f32x4){0.f, 0.f, 0.f, 0.f};
#pragma unroll 8
    for (int ks = 0; ks < 32; ++ks) {
        const bf16x8 a = *(const bf16x8*)(xa + 32 * ks);
        const bf16x8 bh0 = *(const bf16x8*)(wh + 32 * ks), bh1 = *(const bf16x8*)(wh + 16 * 1024 + 32 * ks), bl0 = *(const bf16x8*)(wh + NE * 1024 + 32 * ks), bl1 = *(const bf16x8*)(wh + (NE + 16) * 1024 + 32 * ks);
        asm volatile("s_nop 1\n\tv_mfma_f32_16x16x32_bf16 %0, %1, %2, %0" : "+v"(acc0) : "v"(a), "v"(bh0));
        asm volatile("s_nop 1\n\tv_mfma_f32_16x16x32_bf16 %0, %1, %2, %0" : "+v"(acc1) : "v"(a), "v"(bh1));
        asm volatile("s_nop 1\n\tv_mfma_f32_16x16x32_bf16 %0, %1, %2, %0" : "+v"(acc0) : "v"(a), "v"(bl0));
        asm volatile("s_nop 1\n\tv_mfma_f32_16x16x32_bf16 %0, %1, %2, %0" : "+v"(acc1) : "v"(a), "v"(bl1)); }
    asm volatile("s_nop 15\n\ts_nop 15" : "+v"(acc0), "+v"(acc1));
#pragma unroll
    for (int j = 0; j < 4; ++j) { lgs[(4 * fq + j) * 32 + fr] = acc0[j]; lgs[(4 * fq + j) * 32 + 16 + fr] = acc1[j]; }
    asm volatile("s_waitcnt lgkmcnt(0)" ::: "memory");
}

constexpr int RB = 4;
template <class CT>
__device__ __forceinline__ void router_rows(const CT& c, int l, int t0, int lane, LAS int* park, const LAS float* lgs, const bool dummy = false) {
    float rstd_r[RB];
#pragma unroll
    for (int r = 0; r < RB; ++r) { const bf16_t* xr = (const bf16_t*)c.X() + (size_t)(t0 + r) * D; float ss = 0.f; f32x4 v[4];
#pragma unroll
        for (int j = 0; j < 4; ++j) { const uint2 xw_ = *(const uint2*)(xr + 4 * lane + 256 * j);
            v[j] = (f32x4){__builtin_bit_cast(float, xw_.x << 16), __builtin_bit_cast(float, xw_.x & 0xffff0000u), __builtin_bit_cast(float, xw_.y << 16), __builtin_bit_cast(float, xw_.y & 0xffff0000u)}; ss += v[j][0] * v[j][0] + v[j][1] * v[j][1] + v[j][2] * v[j][2] + v[j][3] * v[j][3]; }
        const float rstd = 1.f / sqrtf(wsum(ss) * (1.f / D) + EPS); rstd_r[r] = rstd;
        unsigned char* orow = (dummy ? (unsigned char*)c.yexp() : c.hq()) + (size_t)(t0 + r) * D;
#pragma unroll
        for (int j = 0; j < 4; ++j) { v[j] = v[j] * rstd; *(unsigned*)(orow + 4 * lane + 256 * j) = f32x2_to_fp8(v[j][0], v[j][1]) | (f32x2_to_fp8(v[j][2], v[j][3]) << 16); } }
    float lg[RB];
#pragma unroll
    for (int r = 0; r < RB; ++r) lg[r] = lgs[r * 32 + (lane & 7) * 4 + (lane >> 4)] * rstd_r[r];
    const int e = (lane & 7) * 4 + (lane >> 4);
    const float rb = c.in[I_RB][l * NE + e];
#pragma unroll
    for (int r = 0; r < RB; ++r) { const int t = t0 + r;
        const float lgr = lg[r] + rb;
        unsigned ub = __builtin_bit_cast(unsigned, lgr); ub ^= (ub >> 31) ? 0xffffffffu : 0x80000000u;
        unsigned long long key = ((unsigned long long)ub << 32) | (unsigned)(31 - e);
        int se[4]; float sv[4];
#pragma unroll
        for (int q = 0; q < 4; ++q) { unsigned long long m = key;
#pragma unroll
            for (int o = 1; o < 64; o <<= 1) { const unsigned long long qq = __shfl_xor(m, o); m = qq > m ? qq : m; }
            const int we = 31 - (int)(m & 31u); unsigned wb = (unsigned)(m >> 32); wb ^= (wb >> 31) ? 0x80000000u : 0xffffffffu;
            se[q] = we; sv[q] = __builtin_bit_cast(float, wb); if (e == we) key = 0ull; }
        const float mx = sv[0]; float ex[4], sum = 0.f;
#pragma unroll
        for (int q = 0; q < 4; ++q) { ex[q] = __builtin_amdgcn_exp2f((sv[q] - mx) * 1.4426950408889634f); sum += ex[q]; }
        const float rsum = __builtin_amdgcn_rcpf(sum);
        if (lane == 0) {
#pragma unroll
            for (int q = 0; q < 4; ++q) { if (!dummy) { c.tke()[t * 4 + q] = se[q]; c.tkg()[t * 4 + q] = ex[q] * rsum; } park[r * 4 + q] = se[q]; } }
    }
}

constexpr int S5_PITCH = 272, S5_ROWS = 33, S5_LDS_WAVE = 2 * S5_ROWS * S5_PITCH;
template <bool FINAL, class CT>
__device__ __forceinline__ void s5_tile_dev(const CT& c, const int l, const int tile, const int g, LAS unsigned char* sl, const int lane) {
    const int fr = lane & 15, fq = lane >> 4;
    const int b = tile / NT, ct = tile % NT, t0 = b * SEQ + ct * LC;
    bf16x8 uf[2][2];
#pragma unroll
    for (int m = 0; m < 2; ++m)
#pragma unroll
        for (int ks = 0; ks < 2; ++ks) uf[m][ks] = *(const bf16x8*)(c.z() + (size_t)(t0 + 4 * (16 * m + fr) + 2 * ks + (fq >> 1)) * D_INP + 256 + 16 * g + 8 * (fq & 1));
#pragma unroll
    for (int dir = 0; dir < 2; ++dir) {
        f32x4 acc[2][8];
#pragma unroll
        for (int m = 0; m < 2; ++m)
#pragma unroll
            for (int nt = 0; nt < 8; ++nt) acc[m][nt] = (f32x4){0.f, 0.f, 0.f, 0.f};
        const bf16_t* w = c.w4t() + (size_t)((l * 24 + g) * 2 + dir) * 128 * 64;
#pragma unroll
        for (int ks = 0; ks < 2; ++ks)
#pragma unroll
            for (int nt = 0; nt < 8; ++nt) { const bf16x8 wf = *(const bf16x8*)(w + (16 * nt + fr) * 64 + 32 * ks + 8 * fq);
#pragma unroll
                for (int m = 0; m < 2; ++m) asm volatile("s_nop 1\n\tv_mfma_f32_16x16x32_bf16 %0, %1, %2, %0" : "+v"(acc[m][nt]) : "v"(wf), "v"(uf[m][ks])); }
        asm volatile("s_nop 15\n\ts_nop 15\n\ts_nop 15\n\ts_nop 15" : "+v"(acc[0][0]), "+v"(acc[0][1]), "+v"(acc[0][2]), "+v"(acc[0][3]), "+v"(acc[0][4]), "+v"(acc[0][5]), "+v"(acc[0][6]), "+v"(acc[0][7]),
                                               "+v"(acc[1][0]), "+v"(acc[1][1]), "+v"(acc[1][2]), "+v"(acc[1][3]), "+v"(acc[1][4]), "+v"(acc[1][5]), "+v"(acc[1][6]), "+v"(acc[1][7]));
#pragma unroll
        for (int m = 0; m < 2; ++m)
#pragma unroll
            for (int nt = 0; nt < 8; ++nt) { const int row = 16 * m + fr + (dir ? 0 : 1);
                unsigned lo = pk2(acc[m][nt][0], acc[m][nt][1]), hi = pk2(acc[m][nt][2], acc[m][nt][3]);
                *(LAS unsigned long long*)(sl + (dir * S5_ROWS + row) * S5_PITCH + (16 * nt + 4 * fq) * 2) = (unsigned long long)lo | ((unsigned long long)hi << 32); }
    }
    asm volatile("s_waitcnt lgkmcnt(0)" ::: "memory");
    {
        const int p = lane;
#pragma unroll
        for (int dir = 0; dir < 2; ++dir) {
            const int ci = ((l * 2 + dir) * 24 + g) * 64 + p;
            const float a4r = c.s5pow()[(size_t)ci * 8], a4i = c.s5pow()[(size_t)ci * 8 + 1];
            const size_t io = ((size_t)(b * NT + ct) * 3072 + dir * 1536 + g * 64 + p) * 2;
            float sr = 0.f, si = 0.f;
            LAS bf16_t* base = (LAS bf16_t*)(sl + dir * S5_ROWS * S5_PITCH);
            if (FINAL) { const float2 cin = *(const float2*)(c.s5in() + io); sr = cin.x; si = cin.y;
                const int crow = dir ? 32 : 0; base[crow * (S5_PITCH / 2) + p] = (bf16_t)f2bf(sr); base[crow * (S5_PITCH / 2) + 64 + p] = (bf16_t)f2bf(si); }
#pragma unroll 8
            for (int q = 0; q < 32; ++q) { const int row = dir ? 31 - q : q + 1;
                const float gr = bf2f(base[row * (S5_PITCH / 2) + p]), gi = bf2f(base[row * (S5_PITCH / 2) + 64 + p]);
                const float nr = a4r * sr - a4i * si + gr, ni = a4r * si + a4i * sr + gi; sr = nr; si = ni;
                if (FINAL) { base[row * (S5_PITCH / 2) + p] = (bf16_t)f2bf(sr); base[row * (S5_PITCH / 2) + 64 + p] = (bf16_t)f2bf(si); } }
            if (!FINAL) { float2 e2; e2.x = sr; e2.y = si; *(float2*)(c.s5e() + io) = e2; }
        }
    }
    if (FINAL) {
        asm volatile("s_waitcnt lgkmcnt(0)" ::: "memory");
        f32x4 ya[4][2];
#pragma unroll
        for (int mj = 0; mj < 4; ++mj)
#pragma unroll
            for (int nt = 0; nt < 2; ++nt) ya[mj][nt] = (f32x4){0.f, 0.f, 0.f, 0.f};
        const bf16_t* ym = c.ymat() + (size_t)(l * 24 + g) * 64 * 320;
        bf16x8 bq[8][2];
#pragma unroll
        for (int ks = 0; ks < 8; ++ks)
#pragma unroll
            for (int nt = 0; nt < 2; ++nt) bq[ks][nt] = ks < 4 ? *(const LAS bf16x8*)(sl + (16 * nt + fr) * S5_PITCH + (32 * ks + 8 * fq) * 2) : *(const LAS bf16x8*)(sl + (S5_ROWS + 16 * nt + fr + 1) * S5_PITCH + (32 * (ks - 4) + 8 * fq) * 2);
#pragma unroll
        for (int ks = 0; ks < 10; ++ks) {
            bf16x8 af[4], bfr[2];
#pragma unroll
            for (int mj = 0; mj < 4; ++mj) af[mj] = *(const bf16x8*)(ym + (16 * mj + fr) * 320 + 32 * ks + 8 * fq);
#pragma unroll
            for (int nt = 0; nt < 2; ++nt) { if (ks < 8) bfr[nt] = bq[ks][nt]; else bfr[nt] = uf[nt][ks - 8]; }
#pragma unroll
            for (int mj = 0; mj < 4; ++mj)
#pragma unroll
                for (int nt = 0; nt < 2; ++nt) asm volatile("s_nop 1\n\tv_mfma_f32_16x16x32_bf16 %0, %1, %2, %0" : "+v"(ya[mj][nt]) : "v"(af[mj]), "v"(bfr[nt]));
        }
        asm volatile("s_nop 15\n\ts_nop 15\n\ts_nop 15\n\ts_nop 15" : "+v"(ya[0][0]), "+v"(ya[0][1]), "+v"(ya[1][0]), "+v"(ya[1][1]), "+v"(ya[2][0]), "+v"(ya[2][1]), "+v"(ya[3][0]), "+v"(ya[3][1]));
#pragma unroll
        for (int mj = 0; mj < 4; ++mj)
#pragma unroll
            for (int nt = 0; nt < 2; ++nt) { const f32x4 y = ya[mj][nt];
                st_bf16x4(c.v() + (size_t)(t0 + 4 * (16 * nt + fr) + mj) * 384 + 16 * g + 4 * fq, gelu_tanh(y[0]), gelu_tanh(y[1]), gelu_tanh(y[2]), gelu_tanh(y[3])); }
    }
    asm volatile("s_waitcnt lgkmcnt(0)" ::: "memory");
}

#define MFMA16(acc_, a_, b_) asm volatile("s_nop 1\n\tv_mfma_f32_16x16x32_bf16 %0, %1, %2, %0" : "+v"(acc_) : "v"(a_), "v"(b_))
#define MFMA_FENCE8(x_) asm volatile("s_nop 15\n\ts_nop 15" : "+v"(x_[0]), "+v"(x_[1]), "+v"(x_[2]), "+v"(x_[3]), "+v"(x_[4]), "+v"(x_[5]), "+v"(x_[6]), "+v"(x_[7]))
template <class CT>
__device__ __forceinline__ void mixer_tile_dev(const CT& c, const int l, const int tile, LAS unsigned char* lds, const int wave, const int lane) {
    const int tid = wave * 64 + lane, fr = lane & 15, fq = lane >> 4;
    const int b = tile / NT, ct = tile % NT, s0 = ct * LC, t0 = b * SEQ + s0;
    {
        LAS bf16_t* dt = (LAS bf16_t*)lds;
        LAS float* ssqp = (LAS float*)(lds + 67584);
        LAS bf16_t* zp = (LAS bf16_t*)(lds + 71680);
#pragma unroll 1
        for (int g4 = 0; g4 < 4; ++g4) {
            { v4u pz[3];
#pragma unroll
              for (int i = 0; i < 3; ++i) { const int p = tid + 512 * i, q = s0 - 8 + (p >> 3);
                  pz[i] = (p < 1152 && q >= 0 && q < SEQ) ? *(const GAS v4u*)(c.z() + (size_t)(b * SEQ + q) * D_INP + g4 * 64 + (p & 7) * 8) : (v4u){0u, 0u, 0u, 0u}; }
#pragma unroll
              for (int i = 0; i < 3; ++i) { const int p = tid + 512 * i; if (p < 1152) *(LAS v4u*)(zp + (p >> 3) * 72 + (p & 7) * 8) = pz[i]; } }
            __syncthreads();
            { const int cc = tid & 63, tq = tid >> 6, half = 1 << g4, tb = tq * 16, sb = s0 + tb;
              int lo = sb - half < 0 ? 0 : sb - half, hi = sb + half > SEQ ? SEQ : sb + half; float sum = 0.f;
              for (int q = lo; q < hi; ++q) sum += bf2f(zp[(q - s0 + 8) * 72 + cc]);
#pragma unroll 4
              for (int t = tb; t < tb + 16; ++t) { const int s = s0 + t;
                  dt[t * 264 + g4 * 64 + cc] = (bf16_t)f2bf(sum * __builtin_amdgcn_rcpf((float)(hi - lo)) - bf2f(zp[(t + 8) * 72 + cc]));
                  const int nlo = s + 1 - half < 0 ? 0 : s + 1 - half, nhi = s + 1 + half > SEQ ? SEQ : s + 1 + half;
                  if (nhi > hi) sum += bf2f(zp[(hi - s0 + 8) * 72 + cc]);
                  if (nlo > lo) sum -= bf2f(zp[(lo - s0 + 8) * 72 + cc]);
                  lo = nlo; hi = nhi; } }
            __syncthreads();
        }
        const int g = wave >> 1, nbase = (wave & 1) * 32;
        f32x4 acc0[8], acc1[8];
#pragma unroll
        for (int m = 0; m < 8; ++m) { acc0[m] = (f32x4){0.f, 0.f, 0.f, 0.f}; acc1[m] = (f32x4){0.f, 0.f, 0.f, 0.f}; }
#pragma unroll
        for (int ks = 0; ks < 2; ++ks) {
            const bf16x8 w0 = *(const bf16x8*)(c.poolw_t() + ((size_t)(l * 4 + g) * 64 + nbase + fr) * 64 + 32 * ks + 8 * fq);
            const bf16x8 w1 = *(const bf16x8*)(c.poolw_t() + ((size_t)(l * 4 + g) * 64 + nbase + 16 + fr) * 64 + 32 * ks + 8 * fq);
#pragma unroll
            for (int m = 0; m < 8; ++m) { const bf16x8 df = *(const LAS bf16x8*)(lds + (16 * m + fr) * 528 + (g * 64 + 32 * ks + 8 * fq) * 2);
                MFMA16(acc0[m], w0, df); MFMA16(acc1[m], w1, df); } }
        MFMA_FENCE8(acc0); MFMA_FENCE8(acc1);
        const int ch0 = g * 64 + nbase + 4 * fq;
        const f32x4 sc0 = *(const f32x4*)(c.in[I_POOLS] + l * 256 + ch0), sc1 = *(const f32x4*)(c.in[I_POOLS] + l * 256 + ch0 + 16);
#pragma unroll
        for (int m = 0; m < 8; ++m) { acc0[m] = acc0[m] * sc0; acc1[m] = acc1[m] * sc1;
            float s = acc0[m][0] * acc0[m][0] + acc0[m][1] * acc0[m][1] + acc0[m][2] * acc0[m][2] + acc0[m][3] * acc0[m][3] + acc1[m][0] * acc1[m][0] + acc1[m][1] * acc1[m][1] + acc1[m][2] * acc1[m][2] + acc1[m][3] * acc1[m][3];
            s += __shfl_xor(s, 16); s += __shfl_xor(s, 32);
            if (fq == 0) ssqp[(16 * m + fr) * 8 + wave] = s; }
        __syncthreads();
#pragma unroll
        for (int m = 0; m < 8; ++m) { const f32x4 pa = *(const LAS f32x4*)(ssqp + (16 * m + fr) * 8), pb = *(const LAS f32x4*)(ssqp + (16 * m + fr) * 8 + 4);
            const float rstd = 1.f / sqrtf(((pa[0] + pa[1]) + (pa[2] + pa[3]) + (pb[0] + pb[1]) + (pb[2] + pb[3])) * (1.f / 256) + EPS);
            bf16_t* orow = c.o() + (size_t)(t0 + 16 * m + fr) * D + ch0;
            st_bf16x4(orow, acc0[m][0] * rstd, acc0[m][1] * rstd, acc0[m][2] * rstd, acc0[m][3] * rstd);
            st_bf16x4(orow + 16, acc1[m][0] * rstd, acc1[m][1] * rstd, acc1[m][2] * rstd, acc1[m][3] * rstd); }
        __syncthreads();
    }
    LAS bf16_t* xcs = (LAS bf16_t*)lds;
    LAS float* As = (LAS float*)(lds + 18432);
    LAS bf16_t* Bs = (LAS bf16_t*)(lds + 88064);
    LAS float* Seg = (LAS float*)(lds + 124928);
    bf16_t tz[17];
#define LRU_SLAB_LOAD(h_) do { int tq_ = tid; asm volatile("" : "+v"(tq_)); _Pragma("unroll") for (int i_ = 0; i_ < 17; ++i_) { const int e2_ = tq_ + 512 * i_, q_ = s0 - 1 + (e2_ >> 6); \
        tz[i_] = ((i_ < 16 || e2_ < 131 * 64) && q_ >= 0 && q_ < SEQ) ? c.z()[(size_t)(b * SEQ + q_) * D_INP + 640 + (h_) * 64 + (e2_ & 63)] : (bf16_t)0; } } while (0)
    LRU_SLAB_LOAD(0);
#pragma unroll 1
    for (int h = 0; h < 6; ++h) {
        int cc; float cb, w0, w1, w2, w3; bf16x8 gwa[2], gwx[2]; f32x4 gba, gbx, glam;
        { LAS bf16_t* zs = (LAS bf16_t*)As;
          { int tq = tid; asm volatile("" : "+v"(tq));
            cc = tq & 63; { const int ch = h * 64 + cc; const float* cwp = c.in[I_CONVW] + l * 4 * 384 + ch; cb = c.in[I_CONVB][l * 384 + ch]; w0 = cwp[0]; w1 = cwp[384]; w2 = cwp[768]; w3 = cwp[1152]; }
            { const bf16_t* wbase = c.lruw_t() + ((size_t)(((l * 2 + (wave >> 2)) * 6 + h) * 2) * 64 + (wave & 3) * 16 + (tq & 15)) * 64 + 8 * ((tq >> 4) & 3);
#pragma unroll
              for (int ks = 0; ks < 2; ++ks) { gwa[ks] = *(const bf16x8*)(wbase + 32 * ks); gwx[ks] = *(const bf16x8*)(wbase + 4096 + 32 * ks); }
              const int pi = (l * 2 + (wave >> 2)) * 384 + h * 64 + (wave & 3) * 16 + 4 * ((tq >> 4) & 3);
              gba = *(const f32x4*)(c.in[I_BA] + pi); gbx = *(const f32x4*)(c.in[I_BX] + pi); glam = *(const f32x4*)((const float*)c.ctl() + SP8_OFF / 4 + pi); }
#pragma unroll
            for (int i = 0; i < 17; ++i) { const int e2 = tq + 512 * i; if (i < 16 || e2 < 131 * 64) zs[(e2 >> 6) * 72 + (e2 & 63)] = tz[i]; } }
          __syncthreads();
#pragma unroll 4
          for (int i = 0; i < 16; ++i) { const int t = (tid >> 6) + 8 * i;
              const float a = cb + w0 * bf2f(zs[t * 72 + cc]) + w1 * bf2f(zs[(t + 1) * 72 + cc]) + w2 * bf2f(zs[(t + 2) * 72 + cc]) + w3 * bf2f(zs[(t + 3) * 72 + cc]);
              xcs[t * 72 + cc] = (bf16_t)f2bf(a); } }
        if (h < 5) LRU_SLAB_LOAD(h + 1);
        __syncthreads();
        {
            const int dir = wave >> 2, c16 = (wave & 3) * 16;
            f32x4 accA[8], accX[8];
#pragma unroll
            for (int m = 0; m < 8; ++m) { accA[m] = (f32x4){0.f, 0.f, 0.f, 0.f}; accX[m] = (f32x4){0.f, 0.f, 0.f, 0.f}; }
#pragma unroll
            for (int ks = 0; ks < 2; ++ks) { const bf16x8 wa = gwa[ks], wx = gwx[ks];
#pragma unroll
                for (int m = 0; m < 8; ++m) { const bf16x8 xf = *(const LAS bf16x8*)(lds + (16 * m + fr) * 144 + (32 * ks + 8 * fq) * 2);
                    MFMA16(accA[m], wa, xf); MFMA16(accX[m], wx, xf); } }
            MFMA_FENCE8(accA); MFMA_FENCE8(accX);
            const int cc0 = c16 + 4 * fq;
            const f32x4 ba = gba, bx = gbx, lam = glam;
            f32x4 sp8;
#pragma unroll
            for (int j = 0; j < 4; ++j) sp8[j] = lam[j];
#pragma unroll
            for (int m = 0; m < 8; ++m) { const int t = 16 * m + fr;
                const unsigned long long xw = *(const LAS unsigned long long*)(lds + t * 144 + cc0 * 2);
                f32x4 av; float btv[4];
#pragma unroll
                for (int j = 0; j < 4; ++j) { const float xcv = bf2f((unsigned)(xw >> (16 * j)) & 0xffffu);
                    const float r = sigmoid_fast(accA[m][j] + ba[j]), ig = sigmoid_fast(accX[m][j] + bx[j]), la = r * sp8[j];
                    av[j] = __builtin_amdgcn_exp2f(1.4426950408889634f * la); btv[j] = __builtin_amdgcn_sqrtf(-expm1_dev(2.f * la, av[j])) * (ig * xcv); }
                *(LAS f32x4*)(As + (dir * 128 + t) * 68 + cc0) = av;
                *(LAS unsigned long long*)(Bs + (dir * 128 + t) * 72 + cc0) = (unsigned long long)pk2(btv[0], btv[1]) | ((unsigned long long)pk2(btv[2], btv[3]) << 32); }
        }
        __syncthreads();
        {
            const int dir = tid >> 8, seg = (tid >> 6) & 3, cc = tid & 63, ch = h * 64 + cc;
            const int tfirst = dir ? 127 - seg * 32 : seg * 32, tstep = dir ? -1 : 1;
            const LAS float* ap = As + (dir * 128 + tfirst) * 68 + cc; const LAS bf16_t* bp = Bs + (dir * 128 + tfirst) * 72 + cc;
            float hh = 0.f, P = 1.f;
#pragma unroll 8
            for (int q = 0; q < 32; ++q) { const float a = ap[q * tstep * 68], bt = bf2f(bp[q * tstep * 72]); hh = a * hh + bt; P *= a; }
            Seg[((dir * 64 + cc) * 4 + seg) * 2] = P; Seg[((dir * 64 + cc) * 4 + seg) * 2 + 1] = hh;
            __syncthreads();
            float carry = 0.f, cpre = 1.f;
#pragma unroll
            for (int s2 = 0; s2 < 3; ++s2) if (s2 < seg) { const float P2 = Seg[((dir * 64 + cc) * 4 + s2) * 2], h2 = Seg[((dir * 64 + cc) * 4 + s2) * 2 + 1]; carry = P2 * carry + h2; cpre *= P2; }
            bf16_t* hp = c.hl() + ((size_t)(t0 + tfirst) * 2 + dir) * 384 + ch; bf16_t* cpp = c.cp() + ((size_t)(t0 + tfirst) * 2 + dir) * 384 + ch;
            hh = carry; P = cpre;
#pragma unroll 4
            for (int q = 0; q < 32; ++q) { const float a = ap[q * tstep * 68], bt = bf2f(bp[q * tstep * 72]); hh = a * hh + bt; P *= a;
                hp[(long)q * tstep * 768] = (bf16_t)f2bf(hh); cpp[(long)q * tstep * 768] = (bf16_t)f2bf(P); }
            if (seg == 3) { float2 pe; pe.x = P; pe.y = hh; *(float2*)(c.lrupe() + ((size_t)(b * NT + ct) * 768 + dir * 384 + ch) * 2) = pe; }
        }
        __syncthreads();
    }
}

template <class CT>
__device__ __forceinline__ void row_mix_norm2_dev(const CT& c, const int t, const int lane) {
    bf16_t* orow = c.o() + (size_t)t * D;
    { const unsigned* yb = (const unsigned*)(c.yb() + (size_t)t * 384); unsigned w[3]; float ss = 0.f;
#pragma unroll
      for (int i = 0; i < 3; ++i) { w[i] = yb[lane + 64 * i]; const float a = bf2f(w[i] & 0xffffu), b2 = bf2f(w[i] >> 16); ss += a * a + b2 * b2; }
      const float rstd = 1.f / sqrtf(wsum(ss) * (1.f / 384) + EPS);
#pragma unroll
      for (int i = 0; i < 3; ++i) ((unsigned*)(orow + 256))[lane + 64 * i] = pk2(bf2f(w[i] & 0xffffu) * rstd, bf2f(w[i] >> 16) * rstd); }
    { const unsigned* hl = (const unsigned*)(c.hl() + (size_t)t * 768); const unsigned* cp = (const unsigned*)(c.cp() + (size_t)t * 768); const unsigned* gz = (const unsigned*)(c.z() + (size_t)t * D_INP + 1024);
      const float2* cin = (const float2*)(c.lruin() + (size_t)((t / SEQ) * NT + (t % SEQ) / LC) * 768);
      float y0[3], y1[3]; float ss = 0.f;
#pragma unroll
      for (int i = 0; i < 3; ++i) { const int k2 = lane + 64 * i; const unsigned hf = hl[k2], hb2 = hl[192 + k2], cf = cp[k2], cb2 = cp[192 + k2], gg = gz[k2]; const float2 nf = cin[k2], nb = cin[192 + k2];
          y0[i] = (bf2f(hf & 0xffffu) + bf2f(cf & 0xffffu) * nf.x + bf2f(hb2 & 0xffffu) + bf2f(cb2 & 0xffffu) * nb.x) * gelu_tanh(bf2f(gg & 0xffffu));
          y1[i] = (bf2f(hf >> 16) + bf2f(cf >> 16) * nf.y + bf2f(hb2 >> 16) + bf2f(cb2 >> 16) * nb.y) * gelu_tanh(bf2f(gg >> 16)); ss += y0[i] * y0[i] + y1[i] * y1[i]; }
      const float rstd = 1.f / sqrtf(wsum(ss) * (1.f / 384) + EPS);
#pragma unroll
      for (int i = 0; i < 3; ++i) ((unsigned*)(orow + 640))[lane + 64 * i] = pk2(y0[i] * rstd, y1[i] * rstd); }
}
template <class CT>
__device__ __forceinline__ void row_combine_dev(const CT& c, const int t, const int lane, const bool last, const bool dummy = false) {
    bf16_t* xr = (bf16_t*)c.X() + (size_t)t * D; float ss = 0.f; bf16_t* xw = dummy ? (bf16_t*)c.out + (size_t)t * D : xr; bf16_t* hbw = dummy ? c.o() : c.hb();
    const int d0 = c.tkd()[t * 4], d1 = c.tkd()[t * 4 + 1], d2 = c.tkd()[t * 4 + 2], d3 = c.tkd()[t * 4 + 3];
    const bf16_t* y0 = c.yexp() + (size_t)d0 * 1024; const bf16_t* y1 = c.yexp() + (size_t)d1 * 1024; const bf16_t* y2 = c.yexp() + (size_t)d2 * 1024; const bf16_t* y3 = c.yexp() + (size_t)d3 * 1024;
    f32x4 v[4];
#pragma unroll
    for (int j = 0; j < 4; ++j) { const int k = 4 * lane + 256 * j; { const uint2 xw_ = *(const uint2*)(xr + k);
            v[j] = (f32x4){__builtin_bit_cast(float, xw_.x << 16), __builtin_bit_cast(float, xw_.x & 0xffff0000u), __builtin_bit_cast(float, xw_.y << 16), __builtin_bit_cast(float, xw_.y & 0xffff0000u)}; }
        const uint2 a = *(const uint2*)(y0 + k), b2 = *(const uint2*)(y1 + k), c2 = *(const uint2*)(y2 + k), e2 = *(const uint2*)(y3 + k);
        v[j][0] += bf2f(a.x & 0xffffu); v[j][0] += bf2f(b2.x & 0xffffu); v[j][0] += bf2f(c2.x & 0xffffu); v[j][0] += bf2f(e2.x & 0xffffu);
        v[j][1] += bf2f(a.x >> 16); v[j][1] += bf2f(b2.x >> 16); v[j][1] += bf2f(c2.x >> 16); v[j][1] += bf2f(e2.x >> 16);
        v[j][2] += bf2f(a.y & 0xffffu); v[j][2] += bf2f(b2.y & 0xffffu); v[j][2] += bf2f(c2.y & 0xffffu); v[j][2] += bf2f(e2.y & 0xffffu);
        v[j][3] += bf2f(a.y >> 16); v[j][3] += bf2f(b2.y >> 16); v[j][3] += bf2f(c2.y >> 16); v[j][3] += bf2f(e2.y >> 16);
        ss += v[j][0] * v[j][0] + v[j][1] * v[j][1] + v[j][2] * v[j][2] + v[j][3] * v[j][3]; }
    const float rstd = 1.f / sqrtf(wsum(ss) * (1.f / D) + EPS);
    if (!last) {
#pragma unroll
        for (int j = 0; j < 4; ++j) { const int k = 4 * lane + 256 * j; { uint2 xo; xo.x = pk2(v[j][0], v[j][1]); xo.y = pk2(v[j][2], v[j][3]); *(uint2*)(xw + k) = xo; } uint2 o; o.x = pk2(v[j][0] * rstd, v[j][1] * rstd); o.y = pk2(v[j][2] * rstd, v[j][3] * rstd); *(uint2*)(hbw + (size_t)t * D + k) = o; }
    } else { const float* fg = c.in[I_FING];
#pragma unroll
        for (int j = 0; j < 4; ++j) { const int k = 4 * lane + 256 * j; const f32x4 g = *(const f32x4*)(fg + k); *(f32x4*)((float*)c.out + (size_t)t * D + k) = v[j] * rstd * g; } }
}

constexpr int NPL = 12, NPH = 1 + DEPTH * NPL;
struct Args { const float* in[32]; float* out; unsigned char* ws; int ph_lo, ph_hi; };

__device__ __forceinline__ void st_route_dev(long gtid, long gs, const Ctx& c, int l, LAS int* pre, int tid) {
    LAS int* cn = pre + 64;
    const unsigned* cnt = c.ctl() + CW_CNT + 32 * l * CNT_STRIDE;
    if (tid < NE) cn[tid] = (int)cnt[tid * CNT_STRIDE];
    __syncthreads();
    if (tid == 0) { int s = 0; for (int q = 0; q < NE; ++q) { pre[q] = s; s += (cn[q] + 255) & ~255; } pre[NE] = s; }
    __syncthreads();
    for (long i = gtid; i < (long)T * 4; i += gs) { const int e = c.tke()[i]; const int d = pre[e] + c.tkp()[i];
        c.tkd()[i] = d; c.rowtok()[d] = (int)(i / 4); c.rowgate()[d] = c.tkg()[i]; }
    const int total = pre[NE];
    for (long r = gtid; r < total; r += gs) { int e = 0;
#pragma unroll
        for (int s2 = 16; s2 > 0; s2 >>= 1) e += (pre[e + s2] <= (int)r) ? s2 : 0;
        if ((int)r - pre[e] >= cn[e]) { c.rowtok()[r] = 0; c.rowgate()[r] = 0.f; }
        if ((r & 255) == 0) c.blke()[r >> 8] = e; }
    if (gtid == 0) c.ctl()[CW_NMB + l] = (unsigned)(total / 256);
}
__device__ __forceinline__ void st_carries_dev(long gtid, long gs, const Ctx& c, int l) {
    constexpr int CB = 16;
    const long tl = gtid % (NWAVES * 64), bx = gtid / (NWAVES * 64), Gn = gs / (NWAVES * 64), first = (tl & 63) + 64 * (bx + Gn * (tl >> 6)), step = 64 * Gn * NWAVES;
    for (long i = first; i < (long)BATCH * 3072; i += step) { const int r = (int)(i % 3072), b = (int)(i / 3072), dir = r / 1536; const int ci = l * 3072 + r;
        const float2 a = *(const float2*)(c.s5a128() + 2 * ci); float sr = 0.f, si = 0.f;
        const float* eb = c.s5e() + ((size_t)(b * NT) * 3072 + r) * 2; float* ib = c.s5in() + ((size_t)(b * NT) * 3072 + r) * 2;
#pragma unroll 1
        for (int q0 = 0; q0 < NT; q0 += CB) { float2 e[CB];
#pragma unroll
            for (int q = 0; q < CB; ++q) { const int ct = dir == 0 ? q0 + q : NT - 1 - q0 - q; e[q] = *(const float2*)(eb + (size_t)ct * 6144); }
#pragma unroll
            for (int q = 0; q < CB; ++q) { const int ct = dir == 0 ? q0 + q : NT - 1 - q0 - q; float2 s2; s2.x = sr; s2.y = si; *(float2*)(ib + (size_t)ct * 6144) = s2;
                const float nr = a.x * sr - a.y * si + e[q].x, ni = a.x * si + a.y * sr + e[q].y; sr = nr; si = ni; } } }
    for (long i = first; i < (long)BATCH * 768; i += step) { const int r = (int)(i % 768), b = (int)(i / 768), dir = r / 384; float h = 0.f;
        const float* pb = c.lrupe() + 2 * ((size_t)(b * NT) * 768 + r); float* hb_ = c.lruin() + (size_t)(b * NT) * 768 + r;
#pragma unroll 1
        for (int q0 = 0; q0 < NT; q0 += CB) { float2 pe[CB];
#pragma unroll
            for (int q = 0; q < CB; ++q) { const int ct = dir == 0 ? q0 + q : NT - 1 - q0 - q; pe[q] = *(const float2*)(pb + (size_t)ct * 1536); }
#pragma unroll
            for (int q = 0; q < CB; ++q) { const int ct = dir == 0 ? q0 + q : NT - 1 - q0 - q; hb_[(size_t)ct * 768] = h; h = pe[q].x * h + pe[q].y; } } }
}
template <class Tp> __device__ __forceinline__ Tp* uniform_ptr(Tp* p) { const unsigned long long v = (unsigned long long)p;
    return (Tp*)(((unsigned long long)(unsigned)__builtin_amdgcn_readfirstlane((int)(v >> 32)) << 32) | (unsigned)__builtin_amdgcn_readfirstlane((int)v)); }
template <int PH>
__device__ __forceinline__ void run_phase(const Ctx& c0, LAS unsigned char* lds, const int wave, const int G) {
    int lane_o = (int)__builtin_amdgcn_mbcnt_hi(~0u, __builtin_amdgcn_mbcnt_lo(~0u, 0u)); asm volatile("" : "+v"(lane_o));
    const int lane = lane_o, tid_o = wave * 64 + lane_o; const long gtid = (long)blockIdx.x * (NWAVES * 64) + tid_o, gs = (long)G * (NWAVES * 64);
    const int gw = blockIdx.x * NWAVES + wave, NGW = G * NWAVES;
    Ctx c = c0; { unsigned long long a_ = (unsigned long long)c0.ws, b_ = (unsigned long long)c0.out, d_ = (unsigned long long)c0.in; asm volatile("" : "+s"(a_), "+s"(b_), "+s"(d_));
        c.ws = (unsigned char*)a_; c.out = (float*)b_; c.in = (const float* const*)d_; }
#ifndef GSEL
#define GSEL 0x1Fu
#endif
    const CtxG cg(c);
    if constexpr (PH == 0) {
        LAS float* scr = (LAS float*)(lds + wave * 16640);
        constexpr int I_IN = 16 * 22, I_GLU = 6 * 12, I_OUT = 16 * 16, I_GU = 16 * 32, I_DN = 16 * 16;
        constexpr int NITEMS = 2 * (I_IN + I_GLU + I_OUT) + 64 * (I_GU + I_DN);
        for (int it = gw; it < NITEMS; it += NGW) { int r = it;
            if (r < 2 * I_IN) { const int l = r / I_IN; transpose_item(c.in[I_WIN] + (size_t)l * D * D_IN, D, D_IN, c.win_t() + (size_t)l * D_INP * D, 0, c.in[I_N1G] + l * D, scr, r % I_IN, lane); continue; } r -= 2 * I_IN;
            if (r < 2 * I_GLU) { const int l = r / I_GLU; transpose_item(c.in[I_WGLU] + (size_t)l * 384 * 768, 384, 768, c.wglu_t() + (size_t)l * 768 * 384, 1, nullptr, scr, r % I_GLU, lane); continue; } r -= 2 * I_GLU;
            if (r < 2 * I_OUT) { const int l = r / I_OUT; transpose_item(c.in[I_WOUT] + (size_t)l * D * D, D, D, c.wout_t() + (size_t)l * D * D, 0, c.in[I_MIXG] + l * D, scr, r % I_OUT, lane); continue; } r -= 2 * I_OUT;
            if (r < 64 * I_GU) { const int le = r / I_GU; transpose_item8(c.in[I_WGU] + (size_t)le * 1024 * 2048, 1024, 2048, c.wgu8() + (size_t)le * 2048 * 1024, c.in[I_N2G] + (le / 32) * D, scr, r % I_GU, lane); continue; } r -= 64 * I_GU;
            { const int le = r / I_DN; transpose_item8(c.in[I_WDN] + (size_t)le * 1024 * 1024, 1024, 1024, c.wdn8() + (size_t)le * 1024 * 1024, nullptr, scr, r % I_DN, lane); }
        }
        st_prep_small(gtid, gs, c); st_prep_mixw(gtid, gs, c);
        for (int t = gw; t < T; t += NGW) row_norm_bf16(c.in[I_X] + (size_t)t * D, c.hb() + (size_t)t * D, lane);
    } else {
        constexpr int l = (PH - 1) / NPL, q = (PH - 1) % NPL;
        if constexpr (q == 0) {
            if constexpr (l == 0) st_prep_s5mat(gtid, gs, c);
            pg8::SchedPlain S; S.so.init(T / 256, D_INP / 256, G, blockIdx.x); S.Bt = (const char*)(c.win_t() + (size_t)l * D_INP * D); S.tstepB = (size_t)256 * D * 2; S.rowtab = nullptr;
            EpiInW E{c.z()}; pg8::gemm_phase<EpiInW, pg8::SchedPlain, false, false, true>(lds, wave, c.hb(), D, S, E);
        } else if constexpr (q == 1) {
            for (int tile = blockIdx.x; tile < BATCH * NT; tile += G) { if constexpr ((GSEL & 1u) != 0) mixer_tile_dev(cg, l, tile, lds, wave, lane); else mixer_tile_dev(c, l, tile, lds, wave, lane); }
            for (int it = gw; it < BATCH * NT * 24; it += NGW) { if constexpr ((GSEL & 2u) != 0) s5_tile_dev<false>(cg, l, it / 24, it % 24, lds + wave * S5_LDS_WAVE, lane); else s5_tile_dev<false>(c, l, it / 24, it % 24, lds + wave * S5_LDS_WAVE, lane); }
        } else if constexpr (q == 2) { st_carries_dev(gtid, gs, c, l);
        } else if constexpr (q == 3) {
            for (int it = gw; it < BATCH * NT * 24; it += NGW) { if constexpr ((GSEL & 2u) != 0) s5_tile_dev<true>(cg, l, it / 24, it % 24, lds + wave * S5_LDS_WAVE, lane); else s5_tile_dev<true>(c, l, it / 24, it % 24, lds + wave * S5_LDS_WAVE, lane); }
        } else if constexpr (q == 4) {
            pg8::SchedPlain S; S.so.init(T / 256, 3, G, blockIdx.x); S.Bt = (const char*)(c.wglu_t() + (size_t)l * 768 * 384); S.tstepB = (size_t)256 * 384 * 2; S.rowtab = nullptr;
            EpiGluW E{c.yb(), uniform_ptr(c.in[I_BGLU]) + l * 768}; pg8::gemm_phase<EpiGluW, pg8::SchedPlain, false, false, true>(lds, wave, c.v(), 384, S, E);
        } else if constexpr (q == 5) { for (int t = gw; t < T; t += NGW) { if constexpr ((GSEL & 4u) != 0) row_mix_norm2_dev(cg, t, lane); else row_mix_norm2_dev(c, t, lane); }
        } else if constexpr (q == 6) {
            pg8::SchedPlain S; S.so.init(T / 256, 4, G, blockIdx.x); S.Bt = (const char*)(c.wout_t() + (size_t)l * D * D); S.tstepB = (size_t)256 * D * 2; S.rowtab = nullptr;
            EpiOutW<l == 0> E{l == 0 ? (const void*)uniform_ptr(c.in[I_X]) : (const void*)c.X(), (bf16_t*)c.X()}; pg8::gemm_phase<EpiOutW<l == 0>, pg8::SchedPlain, false, false, true>(lds, wave, c.o(), D, S, E);
        } else if constexpr (q == 7) {
            static_assert(T % (NWAVES * RB * 4) == 0, "router: 128 rows per workgroup pass");
            LAS int* park = (LAS int*)lds;
            LAS int* hist = (LAS int*)(lds + 2048);
            for (int tb = blockIdx.x * 128; tb < T; tb += G * 128) {
                if (tid_o < 64) hist[tid_o] = 0;
                LAS float* lgs = (LAS float*)(lds + 4096 + wave * 2048);
                router_logits16(cg, l, tb + wave * 16, lane, lgs);
#pragma unroll 1
                for (int i = 0; i < 4; ++i) { if constexpr ((GSEL & 16u) != 0) router_rows(cg, l, tb + wave * 16 + i * RB, lane, park + wave * 64 + i * RB * 4, lgs + i * RB * 32); else router_rows(c, l, tb + wave * 16 + i * RB, lane, park + wave * 64 + i * RB * 4, lgs + i * RB * 32); }
                __syncthreads();
                const int ex_ = park[tid_o]; const int rank = __hip_atomic_fetch_add(hist + ex_, 1, __ATOMIC_RELAXED, __HIP_MEMORY_SCOPE_WORKGROUP);
                __syncthreads();
                if (tid_o < 32) hist[32 + tid_o] = (int)atomicAdd(c.ctl() + CW_CNT + (32 * l + tid_o) * CNT_STRIDE, (unsigned)hist[tid_o]);
                __syncthreads();
                c.tkp()[tb * 4 + tid_o] = hist[32 + ex_] + rank;
                __syncthreads(); }
        } else if constexpr (q == 8) { st_route_dev(gtid, gs, c, l, (LAS int*)lds, tid_o);
        } else if constexpr (q == 9) {
            const int nmb = (int)c.ctl()[CW_NMB + l];
            pg8::SchedMoe S; S.so.init(nmb, 8, G, blockIdx.x); S.Bt = (const char*)(c.wgu8() + (size_t)l * NE * 2048 * 1024); S.tstepB = (size_t)256 * 1024; S.estride = (size_t)2048 * 1024; S.rowtab = c.rowtok(); S.blke = c.blke();
            EpiMoe1F8 E{c.act8(), uniform_ptr(c.in[I_BGU]) + (size_t)l * NE * 2048}; pg8::gemm_phase<EpiMoe1F8, pg8::SchedMoe, true, true, true>(lds, wave, (const bf16_t*)c.hq(), 512, S, E);
#ifdef PROBE_MOENULL
            { __syncthreads(); EpiNullW E2; pg8::gemm_phase<EpiNullW, pg8::SchedMoe, true, true, true>(lds, wave, (const bf16_t*)c.hq(), 512, S, E2); }
#endif
        } else if constexpr (q == 10) {
            const int nmb = (int)c.ctl()[CW_NMB + l];
            pg8::SchedMoe S; S.so.init(nmb, 4, G, blockIdx.x); S.Bt = (const char*)(c.wdn8() + (size_t)l * NE * 1024 * 1024); S.tstepB = (size_t)256 * 1024; S.estride = (size_t)1024 * 1024; S.rowtab = nullptr; S.blke = c.blke();
            EpiMoe2F8 E{c.yexp(), uniform_ptr(c.in[I_BDN]) + (size_t)l * NE * 1024, c.rowgate()}; pg8::gemm_phase<EpiMoe2F8, pg8::SchedMoe, false, true, true>(lds, wave, (const bf16_t*)c.act8(), 512, S, E);
#ifdef PROBE_MOENULL
            { __syncthreads(); EpiNullW E2; pg8::gemm_phase<EpiNullW, pg8::SchedMoe, false, true, true>(lds, wave, (const bf16_t*)c.act8(), 512, S, E2); }
#endif
        } else {
#ifdef PROBE_COMBINE
            if (l == 0) { for (int t = gw; t < T; t += NGW) row_combine_dev(c, t, lane, false, true); __syncthreads(); }
#endif
            for (int t = gw; t < T; t += NGW) { if constexpr ((GSEL & 8u) != 0) row_combine_dev(cg, t, lane, l == DEPTH - 1); else row_combine_dev(c, t, lane, l == DEPTH - 1); } }
    }
}
template <int PH>
__device__ __forceinline__ void run_from(const Ctx& c0, LAS unsigned char* lds, const int wave, const int G, const int lo, const int hi, const XcdBarrier& bar) {
    if (lo <= PH && PH < hi) {
        run_phase<PH>(c0, lds, wave, G);
#ifdef PROBE_REP
        if constexpr (((PROBE_REP >> (PH == 0 ? 0 : 1 + (PH - 1) % NPL)) & 1u) != 0) { __syncthreads(); run_phase<PH>(c0, lds, wave, G); }
#endif
        if (PH + 1 < hi) { const int lane = (int)__builtin_amdgcn_mbcnt_hi(~0u, __builtin_amdgcn_mbcnt_lo(~0u, 0u)); xcd_barrier(bar, wave == 0 && lane == 0); }
    }
    if constexpr (PH + 1 < NPH) run_from<PH + 1>(c0, lds, wave, G, lo, hi, bar);
}

__global__ void __launch_bounds__(NWAVES * 64, 2) mk_fwd(Args args) {
    extern __shared__ __attribute__((aligned(16))) unsigned char lds_raw[];
    LAS unsigned char* lds = (LAS unsigned char*)lds_raw;
    const int tid = threadIdx.x, wave = __builtin_amdgcn_readfirstlane(tid >> 6), G = gridDim.x;
    LAS unsigned long long* ptab = (LAS unsigned long long*)(lds + LDSCTL_OFF + 1024);
    volatile LAS unsigned* MISC = (volatile LAS unsigned*)(lds + LDSCTL_OFF);
    for (int u = tid; u < 256; u += NWAVES * 64) ((LAS unsigned*)(lds + LDSCTL_OFF))[u] = 0u;
    if (tid < 32) ptab[tid] = (unsigned long long)args.in[tid];
    if (tid == 32) ptab[32] = (unsigned long long)args.out;
    if (tid == 33) ptab[33] = (unsigned long long)args.ws;
    __syncthreads();
    Ctx c0; c0.in = (const float* const*)(const void*)(lds_raw + LDSCTL_OFF + 1024);
    { unsigned long long o = ptab[32], w = ptab[33];
      c0.out = (float*)(((unsigned long long)(unsigned)__builtin_amdgcn_readfirstlane((int)(o >> 32)) << 32) | (unsigned)__builtin_amdgcn_readfirstlane((int)o));
      c0.ws = (unsigned char*)(((unsigned long long)(unsigned)__builtin_amdgcn_readfirstlane((int)(w >> 32)) << 32) | (unsigned)__builtin_amdgcn_readfirstlane((int)w)); }
    XcdBarrier bar; bar.bar = (unsigned*)(args.ws + WS_CTL) + CW_BAR; bar.x = 0; bar.st = nullptr;
    if (args.ph_hi - args.ph_lo > 1) bar = xcd_barrier_post((unsigned*)(args.ws + WS_CTL) + CW_BAR, MISC + 8);
    run_from<0>(c0, lds, wave, G, args.ph_lo, args.ph_hi, bar);
}

extern "C" void kernel_launch(void* const* d_in, const int* in_sizes, int n_in, void* d_out, int out_size, void* d_ws, size_t ws_size, hipStream_t stream) {
    static int grid = 0;
    if (grid == 0) {
        if (n_in != 32 || in_sizes[0] != T * D || out_size != T * D || ws_size < WS_END) { fprintf(stderr, "kernel_launch: unexpected shapes (n_in %d in0 %d out %d ws %zu need %zu)\n", n_in, n_in > 0 ? in_sizes[0] : -1, out_size, ws_size, (size_t)WS_END); grid = -1; return; }
        int dev = 0, cus = 0, per_cu = 0;
        if (hipGetDevice(&dev) != hipSuccess || hipDeviceGetAttribute(&cus, hipDeviceAttributeMultiprocessorCount, dev) != hipSuccess) { grid = -1; return; }
        if (hipFuncSetAttribute((const void*)mk_fwd, hipFuncAttributeMaxDynamicSharedMemorySize, LDS_BYTES) != hipSuccess) { fprintf(stderr, "kernel_launch: hipFuncSetAttribute failed\n"); grid = -1; return; }
        if (hipOccupancyMaxActiveBlocksPerMultiprocessor(&per_cu, (const void*)mk_fwd, NWAVES * 64, LDS_BYTES) != hipSuccess || per_cu < 1) { fprintf(stderr, "kernel_launch: occupancy query reports %d blocks per CU\n", per_cu); per_cu = 1; }
        (void)hipGetLastError();
        grid = cus;
    }
    if (grid < 0) return;
    (void)hipMemsetAsync((char*)d_ws + WS_CTL, 0, CTL_BYTES, stream);
    Args a; memset(&a, 0, sizeof(a));
    for (int i = 0; i < 32; ++i) a.in[i] = (const float*)d_in[i];
    a.out = (float*)d_out; a.ws = (unsigned char*)d_ws;
#if MK_PER_PHASE
    for (int ph = 0; ph < NPH; ++ph) { a.ph_lo = ph; a.ph_hi = ph + 1; hipLaunchKernelGGL(mk_fwd, dim3(grid), dim3(NWAVES * 64), LDS_BYTES, stream, a); }
#else
    a.ph_lo = 0; a.ph_hi = NPH;
    void* kargs[] = {&a};
    hipError_t e = hipLaunchCooperativeKernel((const void*)mk_fwd, dim3(grid), dim3(NWAVES * 64), kargs, LDS_BYTES, stream);
    if (e != hipSuccess) fprintf(stderr, "kernel_launch: cooperative launch failed: %s\n", hipGetErrorString(e));
#endif
}
#endif
```

```cpp
#ifndef HOST_TEST
#include <hip/hip_runtime.h>
#endif
#include <cstdio>
#include <cstdint>
#include <cstring>
#include <cmath>

#ifndef CFG_B
#define CFG_B 4
#endif
#ifndef CFG_S
#define CFG_S 8192
#endif
#ifndef MK_PER_PHASE
#define MK_PER_PHASE 0
#define GSEL 0x1Du
#endif

#ifdef HOST_TEST
#define HD inline
#define DEV inline
#else
#define HD __host__ __device__ __forceinline__
#define DEV __device__ __forceinline__
#endif

typedef unsigned short bf16_t;
constexpr int BATCH = CFG_B, SEQ = CFG_S, T = BATCH * SEQ, D = 1024, DEPTH = 2;
constexpr int D_POOL = 256, D_S5 = 384, D_LRU = 384, D_IN = 1408, D_INP = 1536;
constexpr int NE = 32, TOPK = 4;
constexpr int LC = 128, NT = SEQ / LC;
constexpr int NROWS = T * TOPK + NE * 256;
constexpr int NMB_MAX = NROWS / 256;
constexpr float EPS = 1e-5f;
static_assert(SEQ % LC == 0 && T % 256 == 0, "shape");

constexpr size_t AL(size_t x) { return (x + 255) & ~size_t(255); }
constexpr size_t WS_CTL = 0, CTL_BYTES = 1u << 20;
constexpr size_t WS_WIN = WS_CTL + CTL_BYTES;
constexpr size_t WS_WGLU = WS_WIN + (size_t)2 * D_INP * D * 2;
constexpr size_t WS_WOUT = AL(WS_WGLU + (size_t)2 * 768 * 384 * 2);
constexpr size_t WS_WGU = WS_WOUT + (size_t)2 * D * D * 2;
constexpr size_t WS_WDN = WS_WGU + (size_t)2 * NE * 2048 * 1024 * 2;
constexpr size_t WS_RWT = WS_WDN + (size_t)2 * NE * 1024 * 1024 * 2;
constexpr size_t WS_S5A = WS_RWT + (size_t)2 * NE * 1024 * 4;
constexpr size_t WS_S5A128 = WS_S5A + 6144 * 8;
constexpr size_t WS_S5BB = WS_S5A128 + 6144 * 8;
constexpr size_t WS_S5POW = WS_S5BB + (size_t)6144 * 16 * 8;
constexpr size_t WS_W4T = AL(WS_S5POW + (size_t)6144 * 8 * 4);
constexpr size_t WS_YMAT = WS_W4T + (size_t)2 * 24 * 2 * 128 * 64 * 2;
constexpr size_t WS_LRUWT = AL(WS_YMAT + (size_t)2 * 24 * 64 * 320 * 2);
constexpr size_t WS_POOLWT = WS_LRUWT + (size_t)2 * 2 * 6 * 2 * 4096 * 2;
constexpr size_t WS_HB = AL(WS_POOLWT + (size_t)2 * 4 * 4096 * 2);
constexpr size_t WS_Z = WS_HB + (size_t)T * D * 2;
constexpr size_t WS_X = WS_Z + (size_t)T * D_INP * 2;
constexpr size_t WS_O = WS_X + (size_t)T * D * 4;
constexpr size_t WS_V = WS_O + (size_t)T * D * 2;
constexpr size_t WS_YB = WS_V + (size_t)T * 384 * 2;
constexpr size_t WS_PD = WS_YB + (size_t)T * 384 * 2;
constexpr size_t WS_YA = WS_PD + (size_t)T * 256 * 4;
constexpr size_t WS_XC = WS_YA + (size_t)T * 256 * 4;
constexpr size_t WS_HDIR = WS_XC + (size_t)T * 384 * 4;
constexpr size_t WS_S5E = WS_HDIR + (size_t)T * 768 * 4;
constexpr size_t WS_S5IN = WS_S5E + (size_t)BATCH * NT * 3072 * 8;
constexpr size_t WS_LRUPE = WS_S5IN + (size_t)BATCH * NT * 3072 * 8;
constexpr size_t WS_LRUIN = WS_LRUPE + (size_t)BATCH * NT * 768 * 8;
constexpr size_t WS_TKE = AL(WS_LRUIN + (size_t)BATCH * NT * 768 * 4);
constexpr size_t WS_TKG = WS_TKE + (size_t)T * 16;
constexpr size_t WS_TKP = WS_TKG + (size_t)T * 16;
constexpr size_t WS_TKD = WS_TKP + (size_t)T * 16;
constexpr size_t WS_ROWTOK = WS_TKD + (size_t)T * 16;
constexpr size_t WS_ROWGATE = AL(WS_ROWTOK + (size_t)NROWS * 4);
constexpr size_t WS_BLKE = AL(WS_ROWGATE + (size_t)NROWS * 4);
constexpr size_t WS_SCR = AL(WS_BLKE + (size_t)NMB_MAX * 4);
constexpr size_t WS_XBUF = WS_SCR;
constexpr size_t WS_LRUAB = WS_XBUF + (size_t)T * 3072 * 4;
constexpr size_t WS_ACT = WS_SCR;
constexpr size_t WS_YEXP = WS_ACT + (size_t)NROWS * 1024 * 2;
constexpr size_t SCR_A = (size_t)T * 3072 * 4 + (size_t)T * 768 * 8, SCR_B = (size_t)NROWS * 1024 * 2 * 2;
constexpr size_t WS_END = WS_SCR + (SCR_A > SCR_B ? SCR_A : SCR_B);
constexpr int CW_CNT = 8192, CNT_STRIDE = 64;
constexpr int CW_NMB = 192;
constexpr int CW_BAR = 4096;
constexpr size_t SP8_OFF = 524288;

#if defined(__HIP_DEVICE_COMPILE__) && !defined(HOST_TEST)
typedef __bf16 bf16v2_ __attribute__((ext_vector_type(2))); typedef float f32v2_ __attribute__((ext_vector_type(2)));
HD unsigned pk2(float lo, float hi) { const f32v2_ v = {lo, hi}; return __builtin_bit_cast(unsigned, __builtin_convertvector(v, bf16v2_)); }
HD unsigned f2bf(float f) { return (unsigned)__builtin_bit_cast(unsigned short, (__bf16)f); }
#else
HD unsigned f2bf(float f) { unsigned u; memcpy(&u, &f, 4); return (u + 0x7fffu + ((u >> 16) & 1u)) >> 16; }
HD unsigned pk2(float lo, float hi) { return f2bf(lo) | (f2bf(hi) << 16); }
#endif
HD float bf2f(unsigned b) { unsigned u = (b & 0xffffu) << 16; float f; memcpy(&f, &u, 4); return f; }
HD float sigmoidf_(float x) { return 1.f / (1.f + expf(-x)); }
#ifdef HOST_TEST
HD float sigmoid_fast(float x) { return 1.f / (1.f + expf(-x)); }
#else
__device__ __forceinline__ float sigmoid_fast(float x) { return __builtin_amdgcn_rcpf(1.f + __builtin_amdgcn_exp2f(-1.4426950408889634f * x)); }
__device__ __forceinline__ float expm1_dev(float x, float ex) { const float s = x * (1.f + x * (0.5f + x * (0.16666667f + x * (0.041666668f + x * 0.0083333338f)))); const float e = ex * ex - 1.f; return x > -0.3f ? s : e; }
#endif
#if defined(__HIP_DEVICE_COMPILE__) && !defined(HOST_TEST)
HD float gelu_tanh(float x) { return x * sigmoid_fast(1.5957691216057308f * (x + 0.044715f * x * x * x)); }
#else
HD float gelu_tanh(float x) { return 0.5f * x * (1.f + tanhf(0.7978845608028654f * (x + 0.044715f * x * x * x))); }
#endif

#ifdef HOST_TEST
struct f32x4 { float v[4]; float& operator[](int i) { return v[i]; } const float& operator[](int i) const { return v[i]; } };
#else
typedef float f32x4 __attribute__((ext_vector_type(4)));
#endif

struct Unit { int pm, pn, e; };

struct Ctx {
    const float* const* in;
    float* out;
    unsigned char* ws;
#define WSP(T_, name, off) HD T_* name() const { return (T_*)(ws + (off)); }
    WSP(unsigned, ctl, WS_CTL) WSP(bf16_t, win_t, WS_WIN) WSP(bf16_t, wglu_t, WS_WGLU) WSP(bf16_t, wout_t, WS_WOUT) WSP(bf16_t, wgu_t, WS_WGU) WSP(bf16_t, wdn_t, WS_WDN)
    WSP(unsigned char, hq, WS_O) WSP(unsigned char, act8, WS_ACT) WSP(unsigned char, wgu8, WS_WGU) WSP(unsigned char, wdn8, WS_WDN)
    WSP(bf16_t, lruw_t, WS_LRUWT) WSP(bf16_t, poolw_t, WS_POOLWT) WSP(bf16_t, hl, WS_HDIR) WSP(bf16_t, cp, WS_HDIR + (size_t)T * 768 * 2)
    WSP(float, rwt, WS_RWT) WSP(float, s5a, WS_S5A) WSP(float, s5a128, WS_S5A128) WSP(float, s5bb, WS_S5BB) WSP(float, s5pow, WS_S5POW) WSP(bf16_t, w4t, WS_W4T) WSP(bf16_t, ymat, WS_YMAT)
    WSP(bf16_t, hb, WS_HB) WSP(bf16_t, z, WS_Z) WSP(bf16_t, o, WS_O) WSP(bf16_t, v, WS_V) WSP(bf16_t, yb, WS_YB) WSP(bf16_t, act, WS_ACT) WSP(bf16_t, yexp, WS_YEXP)
    WSP(float, X, WS_X) WSP(float, pd, WS_PD) WSP(float, ya, WS_YA) WSP(float, xc, WS_XC) WSP(float, hdir, WS_HDIR) WSP(float, s5e, WS_S5E) WSP(float, s5in, WS_S5IN)
    WSP(float, lrupe, WS_LRUPE) WSP(float, lruin, WS_LRUIN) WSP(float, tkg, WS_TKG) WSP(float, rowgate, WS_ROWGATE) WSP(float, lruab, WS_LRUAB)
    WSP(int, tke, WS_TKE) WSP(int, tkp, WS_TKP) WSP(int, tkd, WS_TKD) WSP(int, rowtok, WS_ROWTOK) WSP(int, blke, WS_BLKE) WSP(unsigned, xbuf, WS_XBUF)
#undef WSP
};
#ifndef HOST_TEST
struct CtxG {
    const __attribute__((address_space(3))) unsigned long long* tab; __attribute__((address_space(1))) float* outg; __attribute__((address_space(1))) unsigned char* wsg;
    struct InProxy { const __attribute__((address_space(3))) unsigned long long* tab; __device__ __forceinline__ const float* operator[](int i) const { return (const float*)(__attribute__((address_space(1))) const float*)tab[i]; } } in;
    float* out;
    __device__ __forceinline__ explicit CtxG(const Ctx& c) { tab = (const __attribute__((address_space(3))) unsigned long long*)(const unsigned long long*)(const void*)c.in; in.tab = tab; outg = (__attribute__((address_space(1))) float*)(unsigned long long)c.out; wsg = (__attribute__((address_space(1))) unsigned char*)(unsigned long long)c.ws; out = (float*)outg; }
#define WSPG(T_, name, off) __device__ __forceinline__ T_* name() const { return (T_*)(__attribute__((address_space(1))) T_*)(wsg + (off)); }
    WSPG(unsigned, ctl, WS_CTL) WSPG(bf16_t, win_t, WS_WIN) WSPG(bf16_t, wglu_t, WS_WGLU) WSPG(bf16_t, wout_t, WS_WOUT) WSPG(bf16_t, wgu_t, WS_WGU) WSPG(bf16_t, wdn_t, WS_WDN)
    WSPG(unsigned char, hq, WS_O) WSPG(unsigned char, act8, WS_ACT) WSPG(unsigned char, wgu8, WS_WGU) WSPG(unsigned char, wdn8, WS_WDN)
    WSPG(bf16_t, lruw_t, WS_LRUWT) WSPG(bf16_t, poolw_t, WS_POOLWT) WSPG(bf16_t, hl, WS_HDIR) WSPG(bf16_t, cp, WS_HDIR + (size_t)T * 768 * 2)
    WSPG(float, rwt, WS_RWT) WSPG(float, s5a, WS_S5A) WSPG(float, s5a128, WS_S5A128) WSPG(float, s5bb, WS_S5BB) WSPG(float, s5pow, WS_S5POW) WSPG(bf16_t, w4t, WS_W4T) WSPG(bf16_t, ymat, WS_YMAT)
    WSPG(bf16_t, hb, WS_HB) WSPG(bf16_t, z, WS_Z) WSPG(bf16_t, o, WS_O) WSPG(bf16_t, v, WS_V) WSPG(bf16_t, yb, WS_YB) WSPG(bf16_t, act, WS_ACT) WSPG(bf16_t, yexp, WS_YEXP)
    WSPG(float, X, WS_X) WSPG(float, pd, WS_PD) WSPG(float, ya, WS_YA) WSPG(float, xc, WS_XC) WSPG(float, hdir, WS_HDIR) WSPG(float, s5e, WS_S5E) WSPG(float, s5in, WS_S5IN)
    WSPG(float, lrupe, WS_LRUPE) WSPG(float, lruin, WS_LRUIN) WSPG(float, tkg, WS_TKG) WSPG(float, rowgate, WS_ROWGATE) WSPG(float, lruab, WS_LRUAB)
    WSPG(int, tke, WS_TKE) WSPG(int, tkp, WS_TKP) WSPG(int, tkd, WS_TKD) WSPG(int, rowtok, WS_ROWTOK) WSPG(int, blke, WS_BLKE) WSPG(unsigned, xbuf, WS_XBUF)
#undef WSPG
};
#endif
enum { I_X = 0, I_N1G, I_WIN, I_POOLW, I_POOLS, I_LAMRE, I_LAMIM, I_LOGSTEP, I_BRE, I_BIM, I_CRE, I_CIM, I_S5D, I_WGLU, I_BGLU, I_CONVW, I_CONVB, I_WA, I_BA, I_WX, I_BX, I_LAM,
       I_MIXG, I_WOUT, I_N2G, I_RW, I_RB, I_WGU, I_BGU, I_WDN, I_BDN, I_FING };

HD void st_prep_small(long gtid, long gs, const Ctx& c) {
    for (long i = gtid; i < 6144; i += gs) {
        const float lr = c.in[I_LAMRE][i], li = c.in[I_LAMIM][i], dt = expf(c.in[I_LOGSTEP][i / 64]);
        const float mag = expf(lr * dt), ar = mag * cosf(li * dt), ai = mag * sinf(li * dt);
        const float den = lr * lr + li * li, nr = ar - 1.f, ni = ai, qr = (nr * lr + ni * li) / den, qi = (ni * lr - nr * li) / den;
        c.s5a()[2 * i] = ar; c.s5a()[2 * i + 1] = ai;
        float pr = ar, pi = ai;
        for (int k = 0; k < 7; ++k) { const float t = pr * pr - pi * pi; pi = 2.f * pr * pi; pr = t; }
        c.s5a128()[2 * i] = pr; c.s5a128()[2 * i + 1] = pi;
        for (int cc = 0; cc < 16; ++cc) { const float br = c.in[I_BRE][i * 16 + cc], bi = c.in[I_BIM][i * 16 + cc];
            c.s5bb()[(i * 16 + cc) * 2] = qr * br - qi * bi; c.s5bb()[(i * 16 + cc) * 2 + 1] = qr * bi + qi * br; }
    }
    for (long i = gtid; i < 2 * NE * 1024; i += gs) { const int l = (int)(i / (NE * 1024)), e = (int)(i / 1024) % NE, k = (int)(i % 1024);
        const float f_ = c.in[I_N2G][l * 1024 + k] * c.in[I_RW][((size_t)l * 1024 + k) * NE + e];
#ifdef HOST_TEST
        c.rwt()[i] = f_; }
#else
        { bf16_t* rh = (bf16_t*)c.rwt(); const unsigned hi_ = f2bf(f_); const float lo_ = f_ - bf2f(hi_);
          rh[((size_t)(l * 2) * NE + e) * 1024 + k] = (bf16_t)hi_; rh[((size_t)(l * 2 + 1) * NE + e) * 1024 + k] = (bf16_t)f2bf(lo_); } }
#endif
    for (long i = gtid; i < (long)2 * 128 * 1024; i += gs) { const int l = (int)(i / (128 * 1024)); const long r = i % (128 * 1024);
        c.win_t()[(size_t)l * D_INP * D + (size_t)D_IN * D + r] = 0; }
}
HD void cpowi(float ar, float ai, int e, float& pr, float& pi) { pr = 1.f; pi = 0.f; for (int k = 0; k < e; ++k) { const float t = pr * ar - pi * ai; pi = pr * ai + pi * ar; pr = t; } }
HD void st_prep_s5mat(long gtid, long gs, const Ctx& c) {
    const float* cre_ = c.in[I_CRE]; const float* cim_ = c.in[I_CIM]; const float* s5d_ = c.in[I_S5D];
    for (long i = gtid; i < 6144; i += gs) { const float ar = c.s5a()[2 * i], ai = c.s5a()[2 * i + 1]; float pr, pi;
        cpowi(ar, ai, 4, pr, pi); c.s5pow()[i * 8 + 0] = pr; c.s5pow()[i * 8 + 1] = pi;
        cpowi(ar, ai, 16, pr, pi); c.s5pow()[i * 8 + 2] = pr; c.s5pow()[i * 8 + 3] = pi;
        cpowi(ar, ai, 32, pr, pi); c.s5pow()[i * 8 + 4] = pr; c.s5pow()[i * 8 + 5] = pi;
        cpowi(ar, ai, 64, pr, pi); c.s5pow()[i * 8 + 6] = pr; c.s5pow()[i * 8 + 7] = pi; }
    for (long i = gtid; i < (long)2 * 24 * 2 * 128 * 64; i += gs) { const int k = (int)(i % 64), pp = (int)(i / 64) % 128, dir = (int)(i / 8192) % 2, g = (int)(i / 16384) % 24, l = (int)(i / 16384 / 24);
        const int p = pp & 63, j = k >> 4, cc = k & 15, ci = ((l * 2 + dir) * 24 + g) * 64 + p; float pr, pi; cpowi(c.s5a()[2 * ci], c.s5a()[2 * ci + 1], dir ? j : 3 - j, pr, pi);
        const float br = c.s5bb()[(ci * 16 + cc) * 2], bi = c.s5bb()[(ci * 16 + cc) * 2 + 1];
        c.w4t()[i] = (bf16_t)f2bf(pp < 64 ? pr * br - pi * bi : pr * bi + pi * br); }
    for (long i = gtid; i < (long)2 * 24 * 64 * 256; i += gs) { const int k = (int)(i % 256), row = (int)(i / 256) % 64, g = (int)(i / 16384) % 24, l = (int)(i / 16384 / 24); const int j = row >> 4, cc = row & 15;
        const int dir = k >> 7, kk = k & 127, nt = kk < 64 ? 0 : 4, p = kk & 63, ci = ((l * 2 + dir) * 24 + g) * 64 + p; float pr, pi; cpowi(c.s5a()[2 * ci], c.s5a()[2 * ci + 1], dir ? 4 - j : j + 1, pr, pi);
        const size_t co = ((size_t)((l * 2 + dir) * 24 + g) * 16 + cc) * 64 + p; const float cr = cre_[co], cim = cim_[co];
        const float val = nt < 4 ? cr * pr - cim * pi : -(cr * pi + cim * pr);
        c.ymat()[((size_t)(l * 24 + g) * 64 + row) * 320 + k] = (bf16_t)f2bf(val); }
    for (long i = gtid; i < (long)2 * 24 * 7 * 256; i += gs) { const int c2 = (int)(i % 16), cc = (int)(i / 16) % 16, dd = (int)(i / 256) % 7, g = (int)(i / 1792) % 24, l = (int)(i / 1792 / 24); const int d = dd - 3;
        float val = (d == 0 && c2 == cc) ? s5d_[l * 384 + g * 16 + cc] : 0.f;
        for (int dir = 0; dir < 2; ++dir) { if (dir == 0 ? d < 0 : d > 0) continue; const int e = d < 0 ? -d : d;
            for (int p = 0; p < 64; ++p) { const int ci = ((l * 2 + dir) * 24 + g) * 64 + p; float pr, pi; cpowi(c.s5a()[2 * ci], c.s5a()[2 * ci + 1], e, pr, pi);
                const size_t co = ((size_t)((l * 2 + dir) * 24 + g) * 16 + cc) * 64 + p; const float cr = cre_[co], cim = cim_[co]; const float xr = cr * pr - cim * pi, xi = cr * pi + cim * pr;
                val += xr * c.s5bb()[(ci * 16 + c2) * 2] - xi * c.s5bb()[(ci * 16 + c2) * 2 + 1]; } }
        const bf16_t vb = (bf16_t)f2bf(val);
        for (int j = 0; j < 4; ++j) { const int ii = j - d; if (ii < 0 || ii > 3) continue; c.ymat()[((size_t)(l * 24 + g) * 64 + j * 16 + cc) * 320 + 256 + ii * 16 + c2] = vb; } }
}
HD void s5_tile_ref(const Ctx& c, int l, int tile, int g, bool final_pass) {
    const int b = tile / NT, ct = tile % NT, t0 = b * SEQ + ct * LC;
    float U[32][64];
    for (int n = 0; n < 32; ++n) for (int k = 0; k < 64; ++k) U[n][k] = bf2f(c.z()[(size_t)(t0 + 4 * n + (k >> 4)) * D_INP + 256 + 16 * g + (k & 15)]);
    float S[2][33][128];
    for (int dir = 0; dir < 2; ++dir) {
        const bf16_t* w = c.w4t() + (size_t)((l * 24 + g) * 2 + dir) * 128 * 64;
        for (int p = 0; p < 64; ++p) { const int ci = ((l * 2 + dir) * 24 + g) * 64 + p; const float a4r = c.s5pow()[ci * 8], a4i = c.s5pow()[ci * 8 + 1];
            float sr = 0.f, si = 0.f; const size_t io = ((size_t)(b * NT + ct) * 3072 + dir * 1536 + g * 64 + p) * 2;
            if (final_pass) { sr = c.s5in()[io]; si = c.s5in()[io + 1]; }
            if (dir == 0) { S[0][0][p] = sr; S[0][0][64 + p] = si; } else { S[1][32][p] = sr; S[1][32][64 + p] = si; }
            for (int q = 0; q < 32; ++q) { const int n = dir == 0 ? q : 31 - q; float gr = 0.f, gi = 0.f;
                for (int k = 0; k < 64; ++k) { gr += U[n][k] * bf2f(w[p * 64 + k]); gi += U[n][k] * bf2f(w[(64 + p) * 64 + k]); }
                const float nr = a4r * sr - a4i * si + gr, ni = a4r * si + a4i * sr + gi; sr = nr; si = ni;
                const int row = dir == 0 ? n + 1 : n; S[dir][row][p] = sr; S[dir][row][64 + p] = si; }
            if (!final_pass) { c.s5e()[io] = sr; c.s5e()[io + 1] = si; } } }
    if (!final_pass) return;
    const bf16_t* ym = c.ymat() + (size_t)(l * 24 + g) * 64 * 320;
    for (int n = 0; n < 32; ++n) for (int row = 0; row < 64; ++row) { float y = 0.f;
        for (int k = 0; k < 256; ++k) { const int dir = k >> 7, pp = k & 127; const float s = dir == 0 ? S[0][n][pp] : S[1][n + 1][pp];
            y += bf2f(ym[row * 320 + k]) * bf2f(f2bf(s)); }
        for (int k = 0; k < 64; ++k) y += bf2f(ym[row * 320 + 256 + k]) * U[n][k];
        c.v()[(size_t)(t0 + 4 * n + (row >> 4)) * 384 + 16 * g + (row & 15)] = (bf16_t)f2bf(gelu_tanh(y)); }
}
HD void st_mix1(long gtid, long gs, const Ctx& c, int l) {
    for (long i = gtid; i < (long)T * 256; i += gs) { const int t = (int)(i / 256), ch = (int)(i % 256), g = ch / 64, half = 1 << g, s = t % SEQ, b0 = t - s;
        const int lo = s - half < 0 ? 0 : s - half, hi = s + half > SEQ ? SEQ : s + half; float sum = 0.f;
        for (int q = lo; q < hi; ++q) sum += bf2f(c.z()[(size_t)(b0 + q) * D_INP + ch]);
        c.pd()[i] = sum / (float)(hi - lo) - bf2f(c.z()[(size_t)t * D_INP + ch]); }
    const float* cw = c.in[I_CONVW] + l * 4 * 384; const float* cb = c.in[I_CONVB] + l * 384;
    for (long i = gtid; i < (long)T * 384; i += gs) { const int t = (int)(i / 384), ch = (int)(i % 384), s = t % SEQ; float a = cb[ch];
        for (int j = 0; j < 4; ++j) { const int q = s - 1 + j; if (q >= 0 && q < SEQ) a += cw[j * 384 + ch] * bf2f(c.z()[(size_t)(t - 1 + j) * D_INP + 640 + ch]); }
        c.xc()[i] = a; }
}
HD void st_s5_scan(long gtid, long gs, const Ctx& c, int l, bool final_pass) {
    for (long i = gtid; i < (long)BATCH * NT * 3072; i += gs) {
        const int p = (int)(i % 64), g = (int)(i / 64) % 24, dir = (int)(i / 1536) % 2, ct = (int)(i / 3072) % NT, b = (int)(i / 3072 / NT);
        const int ci = ((l * 2 + dir) * 24 + g) * 64 + p;
        const float ar = c.s5a()[2 * ci], ai = c.s5a()[2 * ci + 1];
        float bbr[16], bbi[16];
        for (int cc = 0; cc < 16; ++cc) { bbr[cc] = c.s5bb()[(ci * 16 + cc) * 2]; bbi[cc] = c.s5bb()[(ci * 16 + cc) * 2 + 1]; }
        float xr = 0.f, xi = 0.f;
        if (final_pass) { xr = c.s5in()[2 * i]; xi = c.s5in()[2 * i + 1]; }
        for (int q = 0; q < LC; ++q) { const int tt = b * SEQ + ct * LC + (dir == 0 ? q : LC - 1 - q);
            const bf16_t* u = c.z() + (size_t)tt * D_INP + 256 + 16 * g; float bur = 0.f, bui = 0.f;
            for (int cc = 0; cc < 16; ++cc) { const float uv = bf2f(u[cc]); bur += bbr[cc] * uv; bui += bbi[cc] * uv; }
            const float nr = ar * xr - ai * xi + bur, ni = ar * xi + ai * xr + bui; xr = nr; xi = ni;
            if (final_pass) c.xbuf()[((size_t)tt * 2 + dir) * 1536 + g * 64 + p] = pk2(xr, xi); }
        if (!final_pass) { c.s5e()[2 * i] = xr; c.s5e()[2 * i + 1] = xi; }
    }
}
HD void st_mix2(long gtid, long gs, const Ctx& c, int l) {
    const float* pw = c.in[I_POOLW] + l * 4 * 64 * 64; const float* ps = c.in[I_POOLS] + l * 256;
    for (long i = gtid; i < (long)T * 256; i += gs) { const int t = (int)(i / 256), ch = (int)(i % 256), g = ch / 64, dd = ch % 64; float a = 0.f;
        for (int k = 0; k < 64; ++k) a += c.pd()[(size_t)t * 256 + g * 64 + k] * pw[(g * 64 + k) * 64 + dd];
        c.ya()[i] = a * ps[ch]; }
    for (long i = gtid; i < (long)T * 768; i += gs) { const int t = (int)(i / 768), dir = (int)(i / 384) % 2, ch = (int)(i % 384), h = ch / 64, j = ch % 64;
        const float* wa = c.in[I_WA] + (((size_t)(l * 2 + dir) * 6 + h) * 64) * 64; const float* wx = c.in[I_WX] + (((size_t)(l * 2 + dir) * 6 + h) * 64) * 64;
        float ra = c.in[I_BA][(l * 2 + dir) * 384 + ch], rx = c.in[I_BX][(l * 2 + dir) * 384 + ch];
        const float* xr = c.xc() + (size_t)t * 384 + h * 64;
        for (int k = 0; k < 64; ++k) { const float xv = xr[k]; ra += xv * wa[k * 64 + j]; rx += xv * wx[k * 64 + j]; }
        const float r = sigmoidf_(ra), ig = sigmoidf_(rx), sp = log1pf(expf(-c.in[I_LAM][(l * 2 + dir) * 384 + ch]));
        const float la = -8.f * r * sp, a = expf(la), bt = sqrtf(-expm1f(2.f * la)) * (ig * c.xc()[(size_t)t * 384 + ch]);
        c.lruab()[2 * i] = a; c.lruab()[2 * i + 1] = bt; }
    for (long i = gtid; i < (long)BATCH * 3072; i += gs) { const int r = (int)(i % 3072), b = (int)(i / 3072), dir = r / 1536; const int ci = l * 3072 + r;
        const float ar = c.s5a128()[2 * ci], ai = c.s5a128()[2 * ci + 1]; float sr = 0.f, si = 0.f;
        for (int q = 0; q < NT; ++q) { const int ct = dir == 0 ? q : NT - 1 - q; const size_t o = ((size_t)(b * NT + ct) * 3072 + r) * 2;
            c.s5in()[o] = sr; c.s5in()[o + 1] = si; const float er = c.s5e()[o], ei = c.s5e()[o + 1];
            const float nr = ar * sr - ai * si + er, ni = ar * si + ai * sr + ei; sr = nr; si = ni; } }
}
HD void st_lru_scan(long gtid, long gs, const Ctx& c, bool final_pass) {
    for (long i = gtid; i < (long)BATCH * NT * 768; i += gs) { const int r = (int)(i % 768), dir = r / 384, ch = r % 384, ct = (int)(i / 768) % NT, b = (int)(i / 768 / NT);
        float h = final_pass ? c.lruin()[i] : 0.f, P = 1.f;
        for (int q = 0; q < LC; ++q) { const int tt = b * SEQ + ct * LC + (dir == 0 ? q : LC - 1 - q); const size_t o = ((size_t)tt * 768 + r) * 2;
            const float a = c.lruab()[o], bt = c.lruab()[o + 1]; h = a * h + bt; P *= a;
            if (final_pass) c.hdir()[(size_t)tt * 768 + dir * 384 + ch] = h; }
        if (!final_pass) { c.lrupe()[2 * i] = P; c.lrupe()[2 * i + 1] = h; } }
}
HD void st_mix4(long gtid, long gs, const Ctx& c, int l, bool s5_naive) {
    for (long i = gtid; i < (long)BATCH * 768; i += gs) { const int r = (int)(i % 768), b = (int)(i / 768), dir = r / 384; float h = 0.f;
        for (int q = 0; q < NT; ++q) { const int ct = dir == 0 ? q : NT - 1 - q; const size_t o = (size_t)(b * NT + ct) * 768 + r;
            c.lruin()[o] = h; h = c.lrupe()[2 * o] * h + c.lrupe()[2 * o + 1]; } }
    if (s5_naive) for (long i = gtid; i < (long)T * 384; i += gs) { const int t = (int)(i / 384), ch = (int)(i % 384), g = ch / 16, cc = ch % 16;
        float y = c.in[I_S5D][l * 384 + ch] * bf2f(c.z()[(size_t)t * D_INP + 256 + ch]);
        for (int dir = 0; dir < 2; ++dir) { const float* cr = c.in[I_CRE] + ((size_t)((l * 2 + dir) * 24 + g) * 16 + cc) * 64; const float* cim = c.in[I_CIM] + ((size_t)((l * 2 + dir) * 24 + g) * 16 + cc) * 64;
            const unsigned* xb = c.xbuf() + ((size_t)t * 2 + dir) * 1536 + g * 64;
            for (int p = 0; p < 64; ++p) { const unsigned w = xb[p]; y += cr[p] * bf2f(w & 0xffffu) - cim[p] * bf2f(w >> 16); } }
        c.v()[i] = (bf16_t)f2bf(gelu_tanh(y)); }
}
HD float expm1_small(float x) { return x > -0.3f ? x * (1.f + x * (0.5f + x * (0.16666667f + x * (0.041666668f + x * 0.0083333338f)))) : expf(x) - 1.f; }
HD void st_prep_mixw(long gtid, long gs, const Ctx& c) {
    for (long i = gtid; i < (long)2 * 2 * 6 * 2 * 4096; i += gs) { const int ii = (int)(i % 64), j = (int)(i / 64) % 64, which = (int)(i / 4096) % 2; const long ldh = i / 8192;
        const float* w = (which ? c.in[I_WX] : c.in[I_WA]) + ldh * 4096; c.lruw_t()[i] = (bf16_t)f2bf(w[ii * 64 + j]); }
    for (long i = gtid; i < (long)2 * 4 * 4096; i += gs) { const int cc = (int)(i % 64), dd = (int)(i / 64) % 64; const long lg = i / 4096; c.poolw_t()[i] = (bf16_t)f2bf(c.in[I_POOLW][lg * 4096 + cc * 64 + dd]); }
    for (long i = gtid; i < (long)2 * 2 * 384; i += gs) ((float*)c.ctl() + SP8_OFF / 4)[i] = -8.f * log1pf(expf(-c.in[I_LAM][i]));
}
HD void mixer_tile_ref(const Ctx& c, int l, int tile) {
    const int b = tile / NT, ct = tile % NT, s0 = ct * LC, t0 = b * SEQ + s0;
    for (int t = 0; t < LC; ++t) { float ya[256]; float ss = 0.f;
        for (int ch = 0; ch < 256; ++ch) ya[ch] = 0.f;
        for (int g = 0; g < 4; ++g) { const int half = 1 << g, s = s0 + t, lo = s - half < 0 ? 0 : s - half, hi = s + half > SEQ ? SEQ : s + half; float d[64];
            for (int cc = 0; cc < 64; ++cc) { float sum = 0.f; for (int q = lo; q < hi; ++q) sum += bf2f(c.z()[(size_t)(b * SEQ + q) * D_INP + g * 64 + cc]);
                d[cc] = bf2f(f2bf(sum / (float)(hi - lo) - bf2f(c.z()[(size_t)(t0 + t) * D_INP + g * 64 + cc]))); }
            for (int dd = 0; dd < 64; ++dd) { float a = 0.f; for (int cc = 0; cc < 64; ++cc) a += d[cc] * bf2f(c.poolw_t()[((size_t)(l * 4 + g) * 64 + dd) * 64 + cc]);
                ya[g * 64 + dd] = a * c.in[I_POOLS][l * 256 + g * 64 + dd]; } }
        for (int ch = 0; ch < 256; ++ch) ss += ya[ch] * ya[ch];
        const float rstd = 1.f / sqrtf(ss * (1.f / 256) + EPS);
        for (int ch = 0; ch < 256; ++ch) c.o()[(size_t)(t0 + t) * D + ch] = (bf16_t)f2bf(ya[ch] * rstd); }
    for (int h = 0; h < 6; ++h) {
        float xc[LC][64];
        for (int t = 0; t < LC; ++t) for (int cc = 0; cc < 64; ++cc) { const int ch = h * 64 + cc; float a = c.in[I_CONVB][l * 384 + ch];
            for (int j = 0; j < 4; ++j) { const int q = s0 + t - 1 + j; if (q >= 0 && q < SEQ) a += c.in[I_CONVW][(l * 4 + j) * 384 + ch] * bf2f(c.z()[(size_t)(b * SEQ + q) * D_INP + 640 + ch]); }
            xc[t][cc] = bf2f(f2bf(a)); }
        for (int dir = 0; dir < 2; ++dir) for (int cc = 0; cc < 64; ++cc) { const int ch = h * 64 + cc, pi = (l * 2 + dir) * 384 + ch;
            const bf16_t* wa = c.lruw_t() + ((size_t)(((l * 2 + dir) * 6 + h) * 2 + 0) * 64 + cc) * 64; const bf16_t* wx = wa + 4096;
            const float sp = log1pf(expf(-c.in[I_LAM][pi])); float hh = 0.f, P = 1.f;
            for (int q = 0; q < LC; ++q) { const int t = dir == 0 ? q : LC - 1 - q; float ra = c.in[I_BA][pi], rx = c.in[I_BX][pi];
                for (int k = 0; k < 64; ++k) { ra += xc[t][k] * bf2f(wa[k]); rx += xc[t][k] * bf2f(wx[k]); }
                const float r = sigmoidf_(ra), ig = sigmoidf_(rx), la = -8.f * r * sp, a = expf(la), bt = sqrtf(-expm1_small(2.f * la)) * (ig * xc[t][cc]);
                hh = a * hh + bf2f(f2bf(bt)); P *= a;
                c.hl()[((size_t)(t0 + t) * 2 + dir) * 384 + ch] = (bf16_t)f2bf(hh); c.cp()[((size_t)(t0 + t) * 2 + dir) * 384 + ch] = (bf16_t)f2bf(P); }
            const size_t o = ((size_t)(b * NT + ct) * 768 + dir * 384 + ch) * 2; c.lrupe()[o] = P; c.lrupe()[o + 1] = hh; } }
}
HD void st_carries(long gtid, long gs, const Ctx& c, int l) {
    for (long i = gtid; i < (long)BATCH * 3072; i += gs) { const int r = (int)(i % 3072), b = (int)(i / 3072), dir = r / 1536; const int ci = l * 3072 + r;
        const float ar = c.s5a128()[2 * ci], ai = c.s5a128()[2 * ci + 1]; float sr = 0.f, si = 0.f;
        for (int q = 0; q < NT; ++q) { const int ct = dir == 0 ? q : NT - 1 - q; const size_t o = ((size_t)(b * NT + ct) * 3072 + r) * 2;
            c.s5in()[o] = sr; c.s5in()[o + 1] = si; const float er = c.s5e()[o], ei = c.s5e()[o + 1];
            const float nr = ar * sr - ai * si + er, ni = ar * si + ai * sr + ei; sr = nr; si = ni; } }
    for (long i = gtid; i < (long)BATCH * 768; i += gs) { const int r = (int)(i % 768), b = (int)(i / 768), dir = r / 384; float h = 0.f;
        for (int q = 0; q < NT; ++q) { const int ct = dir == 0 ? q : NT - 1 - q; const size_t o = (size_t)(b * NT + ct) * 768 + r;
            c.lruin()[o] = h; h = c.lrupe()[2 * o] * h + c.lrupe()[2 * o + 1]; } }
}
HD void expert_range(const unsigned* cnt, int e, int& start, int& count) { int s = 0; for (int q = 0; q < e; ++q) s += ((int)cnt[q * CNT_STRIDE] + 255) & ~255; start = s; count = (int)cnt[e * CNT_STRIDE]; }
HD void st_route(long gtid, long gs, const Ctx& c, int l) {
    const unsigned* cnt = c.ctl() + CW_CNT + 32 * l * CNT_STRIDE;
    for (long i = gtid; i < (long)T * 4; i += gs) { const int e = c.tke()[i]; int st, n; expert_range(cnt, e, st, n); const int d = st + c.tkp()[i];
        c.tkd()[i] = d; c.rowtok()[d] = (int)(i / 4); c.rowgate()[d] = c.tkg()[i]; }
    int total = 0; for (int q = 0; q < NE; ++q) total += ((int)cnt[q * CNT_STRIDE] + 255) & ~255;
    for (long r = gtid; r < total; r += gs) { int e = 0, st = 0; for (;;) { const int pe = ((int)cnt[e * CNT_STRIDE] + 255) & ~255; if (r < st + pe) break; st += pe; ++e; }
        if (r - st >= (long)cnt[e * CNT_STRIDE]) { c.rowtok()[r] = 0; c.rowgate()[r] = 0.f; }
        if ((r & 255) == 0) c.blke()[r >> 8] = e; }
    if (gtid == 0) c.ctl()[CW_NMB + l] = (unsigned)(total / 256);
}

#ifdef HOST_TEST
constexpr int NL = 1;
inline float wsum(float v) { return v; }
#else
constexpr int NL = 64;
DEV float wsum(float v) {
#pragma unroll
    for (int o = 1; o < 64; o <<= 1) v += __shfl_xor(v, o);
    return v;
}
#endif
HD void row_norm_bf16(const float* xr, bf16_t* orow, int lane) {
    float ss = 0.f;
    for (int k = lane * 4; k < D; k += NL * 4) { const float a = xr[k], b = xr[k + 1], cc = xr[k + 2], d = xr[k + 3]; ss += a * a + b * b + cc * cc + d * d; }
    const float rstd = 1.f / sqrtf(wsum(ss) * (1.f / D) + EPS);
    for (int k = lane * 4; k < D; k += NL * 4) { unsigned* o = (unsigned*)(orow + k); o[0] = pk2(xr[k] * rstd, xr[k + 1] * rstd); o[1] = pk2(xr[k + 2] * rstd, xr[k + 3] * rstd); }
}
HD void row_mix_norm(const Ctx& c, int t, int lane) {
    bf16_t* orow = c.o() + (size_t)t * D;
    { float ss = 0.f; const float* ya = c.ya() + (size_t)t * 256;
      for (int k = lane; k < 256; k += NL) ss += ya[k] * ya[k];
      const float rstd = 1.f / sqrtf(wsum(ss) * (1.f / 256) + EPS);
      for (int k = lane; k < 256; k += NL) orow[k] = (bf16_t)f2bf(ya[k] * rstd); }
    { float ss = 0.f; const bf16_t* yb = c.yb() + (size_t)t * 384;
      for (int k = lane; k < 384; k += NL) { const float y = bf2f(yb[k]); ss += y * y; }
      const float rstd = 1.f / sqrtf(wsum(ss) * (1.f / 384) + EPS);
      for (int k = lane; k < 384; k += NL) orow[256 + k] = (bf16_t)f2bf(bf2f(yb[k]) * rstd); }
    { float ss = 0.f; const float* hd = c.hdir() + (size_t)t * 768; const bf16_t* gz = c.z() + (size_t)t * D_INP + 1024;
      for (int k = lane; k < 384; k += NL) { const float y = (hd[k] + hd[384 + k]) * gelu_tanh(bf2f(gz[k])); ss += y * y; }
      const float rstd = 1.f / sqrtf(wsum(ss) * (1.f / 384) + EPS);
      for (int k = lane; k < 384; k += NL) { const float y = (hd[k] + hd[384 + k]) * gelu_tanh(bf2f(gz[k])); orow[640 + k] = (bf16_t)f2bf(y * rstd); } }
}
HD void row_mix_norm2(const Ctx& c, int t, int lane) {
    bf16_t* orow = c.o() + (size_t)t * D;
    { float ss = 0.f; const bf16_t* yb = c.yb() + (size_t)t * 384;
      for (int k = lane; k < 384; k += NL) { const float y = bf2f(yb[k]); ss += y * y; }
      const float rstd = 1.f / sqrtf(wsum(ss) * (1.f / 384) + EPS);
      for (int k = lane; k < 384; k += NL) orow[256 + k] = (bf16_t)f2bf(bf2f(yb[k]) * rstd); }
    { float ss = 0.f; const bf16_t* hl = c.hl() + (size_t)t * 768; const bf16_t* cp = c.cp() + (size_t)t * 768; const bf16_t* gz = c.z() + (size_t)t * D_INP + 1024;
      const float* cin = c.lruin() + (size_t)((t / SEQ) * NT + (t % SEQ) / LC) * 768;
      for (int k = lane; k < 384; k += NL) { const float y = (bf2f(hl[k]) + bf2f(cp[k]) * cin[k] + bf2f(hl[384 + k]) + bf2f(cp[384 + k]) * cin[384 + k]) * gelu_tanh(bf2f(gz[k])); ss += y * y; }
      const float rstd = 1.f / sqrtf(wsum(ss) * (1.f / 384) + EPS);
      for (int k = lane; k < 384; k += NL) { const float y = (bf2f(hl[k]) + bf2f(cp[k]) * cin[k] + bf2f(hl[384 + k]) + bf2f(cp[384 + k]) * cin[384 + k]) * gelu_tanh(bf2f(gz[k])); orow[640 + k] = (bf16_t)f2bf(y * rstd); } }
}
HD void row_combine(const Ctx& c, int t, int lane, bool last) {
    float* xr = c.X() + (size_t)t * D; float ss = 0.f;
    const int d0 = c.tkd()[t * 4], d1 = c.tkd()[t * 4 + 1], d2 = c.tkd()[t * 4 + 2], d3 = c.tkd()[t * 4 + 3];
    for (int k = lane * 4; k < D; k += NL * 4) {
        for (int j = 0; j < 4; ++j) { float a = xr[k + j];
            a += bf2f(c.yexp()[(size_t)d0 * 1024 + k + j]); a += bf2f(c.yexp()[(size_t)d1 * 1024 + k + j]); a += bf2f(c.yexp()[(size_t)d2 * 1024 + k + j]); a += bf2f(c.yexp()[(size_t)d3 * 1024 + k + j]);
            xr[k + j] = a; ss += a * a; } }
    const float rstd = 1.f / sqrtf(wsum(ss) * (1.f / D) + EPS);
    if (!last) { bf16_t* orow = c.hb() + (size_t)t * D;
        for (int k = lane * 4; k < D; k += NL * 4) { unsigned* o = (unsigned*)(orow + k); o[0] = pk2(xr[k] * rstd, xr[k + 1] * rstd); o[1] = pk2(xr[k + 2] * rstd, xr[k + 3] * rstd); } }
    else { float* orow = c.out + (size_t)t * D; const float* fg = c.in[I_FING];
        for (int k = lane * 4; k < D; k += NL * 4) for (int j = 0; j < 4; ++j) orow[k + j] = xr[k + j] * rstd * fg[k + j]; }
}

HD void st_bf16x4(bf16_t* p, float a, float b, float cc, float d) { unsigned* o = (unsigned*)p; o[0] = pk2(a, b); o[1] = pk2(cc, d); }
struct EpiIn { static constexpr bool SIDE = false; bf16_t* z; HD void operator()(const Unit&, int row, int col, const f32x4& v) const { st_bf16x4(z + (size_t)row * D_INP + col, v[0], v[1], v[2], v[3]); } };
struct EpiGlu { static constexpr bool SIDE = false; bf16_t* yb; const float* b;
    HD void operator()(const Unit&, int row, int col, const f32x4& v) const { const int j = col >> 1;
        const float y0 = (v[0] + b[j]) * sigmoid_fast(v[1] + b[384 + j]), y1 = (v[2] + b[j + 1]) * sigmoid_fast(v[3] + b[384 + j + 1]);
        *(unsigned*)(yb + (size_t)row * 384 + j) = pk2(y0, y1); } };
struct EpiOut { static constexpr bool SIDE = false; const float* base; float* X;
#ifdef HOST_TEST
    HD void operator()(const Unit&, int row, int col, const f32x4& v) const { const size_t o = (size_t)row * D + col; for (int j = 0; j < 4; ++j) X[o + j] = base[o + j] + v[j]; } };
#else
    __device__ __forceinline__ void operator()(const Unit&, int row, int col, const f32x4& v) const { const size_t o = (size_t)row * D + col; const f32x4 r = *(const __attribute__((address_space(1))) f32x4*)(base + o) + v; *(__attribute__((address_space(1))) f32x4*)(X + o) = r; } };
#endif
#ifndef HOST_TEST
template <bool BASE_F32>
struct EpiOutW { static constexpr bool SIDE = false; const void* base; bf16_t* X;
    __device__ __forceinline__ void wide(const Unit&, int row, int col, const f32x4& a, const f32x4& b) const { typedef unsigned u4_ __attribute__((ext_vector_type(4)));
        const size_t o = (size_t)row * D + col; f32x4 r0, r1;
        if constexpr (BASE_F32) { const __attribute__((address_space(1))) f32x4* p = (const __attribute__((address_space(1))) f32x4*)((const float*)base + o); r0 = p[0]; r1 = p[1]; }
        else { const u4_ w = *(const __attribute__((address_space(1))) u4_*)((const bf16_t*)base + o);
            r0 = (f32x4){__builtin_bit_cast(float, w.x << 16), __builtin_bit_cast(float, w.x & 0xffff0000u), __builtin_bit_cast(float, w.y << 16), __builtin_bit_cast(float, w.y & 0xffff0000u)};
            r1 = (f32x4){__builtin_bit_cast(float, w.z << 16), __builtin_bit_cast(float, w.z & 0xffff0000u), __builtin_bit_cast(float, w.w << 16), __builtin_bit_cast(float, w.w & 0xffff0000u)}; }
        r0 += a; r1 += b;
        u4_ q; q.x = pk2(r0[0], r0[1]); q.y = pk2(r0[2], r0[3]); q.z = pk2(r1[0], r1[1]); q.w = pk2(r1[2], r1[3]);
        *(__attribute__((address_space(1))) u4_*)(X + o) = q; } };
#endif
struct EpiMoe1 { static constexpr bool SIDE = false; bf16_t* act; const float* bgu;
    HD void operator()(const Unit& u, int row, int col, const f32x4& v) const { const float* b = bgu + (size_t)u.e * 2048 + col; float r[2];
        for (int q = 0; q < 2; ++q) { float g = v[2 * q] + b[2 * q], up = v[2 * q + 1] + b[2 * q + 1]; g = g < 7.f ? g : 7.f; up = up < -7.f ? -7.f : (up > 7.f ? 7.f : up);
            r[q] = (up + 1.f) * (g * sigmoid_fast(1.702f * g)); }
        *(unsigned*)(act + (size_t)row * 1024 + (col >> 1)) = pk2(r[0], r[1]); } };
struct EpiMoe2 { static constexpr bool SIDE = false; bf16_t* yexp; const float* bdn; const float* rowgate;
    HD void operator()(const Unit& u, int row, int col, const f32x4& v) const { const float* b = bdn + (size_t)u.e * 1024 + col; const float g = rowgate[row];
        st_bf16x4(yexp + (size_t)row * 1024 + col, (v[0] + b[0]) * g, (v[1] + b[1]) * g, (v[2] + b[2]) * g, (v[3] + b[3]) * g); } };

#ifndef HOST_TEST
#define LAS __attribute__((address_space(3)))
__device__ __forceinline__ unsigned f32x2_to_fp8(float a, float b) { return (unsigned)__builtin_amdgcn_cvt_pk_fp8_f32(a, b, 0, false) & 0xffffu; }
constexpr float W8_SCALE = 64.f, W8_INV = 1.f / 64.f;
struct EpiInW { static constexpr bool SIDE = false; bf16_t* z;
    __device__ __forceinline__ void wide(const Unit&, int row, int col, const f32x4& a, const f32x4& b) const { typedef unsigned u4_ __attribute__((ext_vector_type(4))); u4_ w; w.x = pk2(a[0], a[1]); w.y = pk2(a[2], a[3]); w.z = pk2(b[0], b[1]); w.w = pk2(b[2], b[3]);
        if (col < D_IN) *(__attribute__((address_space(1))) u4_*)(z + (size_t)row * D_INP + col) = w; } };
struct EpiGluW { static constexpr bool SIDE = true; bf16_t* yb; const float* b;
    __device__ __forceinline__ void load_side(const Unit& u, LAS unsigned char* sp, int par, int tid) const { if (tid < 256) { const int col = u.pn * 256 + tid; ((LAS float*)(sp + par * 1024))[tid] = b[(col & 1) * 384 + (col >> 1)]; } }
    __device__ __forceinline__ void wide_side(const Unit&, int row, int col, const f32x4& a, const f32x4& c2, LAS unsigned char* sp, int par) const { const LAS float* bp = (const LAS float*)(sp + par * 1024) + (col & 255); const f32x4 b0 = *(const LAS f32x4*)bp, b1 = *(const LAS f32x4*)(bp + 4);
        const float y0 = (a[0] + b0[0]) * sigmoid_fast(a[1] + b0[1]), y1 = (a[2] + b0[2]) * sigmoid_fast(a[3] + b0[3]), y2 = (c2[0] + b1[0]) * sigmoid_fast(c2[1] + b1[1]), y3 = (c2[2] + b1[2]) * sigmoid_fast(c2[3] + b1[3]);
        typedef unsigned u2_ __attribute__((ext_vector_type(2))); u2_ w; w.x = pk2(y0, y1); w.y = pk2(y2, y3); *(__attribute__((address_space(1))) u2_*)(yb + (size_t)row * 384 + (col >> 1)) = w; } };
struct EpiNullW { static constexpr bool SIDE = false; __device__ __forceinline__ void wide(const Unit&, int, int, const f32x4&, const f32x4&) const {} };
struct EpiMoe1F8 { static constexpr bool SIDE = true; unsigned char* act8; const float* bgu;
    __device__ __forceinline__ void load_side(const Unit& u, LAS unsigned char* sp, int par, int tid) const { if (tid < 256) ((LAS float*)(sp + par * 1024))[tid] = bgu[(size_t)u.e * 2048 + u.pn * 256 + tid]; }
    __device__ __forceinline__ void wide_side(const Unit& u, int row, int col, const f32x4& a, const f32x4& c2, LAS unsigned char* sp, int par) const { const LAS float* bp = (const LAS float*)(sp + par * 1024) + (col & 255); const f32x4 b0 = *(const LAS f32x4*)bp, b1 = *(const LAS f32x4*)(bp + 4); float r[4];
#pragma unroll
        for (int q = 0; q < 4; ++q) { float g = (q < 2 ? a[2 * q] : c2[2 * q - 4]) * W8_INV + (q < 2 ? b0[2 * q] : b1[2 * q - 4]), up = (q < 2 ? a[2 * q + 1] : c2[2 * q - 3]) * W8_INV + (q < 2 ? b0[2 * q + 1] : b1[2 * q - 3]);
            g = __builtin_fminf(g, 7.f); up = __builtin_amdgcn_fmed3f(up, -7.f, 7.f); r[q] = (up + 1.f) * (g * __builtin_amdgcn_rcpf(1.f + __builtin_amdgcn_exp2f(g * -2.4554669595930157f))); }
        *(__attribute__((address_space(1))) unsigned*)(act8 + (size_t)row * 1024 + (col >> 1)) = f32x2_to_fp8(r[0], r[1]) | (f32x2_to_fp8(r[2], r[3]) << 16); }
    __device__ __forceinline__ void wide(const Unit& u, int row, int col, const f32x4& a, const f32x4& c2) const { const float* bp = bgu + (size_t)u.e * 2048 + col; const f32x4 b0 = *(const f32x4*)bp, b1 = *(const f32x4*)(bp + 4); float r[4];
#pragma unroll
        for (int q = 0; q < 4; ++q) { float g = (q < 2 ? a[2 * q] : c2[2 * q - 4]) * W8_INV + (q < 2 ? b0[2 * q] : b1[2 * q - 4]), up = (q < 2 ? a[2 * q + 1] : c2[2 * q - 3]) * W8_INV + (q < 2 ? b0[2 * q + 1] : b1[2 * q - 3]);
            g = __builtin_fminf(g, 7.f); up = __builtin_amdgcn_fmed3f(up, -7.f, 7.f); r[q] = (up + 1.f) * (g * __builtin_amdgcn_rcpf(1.f + __builtin_amdgcn_exp2f(g * -2.4554669595930157f))); }
        *(unsigned*)(act8 + (size_t)row * 1024 + (col >> 1)) = f32x2_to_fp8(r[0], r[1]) | (f32x2_to_fp8(r[2], r[3]) << 16); }
    __device__ __forceinline__ void operator()(const Unit& u, int row, int col, const f32x4& v) const { const float* b = bgu + (size_t)u.e * 2048 + col; float r[2];
        for (int q = 0; q < 2; ++q) { float g = v[2 * q] * W8_INV + b[2 * q], up = v[2 * q + 1] * W8_INV + b[2 * q + 1]; g = g < 7.f ? g : 7.f; up = up < -7.f ? -7.f : (up > 7.f ? 7.f : up);
            r[q] = (up + 1.f) * (g * sigmoid_fast(1.702f * g)); }
        *(unsigned short*)(act8 + (size_t)row * 1024 + (col >> 1)) = (unsigned short)f32x2_to_fp8(r[0], r[1]); } };
struct EpiMoe2F8 { static constexpr bool SIDE = true; bf16_t* yexp; const float* bdn; const float* rowgate;
    __device__ __forceinline__ void load_side(const Unit& u, LAS unsigned char* sp, int par, int tid) const { if (tid < 256) ((LAS float*)(sp + par * 1024))[tid] = bdn[(size_t)u.e * 1024 + u.pn * 256 + tid]; else ((LAS float*)(sp + 2048 + par * 1024))[tid - 256] = rowgate[u.pm * 256 + tid - 256]; }
    __device__ __forceinline__ void wide_side(const Unit& u, int row, int col, const f32x4& a, const f32x4& c2, LAS unsigned char* sp, int par) const { typedef unsigned u4_ __attribute__((ext_vector_type(4))); const LAS float* bp = (const LAS float*)(sp + par * 1024) + (col & 255); const f32x4 b0 = *(const LAS f32x4*)bp, b1 = *(const LAS f32x4*)(bp + 4);
        const float g = ((const LAS float*)(sp + 2048 + par * 1024))[row & 255];
        u4_ w; w.x = pk2((a[0] * W8_INV + b0[0]) * g, (a[1] * W8_INV + b0[1]) * g); w.y = pk2((a[2] * W8_INV + b0[2]) * g, (a[3] * W8_INV + b0[3]) * g); w.z = pk2((c2[0] * W8_INV + b1[0]) * g, (c2[1] * W8_INV + b1[1]) * g); w.w = pk2((c2[2] * W8_INV + b1[2]) * g, (c2[3] * W8_INV + b1[3]) * g);
        *(__attribute__((address_space(1))) u4_*)(yexp + (size_t)row * 1024 + col) = w; }
    __device__ __forceinline__ void wide(const Unit& u, int row, int col, const f32x4& a, const f32x4& c2) const { typedef unsigned u4_ __attribute__((ext_vector_type(4))); const float* bp = bdn + (size_t)u.e * 1024 + col; const f32x4 b0 = *(const f32x4*)bp, b1 = *(const f32x4*)(bp + 4); const float g = rowgate[row];
        u4_ w; w.x = pk2((a[0] * W8_INV + b0[0]) * g, (a[1] * W8_INV + b0[1]) * g); w.y = pk2((a[2] * W8_INV + b0[2]) * g, (a[3] * W8_INV + b0[3]) * g); w.z = pk2((c2[0] * W8_INV + b1[0]) * g, (c2[1] * W8_INV + b1[1]) * g); w.w = pk2((c2[2] * W8_INV + b1[2]) * g, (c2[3] * W8_INV + b1[3]) * g);
        *(u4_*)(yexp + (size_t)row * 1024 + col) = w; }
    __device__ __forceinline__ void operator()(const Unit& u, int row, int col, const f32x4& v) const { const float* b = bdn + (size_t)u.e * 1024 + col; const float g = rowgate[row];
        st_bf16x4(yexp + (size_t)row * 1024 + col, (v[0] * W8_INV + b[0]) * g, (v[1] * W8_INV + b[1]) * g, (v[2] * W8_INV + b[2]) * g, (v[3] * W8_INV + b[3]) * g); } };
#endif
HD int wmap_row(int mode, int n) { return mode == 0 ? n : (n < 384 ? 2 * n : 2 * (n - 384) + 1); }

#ifndef HOST_TEST
#ifndef LAS
#define LAS __attribute__((address_space(3)))
#endif
#define GAS __attribute__((address_space(1)))
typedef short bf16x8 __attribute__((ext_vector_type(8)));
typedef unsigned v4u __attribute__((ext_vector_type(4)));
constexpr int NWAVES = 8;

namespace pg8 {
constexpr int BM = 256, BK = 64, HALF = 128, HTB = HALF * BK * 2, STAGE_BYTES = 8 * HTB, NXCD = 8, WGM = 8;
__host__ __device__ __forceinline__ int lds_byte(int r, int c) { const int st = (r >> 4) * 2 + (c >> 5), rr = r & 15, cc = c & 31, ob = rr * 64 + cc * 2; return st * 1024 + (ob ^ (((ob >> 9) & 1) << 5)); }
__host__ __device__ __forceinline__ void stage_rc(int b, int& R, int& C) { const int st = b / 1024, sb = b % 1024, swz = sb ^ (((sb >> 9) & 1) << 5); R = (st >> 1) * 16 + swz / 64; C = (st & 1) * 32 + (swz % 64) / 2; }
struct StaticOrder {
    int nM, nN, nwg, G, c;
    __device__ __forceinline__ void init(int nM_, int nN_, int G_, int c_) { nM = nM_; nN = nN_; nwg = nM * nN; G = G_; c = c_; }
    __device__ __forceinline__ bool next(int i, Unit& u) const {
        const long L = (long)i * G + c; if (L >= nwg) return false;
        int wgid = (int)L; { const int q = nwg / NXCD, r = nwg % NXCD, xcd = wgid % NXCD, off = wgid / NXCD; wgid = (xcd < r ? xcd * (q + 1) : r * (q + 1) + (xcd - r) * q) + off; }
        const int nig = WGM * nN, gid = wgid / nig, fm = gid * WGM, gsz = (nM - fm) < WGM ? (nM - fm) : WGM;
        u.pm = fm + ((wgid % nig) % gsz); u.pn = (wgid % nig) / gsz; u.e = 0; return true;
    }
};
struct SchedPlain { StaticOrder so; const char* Bt; size_t tstepB; const int* rowtab;
    __device__ __forceinline__ bool next(int i, Unit& u) const { return so.next(i, u); }
    __device__ __forceinline__ const char* bptr(const Unit& u) const { return Bt + (size_t)u.pn * tstepB; } };
struct SchedMoe { StaticOrder so; const char* Bt; size_t tstepB, estride; const int* rowtab; const int* blke; const LAS int* ue;
    __device__ __forceinline__ bool next(int i, Unit& u) const { if (!so.next(i, u)) return false; u.e = ue[i]; return true; }
    __device__ __forceinline__ const char* bptr(const Unit& u) const { return Bt + (size_t)u.e * estride + (size_t)u.pn * tstepB; } };

__host__ __device__ __forceinline__ int perm32(int rho) { const int n = rho >> 4, i = rho & 15; return 8 * (i >> 2) + 4 * n + (i & 3); }
template <class Epi, class Sched, bool GATHER, bool F8 = false, bool PERM = false>
__device__ __forceinline__ void gemm_phase(LAS unsigned char* lds, const int wave_id, const bf16_t* A, const int K, const Sched& S, const Epi& E) {
    int lane_ = (int)__builtin_amdgcn_mbcnt_hi(~0u, __builtin_amdgcn_mbcnt_lo(~0u, 0u)); asm volatile("" : "+v"(lane_));
    const int wid = wave_id, lane = lane_, tid = wid * 64 + lane, wr = wid >> 2, wc = wid & 3, fr = lane & 15, fq = lane >> 4;
    const int nt = K / BK;
    unsigned voffA[2], voffB[2];
#pragma unroll
    for (int i = 0; i < 2; ++i) { int R, C; stage_rc(tid * 16 + i * 8192, R, C); voffA[i] = (unsigned)(R * K + C) * 2u; const int Rb = PERM ? ((R & ~31) + perm32(R & 31)) : R; voffB[i] = (unsigned)(Rb * K + C) * 2u; }
    const size_t kstep = (size_t)(BK * 2);
    const size_t hstep = (size_t)HALF * K * 2;
    const unsigned ldsw = (unsigned)wid * 1024u;
    const int aoff = lds_byte(wr * 64 + fr, fq * 8), boff = lds_byte(wc * 32 + fr, fq * 8);
#define PG8_SA(b, h) (((b) * 2 + (h)) * HTB)
#define PG8_SB(b, h) ((4 + (b) * 2 + (h)) * HTB)
#define PG8_STAGE(bufoff, gbase, voff) do { _Pragma("unroll") for (int _i = 0; _i < 2; ++_i) \
        __builtin_amdgcn_global_load_lds((const unsigned*)((const char*)(gbase) + (voff)[_i]), (LAS unsigned*)(lds + (bufoff) + ldsw + _i * 8192), 16, 0, 0); } while (0)
#define PG8_LDA(dst, b, h) do { _Pragma("unroll") for (int m = 0; m < 4; ++m) _Pragma("unroll") for (int k = 0; k < 2; ++k) dst[m][k] = *(const LAS bf16x8*)(lds + PG8_SA(b, h) + aoff + m * 2048 + k * 1024); } while (0)
#define PG8_LDB(dst, b, h) do { _Pragma("unroll") for (int n = 0; n < 2; ++n) _Pragma("unroll") for (int k = 0; k < 2; ++k) dst[n][k] = *(const LAS bf16x8*)(lds + PG8_SB(b, h) + boff + n * 2048 + k * 1024); } while (0)
#define PG8_MMA(ai, bj, At, Bt) do { __builtin_amdgcn_s_setprio(1); _Pragma("unroll") for (int m = 0; m < 4; ++m) _Pragma("unroll") for (int n = 0; n < 2; ++n) _Pragma("unroll") for (int k = 0; k < 2; ++k) \
        asm volatile("s_nop 1\n\tv_mfma_f32_16x16x32_bf16 %0, %1, %2, %0" : "+v"(acc[ai][bj][m][n]) : "v"(Bt[n][k]), "v"(At[m][k])); __builtin_amdgcn_s_setprio(0); } while (0)
    typedef int v4i_ __attribute__((ext_vector_type(4))); typedef int v8i_ __attribute__((ext_vector_type(8)));
    int sc1 = 0x7f7f7f7f; asm volatile("" : "+v"(sc1));
#define PG8_MMA8(ai, bj, At, Bt) do { __builtin_amdgcn_s_setprio(1); _Pragma("unroll") for (int m = 0; m < 4; ++m) _Pragma("unroll") for (int n = 0; n < 2; ++n) { \
        const v8i_ a8_ = __builtin_shufflevector(__builtin_bit_cast(v4i_, At[m][0]), __builtin_bit_cast(v4i_, At[m][1]), 0, 1, 2, 3, 4, 5, 6, 7), b8_ = __builtin_shufflevector(__builtin_bit_cast(v4i_, Bt[n][0]), __builtin_bit_cast(v4i_, Bt[n][1]), 0, 1, 2, 3, 4, 5, 6, 7); \
        asm volatile("s_nop 1\n\tv_mfma_scale_f32_16x16x128_f8f6f4 %0, %1, %2, %0, %3, %3 op_sel_hi:[0,0,0]" : "+v"(acc[ai][bj][m][n]) : "v"(b8_), "v"(a8_), "v"(sc1)); } __builtin_amdgcn_s_setprio(0); } while (0)
#define PG8_MM(ai, bj, At, Bt) do { if constexpr (F8) PG8_MMA8(ai, bj, At, Bt); else PG8_MMA(ai, bj, At, Bt); } while (0)
#define PG8_WAIT_V(n) asm volatile("s_waitcnt vmcnt(" #n ")" ::: "memory")
#define PG8_WAIT_L(n) asm volatile("s_waitcnt lgkmcnt(" #n ")" ::: "memory")
#define PG8_BAR __builtin_amdgcn_s_barrier()
#define PG8_SCHED __builtin_amdgcn_sched_barrier(0)
#define PG8_ROWS(u, dst) do { _Pragma("unroll") for (int h = 0; h < 2; ++h) _Pragma("unroll") for (int i = 0; i < 2; ++i) { int R, C; stage_rc(tid * 16 + i * 8192, R, C); \
        const int rix = S.rowtab[(u).pm * BM + h * HALF + R]; dst[h][i] = (unsigned)rix * (unsigned)(K * 2) + (unsigned)C * 2u; } } while (0)
#define PG8_STAGE_A(bufoff, h, koff, nx) do { if constexpr (GATHER) { _Pragma("unroll") for (int _i = 0; _i < 2; ++_i) \
            __builtin_amdgcn_global_load_lds((const unsigned*)((const char*)A + (koff) + ((nx) ? vn[h][_i] : vc[h][_i])), (LAS unsigned*)(lds + (bufoff) + ldsw + _i * 8192), 16, 0, 0); } \
        else { const char* _b = ((nx) ? nA : cA) + (h) * hstep + (koff); _Pragma("unroll") for (int _i = 0; _i < 2; ++_i) \
            __builtin_amdgcn_global_load_lds((const unsigned*)(_b + voffA[_i]), (LAS unsigned*)(lds + (bufoff) + ldsw + _i * 8192), 16, 0, 0); } } while (0)
    Unit cur, nxt; int ui = 0;
    if (!S.next(0, cur)) return;
    if constexpr (Epi::SIDE) E.load_side(cur, lds + STAGE_BYTES, 0, tid);
    f32x4 acc[2][2][4][2];
#pragma unroll
    for (int a = 0; a < 2; ++a)
#pragma unroll
        for (int b = 0; b < 2; ++b)
#pragma unroll
            for (int m = 0; m < 4; ++m)
#pragma unroll
                for (int n = 0; n < 2; ++n) acc[a][b][m][n] = (f32x4){0.f, 0.f, 0.f, 0.f};
    bf16x8 At[4][2], B0[2][2], B1[2][2];
    unsigned vc[2][2], vn[2][2];
    const size_t tstepA = 2 * hstep;
    const char* cA = (const char*)A; const char* nA = cA;
    if constexpr (GATHER) { PG8_ROWS(cur, vc); } else { cA = (const char*)A + (size_t)cur.pm * tstepA; }
    const char* cB = S.bptr(cur);
    PG8_STAGE(PG8_SB(0, 0), cB, voffB); PG8_STAGE_A(PG8_SA(0, 0), 0, 0, false); PG8_STAGE(PG8_SB(0, 1), cB + hstep, voffB); PG8_STAGE_A(PG8_SA(0, 1), 1, 0, false);
    if (wr == 1) PG8_BAR;
    PG8_WAIT_V(4); PG8_BAR;
    PG8_STAGE(PG8_SB(1, 0), cB + kstep, voffB); PG8_STAGE_A(PG8_SA(1, 0), 0, kstep, false); PG8_STAGE(PG8_SB(1, 1), cB + hstep + kstep, voffB);
    PG8_WAIT_V(6); PG8_BAR;
    for (;;) {
        const bool has_next = S.next(ui + 1, nxt);
        if constexpr (GATHER) {
            if (has_next) { PG8_ROWS(nxt, vn); } else {
#pragma unroll
                for (int h = 0; h < 2; ++h)
#pragma unroll
                    for (int i = 0; i < 2; ++i) vn[h][i] = vc[h][i]; }
        } else { nA = has_next ? (const char*)A + (size_t)nxt.pm * tstepA : cA; }
        const char* nB = has_next ? S.bptr(nxt) : cB;
        for (int t = 0; t < nt; t += 2) {
            const bool last = (t == nt - 2);
            const size_t k1 = (size_t)(t + 1) * kstep, k2 = last ? 0 : (size_t)(t + 2) * kstep, k3 = k2 + kstep;
            const char* b2 = last ? nB : cB + (size_t)(t + 2) * kstep; const char* b3 = b2 + kstep;
            PG8_LDB(B0, 0, 0); PG8_SCHED; PG8_LDA(At, 0, 0); PG8_STAGE_A(PG8_SA(1, 1), 1, k1, false);
            PG8_WAIT_L(8); PG8_BAR; PG8_WAIT_L(0); PG8_MM(0, 0, At, B0); PG8_BAR; PG8_SCHED;
            PG8_LDB(B1, 0, 1); PG8_STAGE(PG8_SB(0, 0), b2, voffB);
            PG8_BAR; PG8_WAIT_L(0); PG8_MM(0, 1, At, B1); PG8_BAR;
            PG8_LDA(At, 0, 1); PG8_STAGE_A(PG8_SA(0, 0), 0, k2, last);
            PG8_BAR; PG8_WAIT_L(0); PG8_MM(1, 0, At, B0); PG8_BAR; PG8_SCHED;
            PG8_STAGE(PG8_SB(0, 1), b2 + hstep, voffB);
            PG8_WAIT_V(6); PG8_BAR; PG8_MM(1, 1, At, B1); PG8_BAR;
            PG8_LDB(B0, 1, 0); PG8_SCHED; PG8_LDA(At, 1, 0); PG8_STAGE_A(PG8_SA(0, 1), 1, k2, last);
            PG8_WAIT_L(8); PG8_BAR; PG8_WAIT_L(0); PG8_MM(0, 0, At, B0); PG8_BAR; PG8_SCHED;
            PG8_LDB(B1, 1, 1); PG8_STAGE(PG8_SB(1, 0), b3, voffB);
            PG8_BAR; PG8_WAIT_L(0); PG8_MM(0, 1, At, B1); PG8_BAR;
            PG8_LDA(At, 1, 1); PG8_STAGE_A(PG8_SA(1, 0), 0, k3, last);
            PG8_BAR; PG8_WAIT_L(0); PG8_MM(1, 0, At, B0); PG8_BAR; PG8_SCHED;
            PG8_STAGE(PG8_SB(1, 1), b3 + hstep, voffB);
            PG8_WAIT_V(6); PG8_BAR; PG8_MM(1, 1, At, B1); PG8_BAR;
        }
        asm volatile("s_nop 15\n\ts_nop 15" : "+v"(acc[0][0][0][0]), "+v"(acc[1][1][3][1]));
        Unit eu; eu.pm = __builtin_amdgcn_readfirstlane(cur.pm); eu.pn = __builtin_amdgcn_readfirstlane(cur.pn); eu.e = __builtin_amdgcn_readfirstlane(cur.e); int rbase = wr * 64 + fr, cbase = wc * 32 + 4 * fq;
        asm volatile("" : "+s"(eu.pm), "+s"(eu.pn), "+s"(eu.e), "+v"(rbase), "+v"(cbase));
#pragma unroll
        for (int ai = 0; ai < 2; ++ai)
#pragma unroll
            for (int m = 0; m < 4; ++m) { const int row = eu.pm * BM + ai * HALF + m * 16 + rbase;
                if constexpr (PERM) {
#pragma unroll
                    for (int bj = 0; bj < 2; ++bj) { if constexpr (Epi::SIDE) E.wide_side(eu, row, eu.pn * BM + bj * HALF + 2 * cbase - (cbase & ~31), acc[ai][bj][m][0], acc[ai][bj][m][1], lds + STAGE_BYTES, ui & 1);
                        else E.wide(eu, row, eu.pn * BM + bj * HALF + 2 * cbase - (cbase & ~31), acc[ai][bj][m][0], acc[ai][bj][m][1]);
                        if constexpr (Epi::SIDE) asm volatile("" ::: "memory"); }
                } else {
#pragma unroll
                for (int bj = 0; bj < 2; ++bj)
#pragma unroll
                    for (int n = 0; n < 2; ++n) E(eu, row, eu.pn * BM + bj * HALF + n * 16 + cbase, acc[ai][bj][m][n]);
                }
                asm volatile("" ::: "memory"); }
        if (!has_next) break;
#pragma unroll
        for (int a = 0; a < 2; ++a)
#pragma unroll
            for (int b = 0; b < 2; ++b)
#pragma unroll
                for (int m = 0; m < 4; ++m)
#pragma unroll
                    for (int n = 0; n < 2; ++n) acc[a][b][m][n] = (f32x4){0.f, 0.f, 0.f, 0.f};
        cur = nxt; cB = nB; cA = nA; ++ui;
        if constexpr (Epi::SIDE) { int tid_s = tid; asm volatile("" : "+v"(tid_s)); E.load_side(cur, lds + STAGE_BYTES, ui & 1, tid_s); }
        if constexpr (GATHER) {
#pragma unroll
            for (int h = 0; h < 2; ++h)
#pragma unroll
                for (int i = 0; i < 2; ++i) vc[h][i] = vn[h][i]; }
    }
    PG8_WAIT_V(0);
    if (wr == 0) PG8_BAR;
    PG8_BAR;
#undef PG8_SA
#undef PG8_SB
#undef PG8_STAGE
#undef PG8_LDA
#undef PG8_LDB
#undef PG8_MMA
#undef PG8_MMA8
#undef PG8_MM
#undef PG8_WAIT_V
#undef PG8_WAIT_L
#undef PG8_BAR
#undef PG8_SCHED
#undef PG8_ROWS
#undef PG8_STAGE_A
}
}

#define XB_TMO      128
#define XB_XCNT(j)  (256  + 64 * (j))
#define XB_XSUB(j)  (1280 + 64 * (j))
#define XB_XGEN(j)  (2304 + 64 * (j))
#define XB_TOP      3328
#define XB_TOPGEN   3392
#define XCD_BAR_WORDS 3456
#define XB_SPIN_CAP (1u << 18)
__device__ __forceinline__ unsigned xb_ld(unsigned* p)              { return __hip_atomic_load(p, __ATOMIC_RELAXED, __HIP_MEMORY_SCOPE_AGENT); }
__device__ __forceinline__ unsigned xb_add(unsigned* p, unsigned v) { return __hip_atomic_fetch_add(p, v, __ATOMIC_RELAXED, __HIP_MEMORY_SCOPE_AGENT); }
__device__ __forceinline__ unsigned xb_xcc_id() { return (unsigned)__builtin_amdgcn_s_getreg((3 << 11) | 20) & 0xFu; }
#define XB_SPIN(cond, bar) do { unsigned _sp = 0; while (cond) { __builtin_amdgcn_s_sleep(1); \
    if ((++_sp & 255u) == 0u) { if (xb_ld(&(bar)[XB_TMO])) break; if (_sp > XB_SPIN_CAP) { atomicAdd(&(bar)[XB_TMO], 1u); break; } } } } while (0)
struct XcdBarrier { unsigned* bar; unsigned x; volatile LAS unsigned* st; };
__device__ __forceinline__ XcdBarrier xcd_barrier_post(unsigned* bar, volatile LAS unsigned* st) {
    XcdBarrier b; b.bar = bar; b.x = xb_xcc_id(); b.st = st;
    if (threadIdx.x == 0) (void)xb_add(&bar[XB_XCNT(b.x)], 1u);
    return b;
}
__device__ __forceinline__ void xcd_barrier_complete(unsigned* bar, unsigned x, unsigned& nloc, unsigned& nx) {
    const unsigned G = gridDim.x * gridDim.y * gridDim.z;
    unsigned sum, cnt, mine, sp = 0u;
    for (;;) {
        sum = 0u; cnt = 0u; mine = 0u;
#pragma unroll
        for (unsigned j = 0; j < 16; ++j) { const unsigned c = xb_ld(&bar[XB_XCNT(j)]); sum += c; cnt += (c > 0u) ? 1u : 0u; mine = (j == x) ? c : mine; }
        if (sum == G) break;
        __builtin_amdgcn_s_sleep(1);
        if ((++sp & 255u) == 0u) { if (xb_ld(&bar[XB_TMO])) break; if (sp > XB_SPIN_CAP) { atomicAdd(&bar[XB_TMO], 1u); break; } }
    }
    nloc = mine > 0u ? mine : 1u; nx = cnt > 0u ? cnt : 1u;
}
__device__ __forceinline__ void xcd_barrier(const XcdBarrier& b, const bool leader) {
    asm volatile("s_waitcnt vmcnt(0)" ::: "memory");
    __syncthreads();
    if (leader) {
        unsigned* bar = b.bar;
        __builtin_amdgcn_s_waitcnt(0);
        unsigned nloc = b.st[0], nx = b.st[1];
        if (nloc == 0u) { xcd_barrier_complete(bar, b.x, nloc, nx); b.st[0] = nloc; b.st[1] = nx; }
        const unsigned old = xb_add(&bar[XB_XSUB(b.x)], 1u);
        const unsigned gen = old / nloc;
        if (old + 1u == (gen + 1u) * nloc) {
            __builtin_amdgcn_fence(__ATOMIC_RELEASE, "agent");
            asm volatile("s_waitcnt vmcnt(0)" ::: "memory");
            const unsigned og = xb_add(&bar[XB_TOP], 1u);
            const unsigned tg = og / nx;
            if (og + 1u == (tg + 1u) * nx) xb_add(&bar[XB_TOPGEN], 1u);
            else XB_SPIN(xb_ld(&bar[XB_TOPGEN]) == tg, bar);
            __builtin_amdgcn_fence(__ATOMIC_ACQUIRE, "agent");
            xb_add(&bar[XB_XGEN(b.x)], 1u);
            asm volatile("s_waitcnt vmcnt(0)" ::: "memory");
        } else {
            XB_SPIN(xb_ld(&bar[XB_XGEN(b.x)]) == gen, bar);
            __builtin_amdgcn_fence(__ATOMIC_ACQUIRE, "agent");
            asm volatile("s_waitcnt vmcnt(0)" ::: "memory");
        }
    }
    __syncthreads();
}

constexpr int RING_BYTES = 131072, LDSCTL_OFF = 143616, LDS_BYTES = 147456;

__device__ __forceinline__ void transpose_item(const float* W, int K, int N, bf16_t* WT, int mode, const float* scale, LAS float* scr, int item, int lane) {
    const int nblk = N / 64, kb = item / nblk, nb = item % nblk, k0 = 64 * kb, n0 = 64 * nb;
    const int n4 = (lane & 15) * 4, kr = lane >> 4;
#pragma unroll 8
    for (int i = 0; i < 16; ++i) { const int kk = 4 * i + kr; f32x4 w = __builtin_nontemporal_load((const __attribute__((address_space(1))) f32x4*)(W + (size_t)(k0 + kk) * N + n0 + n4)); if (scale) w = w * *(const __attribute__((address_space(1))) float*)(scale + k0 + kk);
        scr[kk * 65 + n4] = w[0]; scr[kk * 65 + n4 + 1] = w[1]; scr[kk * 65 + n4 + 2] = w[2]; scr[kk * 65 + n4 + 3] = w[3]; }
    asm volatile("s_waitcnt lgkmcnt(0)" ::: "memory");
    const int c = lane & 7;
#pragma unroll
    for (int j = 0; j < 8; ++j) { const int n = (lane >> 3) + 8 * j; const LAS float* s = scr + (8 * c) * 65 + n;
        v4u o; o.x = pk2(s[0 * 65], s[1 * 65]); o.y = pk2(s[2 * 65], s[3 * 65]); o.z = pk2(s[4 * 65], s[5 * 65]); o.w = pk2(s[6 * 65], s[7 * 65]);
        *(__attribute__((address_space(1))) v4u*)(WT + (size_t)wmap_row(mode, n0 + n) * K + k0 + 8 * c) = o; }
    asm volatile("s_waitcnt lgkmcnt(0)" ::: "memory");
}

__device__ __forceinline__ void transpose_item8(const float* W, int K, int N, unsigned char* WT, const float* scale, LAS float* scr, int item, int lane) {
    const int nblk = N / 64, kb = item / nblk, nb = item % nblk, k0 = 64 * kb, n0 = 64 * nb;
    const int n4 = (lane & 15) * 4, kr = lane >> 4;
#pragma unroll 8
    for (int i = 0; i < 16; ++i) { const int kk = 4 * i + kr; f32x4 w = __builtin_nontemporal_load((const __attribute__((address_space(1))) f32x4*)(W + (size_t)(k0 + kk) * N + n0 + n4)); w = w * (scale ? *(const __attribute__((address_space(1))) float*)(scale + k0 + kk) * W8_SCALE : W8_SCALE);
        scr[kk * 65 + n4] = w[0]; scr[kk * 65 + n4 + 1] = w[1]; scr[kk * 65 + n4 + 2] = w[2]; scr[kk * 65 + n4 + 3] = w[3]; }
    asm volatile("s_waitcnt lgkmcnt(0)" ::: "memory");
    const int c = lane & 3;
#pragma unroll
    for (int j = 0; j < 4; ++j) { const int n = (lane >> 2) + 16 * j; const LAS float* s = scr + (16 * c) * 65 + n; v4u o;
        o.x = f32x2_to_fp8(s[0 * 65], s[1 * 65]) | (f32x2_to_fp8(s[2 * 65], s[3 * 65]) << 16); o.y = f32x2_to_fp8(s[4 * 65], s[5 * 65]) | (f32x2_to_fp8(s[6 * 65], s[7 * 65]) << 16);
        o.z = f32x2_to_fp8(s[8 * 65], s[9 * 65]) | (f32x2_to_fp8(s[10 * 65], s[11 * 65]) << 16); o.w = f32x2_to_fp8(s[12 * 65], s[13 * 65]) | (f32x2_to_fp8(s[14 * 65], s[15 * 65]) << 16);
        *(__attribute__((address_space(1))) v4u*)(WT + (size_t)(n0 + n) * K + k0 + 16 * c) = o; }
    asm volatile("s_waitcnt lgkmcnt(0)" ::: "memory");
}

template <class CT>
__device__ __forceinline__ void router_logits16(const CT& c, int l, int t0, int lane, LAS float* lgs) {
    const int fr = lane & 15, fq = lane >> 4;
    const bf16_t* xa = (const bf16_t*)c.X() + (size_t)(t0 + fr) * D + 8 * fq;
    const bf16_t* wh = (const bf16_t*)c.rwt() + ((size_t)(l * 2) * NE + fr) * 1024 + 8 * fq;
    f32x4 acc0 = (f32x4){0.f, 0.f, 0.f, 0.f}, acc1 = (f32x4){0.f, 0.f, 0.f, 0.f};
#pragma unroll 8
    for (int ks = 0; ks < 32; ++ks) {
        const bf16x8 a = *(const bf16x8*)(xa + 32 * ks);
        const bf16x8 bh0 = *(const bf16x8*)(wh + 32 * ks), bh1 = *(const bf16x8*)(wh + 16 * 1024 + 32 * ks), bl0 = *(const bf16x8*)(wh + NE * 1024 + 32 * ks), bl1 = *(const bf16x8*)(wh + (NE + 16) * 1024 + 32 * ks);
        asm volatile("s_nop 1\n\tv_mfma_f32_16x16x32_bf16 %0, %1, %2, %0" : "+v"(acc0) : "v"(a), "v"(bh0));
        asm volatile("s_nop 1\n\tv_mfma_f32_16x16x32_bf16 %0, %1, %2, %0" : "+v"(acc1) : "v"(a), "v"(bh1));
        asm volatile("s_nop 1\n\tv_mfma_f32_16x16x32_bf16 %0, %1, %2, %0" : "+v"(acc0) : "v"(a), "v"(bl0));
        asm volatile("s_nop 1\n\tv_mfma_f32_16x16x32_bf16 %0, %1, %2, %0" : "+v"(acc1) : "v"(a), "v"(bl1)); }
    asm volatile("s_nop 15\n\ts_nop 15" : "+v"(acc0), "+v"(acc1));
#pragma unroll
    for (int j = 0; j < 4; ++j) { lgs[(4 * fq + j) * 32 + fr] = acc0[j]; lgs[(4 * fq + j) * 32 + 16 + fr] = acc1[j]; }
    asm volatile("s_waitcnt lgkmcnt(0)" ::: "memory");
}

constexpr int RB = 4;
template <class CT>
__device__ __forceinline__ void router_rows(const CT& c, int l, int t0, int lane, LAS int* park, const LAS float* lgs, const bool dummy = false) {
    float rstd_r[RB];
#pragma unroll
    for (int r = 0; r < RB; ++r) { const bf16_t* xr = (const bf16_t*)c.X() + (size_t)(t0 + r) * D; float ss = 0.f; f32x4 v[4];
#pragma unroll
        for (int j = 0; j < 4; ++j) { const uint2 xw_ = *(const uint2*)(xr + 4 * lane + 256 * j);
            v[j] = (f32x4){__builtin_bit_cast(float, xw_.x << 16), __builtin_bit_cast(float, xw_.x & 0xffff0000u), __builtin_bit_cast(float, xw_.y << 16), __builtin_bit_cast(float, xw_.y & 0xffff0000u)}; ss += v[j][0] * v[j][0] + v[j][1] * v[j][1] + v[j][2] * v[j][2] + v[j][3] * v[j][3]; }
        const float rstd = 1.f / sqrtf(wsum(ss) * (1.f / D) + EPS); rstd_r[r] = rstd;
        unsigned char* orow = (dummy ? (unsigned char*)c.yexp() : c.hq()) + (size_t)(t0 + r) * D;
#pragma unroll
        for (int j = 0; j < 4; ++j) { v[j] = v[j] * rstd; *(unsigned*)(orow + 4 * lane + 256 * j) = f32x2_to_fp8(v[j][0], v[j][1]) | (f32x2_to_fp8(v[j][2], v[j][3]) << 16); } }
    float lg[RB];
#pragma unroll
    for (int r = 0; r < RB; ++r) lg[r] = lgs[r * 32 + (lane & 7) * 4 + (lane >> 4)] * rstd_r[r];
    const int e = (lane & 7) * 4 + (lane >> 4);
    const float rb = c.in[I_RB][l * NE + e];
#pragma unroll
    for (int r = 0; r < RB; ++r) { const int t = t0 + r;
        const float lgr = lg[r] + rb;
        unsigned ub = __builtin_bit_cast(unsigned, lgr); ub ^= (ub >> 31) ? 0xffffffffu : 0x80000000u;
        unsigned long long key = ((unsigned long long)ub << 32) | (unsigned)(31 - e);
        int se[4]; float sv[4];
#pragma unroll
        for (int q = 0; q < 4; ++q) { unsigned long long m = key;
#pragma unroll
            for (int o = 1; o < 64; o <<= 1) { const unsigned long long qq = __shfl_xor(m, o); m = qq > m ? qq : m; }
            const int we = 31 - (int)(m & 31u); unsigned wb = (unsigned)(m >> 32); wb ^= (wb >> 31) ? 0x80000000u : 0xffffffffu;
            se[q] = we; sv[q] = __builtin_bit_cast(float, wb); if (e == we) key = 0ull; }
        const float mx = sv[0]; float ex[4], sum = 0.f;
#pragma unroll
        for (int q = 0; q < 4; ++q) { ex[q] = __builtin_amdgcn_exp2f((sv[q] - mx) * 1.4426950408889634f); sum += ex[q]; }
        const float rsum = __builtin_amdgcn_rcpf(sum);
        if (lane == 0) {
#pragma unroll
            for (int q = 0; q < 4; ++q) { if (!dummy) { c.tke()[t * 4 + q] = se[q]; c.tkg()[t * 4 + q] = ex[q] * rsum; } park[r * 4 + q] = se[q]; } }
    }
}

constexpr int S5_PITCH = 272, S5_ROWS = 33, S5_LDS_WAVE = 2 * S5_ROWS * S5_PITCH;
template <bool FINAL, class CT>
__device__ __forceinline__ void s5_tile_dev(const CT& c, const int l, const int tile, const int g, LAS unsigned char* sl, const int lane) {
    const int fr = lane & 15, fq = lane >> 4;
    const int b = tile / NT, ct = tile % NT, t0 = b * SEQ + ct * LC;
    bf16x8 uf[2][2];
#pragma unroll
    for (int m = 0; m < 2; ++m)
#pragma unroll
        for (int ks = 0; ks < 2; ++ks) uf[m][ks] = *(const bf16x8*)(c.z() + (size_t)(t0 + 4 * (16 * m + fr) + 2 * ks + (fq >> 1)) * D_INP + 256 + 16 * g + 8 * (fq & 1));
#pragma unroll
    for (int dir = 0; dir < 2; ++dir) {
        f32x4 acc[2][8];
#pragma unroll
        for (int m = 0; m < 2; ++m)
#pragma unroll
            for (int nt = 0; nt < 8; ++nt) acc[m][nt] = (f32x4){0.f, 0.f, 0.f, 0.f};
        const bf16_t* w = c.w4t() + (size_t)((l * 24 + g) * 2 + dir) * 128 * 64;
#pragma unroll
        for (int ks = 0; ks < 2; ++ks)
#pragma unroll
            for (int nt = 0; nt < 8; ++nt) { const bf16x8 wf = *(const bf16x8*)(w + (16 * nt + fr) * 64 + 32 * ks + 8 * fq);
#pragma unroll
                for (int m = 0; m < 2; ++m) asm volatile("s_nop 1\n\tv_mfma_f32_16x16x32_bf16 %0, %1, %2, %0" : "+v"(acc[m][nt]) : "v"(wf), "v"(uf[m][ks])); }
        asm volatile("s_nop 15\n\ts_nop 15\n\ts_nop 15\n\ts_nop 15" : "+v"(acc[0][0]), "+v"(acc[0][1]), "+v"(acc[0][2]), "+v"(acc[0][3]), "+v"(acc[0][4]), "+v"(acc[0][5]), "+v"(acc[0][6]), "+v"(acc[0][7]),
                                               "+v"(acc[1][0]), "+v"(acc[1][1]), "+v"(acc[1][2]), "+v"(acc[1][3]), "+v"(acc[1][4]), "+v"(acc[1][5]), "+v"(acc[1][6]), "+v"(acc[1][7]));
#pragma unroll
        for (int m = 0; m < 2; ++m)
#pragma unroll
            for (int nt = 0; nt < 8; ++nt) { const int row = 16 * m + fr + (dir ? 0 : 1);
                unsigned lo = pk2(acc[m][nt][0], acc[m][nt][1]), hi = pk2(acc[m][nt][2], acc[m][nt][3]);
                *(LAS unsigned long long*)(sl + (dir * S5_ROWS + row) * S5_PITCH + (16 * nt + 4 * fq) * 2) = (unsigned long long)lo | ((unsigned long long)hi << 32); }
    }
    asm volatile("s_waitcnt lgkmcnt(0)" ::: "memory");
    {
        const int p = lane;
#pragma unroll
        for (int dir = 0; dir < 2; ++dir) {
            const int ci = ((l * 2 + dir) * 24 + g) * 64 + p;
            const float a4r = c.s5pow()[(size_t)ci * 8], a4i = c.s5pow()[(size_t)ci * 8 + 1];
            const size_t io = ((size_t)(b * NT + ct) * 3072 + dir * 1536 + g * 64 + p) * 2;
            float sr = 0.f, si = 0.f;
            LAS bf16_t* base = (LAS bf16_t*)(sl + dir * S5_ROWS * S5_PITCH);
            if (FINAL) { const float2 cin = *(const float2*)(c.s5in() + io); sr = cin.x; si = cin.y;
                const int crow = dir ? 32 : 0; base[crow * (S5_PITCH / 2) + p] = (bf16_t)f2bf(sr); base[crow * (S5_PITCH / 2) + 64 + p] = (bf16_t)f2bf(si); }
#pragma unroll 8
            for (int q = 0; q < 32; ++q) { const int row = dir ? 31 - q : q + 1;
                const float gr = bf2f(base[row * (S5_PITCH / 2) + p]), gi = bf2f(base[row * (S5_PITCH / 2) + 64 + p]);
                const float nr = a4r * sr - a4i * si + gr, ni = a4r * si + a4i * sr + gi; sr = nr; si = ni;
                if (FINAL) { base[row * (S5_PITCH / 2) + p] = (bf16_t)f2bf(sr); base[row * (S5_PITCH / 2) + 64 + p] = (bf16_t)f2bf(si); } }
            if (!FINAL) { float2 e2; e2.x = sr; e2.y = si; *(float2*)(c.s5e() + io) = e2; }
        }
    }
    if (FINAL) {
        asm volatile("s_waitcnt lgkmcnt(0)" ::: "memory");
        f32x4 ya[4][2];
#pragma unroll
        for (int mj = 0; mj < 4; ++mj)
#pragma unroll
            for (int nt = 0; nt < 2; ++nt) ya[mj][nt] = (f32x4){0.f, 0.f, 0.f, 0.f};
        const bf16_t* ym = c.ymat() + (size_t)(l * 24 + g) * 64 * 320;
        bf16x8 bq[8][2];
#pragma unroll
        for (int ks = 0; ks < 8; ++ks)
#pragma unroll
            for (int nt = 0; nt < 2; ++nt) bq[ks][nt] = ks < 4 ? *(const LAS bf16x8*)(sl + (16 * nt + fr) * S5_PITCH + (32 * ks + 8 * fq) * 2) : *(const LAS bf16x8*)(sl + (S5_ROWS + 16 * nt + fr + 1) * S5_PITCH + (32 * (ks - 4) + 8 * fq) * 2);
#pragma unroll
        for (int ks = 0; ks < 10; ++ks) {
            bf16x8 af[4], bfr[2];
#pragma unroll
            for (int mj = 0; mj < 4; ++mj) af[mj] = *(const bf16x8*)(ym + (16 * mj + fr) * 320 + 32 * ks + 8 * fq);
#pragma unroll
            for (int nt = 0; nt < 2; ++nt) { if (ks < 8) bfr[nt] = bq[ks][nt]; else bfr[nt] = uf[nt][ks - 8]; }
#pragma unroll
            for (int mj = 0; mj < 4; ++mj)
#pragma unroll
                for (int nt = 0; nt < 2; ++nt) asm volatile("s_nop 1\n\tv_mfma_f32_16x16x32_bf16 %0, %1, %2, %0" : "+v"(ya[mj][nt]) : "v"(af[mj]), "v"(bfr[nt]));
        }
        asm volatile("s_nop 15\n\ts_nop 15\n\ts_nop 15\n\ts_nop 15" : "+v"(ya[0][0]), "+v"(ya[0][1]), "+v"(ya[1][0]), "+v"(ya[1][1]), "+v"(ya[2][0]), "+v"(ya[2][1]), "+v"(ya[3][0]), "+v"(ya[3][1]));
#pragma unroll
        for (int mj = 0; mj < 4; ++mj)
#pragma unroll
            for (int nt = 0; nt < 2; ++nt) { const f32x4 y = ya[mj][nt];
                st_bf16x4(c.v() + (size_t)(t0 + 4 * (16 * nt + fr) + mj) * 384 + 16 * g + 4 * fq, gelu_tanh(y[0]), gelu_tanh(y[1]), gelu_tanh(y[2]), gelu_tanh(y[3])); }
    }
    asm volatile("s_waitcnt lgkmcnt(0)" ::: "memory");
}

#define MFMA16(acc_, a_, b_) asm volatile("s_nop 1\n\tv_mfma_f32_16x16x32_bf16 %0, %1, %2, %0" : "+v"(acc_) : "v"(a_), "v"(b_))
#define MFMA_FENCE8(x_) asm volatile("s_nop 15\n\ts_nop 15" : "+v"(x_[0]), "+v"(x_[1]), "+v"(x_[2]), "+v"(x_[3]), "+v"(x_[4]), "+v"(x_[5]), "+v"(x_[6]), "+v"(x_[7]))
template <class CT>
__device__ __forceinline__ void mixer_tile_dev(const CT& c, const int l, const int tile, LAS unsigned char* lds, const int wave, const int lane) {
    const int tid = wave * 64 + lane, fr = lane & 15, fq = lane >> 4;
    const int b = tile / NT, ct = tile % NT, s0 = ct * LC, t0 = b * SEQ + s0;
    {
        LAS bf16_t* dt = (LAS bf16_t*)lds;
        LAS float* ssqp = (LAS float*)(lds + 67584);
        LAS bf16_t* zp = (LAS bf16_t*)(lds + 71680);
#pragma unroll 1
        for (int g4 = 0; g4 < 4; ++g4) {
            { v4u pz[3];
#pragma unroll
              for (int i = 0; i < 3; ++i) { const int p = tid + 512 * i, q = s0 - 8 + (p >> 3);
                  pz[i] = (p < 1152 && q >= 0 && q < SEQ) ? *(const GAS v4u*)(c.z() + (size_t)(b * SEQ + q) * D_INP + g4 * 64 + (p & 7) * 8) : (v4u){0u, 0u, 0u, 0u}; }
#pragma unroll
              for (int i = 0; i < 3; ++i) { const int p = tid + 512 * i; if (p < 1152) *(LAS v4u*)(zp + (p >> 3) * 72 + (p & 7) * 8) = pz[i]; } }
            __syncthreads();
            { const int cc = tid & 63, tq = tid >> 6, half = 1 << g4, tb = tq * 16, sb = s0 + tb;
              int lo = sb - half < 0 ? 0 : sb - half, hi = sb + half > SEQ ? SEQ : sb + half; float sum = 0.f;
              for (int q = lo; q < hi; ++q) sum += bf2f(zp[(q - s0 + 8) * 72 + cc]);
#pragma unroll 4
              for (int t = tb; t < tb + 16; ++t) { const int s = s0 + t;
                  dt[t * 264 + g4 * 64 + cc] = (bf16_t)f2bf(sum * __builtin_amdgcn_rcpf((float)(hi - lo)) - bf2f(zp[(t + 8) * 72 + cc]));
                  const int nlo = s + 1 - half < 0 ? 0 : s + 1 - half, nhi = s + 1 + half > SEQ ? SEQ : s + 1 + half;
                  if (nhi > hi) sum += bf2f(zp[(hi - s0 + 8) * 72 + cc]);
                  if (nlo > lo) sum -= bf2f(zp[(lo - s0 + 8) * 72 + cc]);
                  lo = nlo; hi = nhi; } }
            __syncthreads();
        }
        const int g = wave >> 1, nbase = (wave & 1) * 32;
        f32x4 acc0[8], acc1[8];
#pragma unroll
        for (int m = 0; m < 8; ++m) { acc0[m] = (f32x4){0.f, 0.f, 0.f, 0.f}; acc1[m] = (f32x4){0.f, 0.f, 0.f, 0.f}; }
#pragma unroll
        for (int ks = 0; ks < 2; ++ks) {
            const bf16x8 w0 = *(const bf16x8*)(c.poolw_t() + ((size_t)(l * 4 + g) * 64 + nbase + fr) * 64 + 32 * ks + 8 * fq);
            const bf16x8 w1 = *(const bf16x8*)(c.poolw_t() + ((size_t)(l * 4 + g) * 64 + nbase + 16 + fr) * 64 + 32 * ks + 8 * fq);
#pragma unroll
            for (int m = 0; m < 8; ++m) { const bf16x8 df = *(const LAS bf16x8*)(lds + (16 * m + fr) * 528 + (g * 64 + 32 * ks + 8 * fq) * 2);
                MFMA16(acc0[m], w0, df); MFMA16(acc1[m], w1, df); } }
        MFMA_FENCE8(acc0); MFMA_FENCE8(acc1);
        const int ch0 = g * 64 + nbase + 4 * fq;
        const f32x4 sc0 = *(const f32x4*)(c.in[I_POOLS] + l * 256 + ch0), sc1 = *(const f32x4*)(c.in[I_POOLS] + l * 256 + ch0 + 16);
#pragma unroll
        for (int m = 0; m < 8; ++m) { acc0[m] = acc0[m] * sc0; acc1[m] = acc1[m] * sc1;
            float s = acc0[m][0] * acc0[m][0] + acc0[m][1] * acc0[m][1] + acc0[m][2] * acc0[m][2] + acc0[m][3] * acc0[m][3] + acc1[m][0] * acc1[m][0] + acc1[m][1] * acc1[m][1] + acc1[m][2] * acc1[m][2] + acc1[m][3] * acc1[m][3];
            s += __shfl_xor(s, 16); s += __shfl_xor(s, 32);
            if (fq == 0) ssqp[(16 * m + fr) * 8 + wave] = s; }
        __syncthreads();
#pragma unroll
        for (int m = 0; m < 8; ++m) { const f32x4 pa = *(const LAS f32x4*)(ssqp + (16 * m + fr) * 8), pb = *(const LAS f32x4*)(ssqp + (16 * m + fr) * 8 + 4);
            const float rstd = 1.f / sqrtf(((pa[0] + pa[1]) + (pa[2] + pa[3]) + (pb[0] + pb[1]) + (pb[2] + pb[3])) * (1.f / 256) + EPS);
            bf16_t* orow = c.o() + (size_t)(t0 + 16 * m + fr) * D + ch0;
            st_bf16x4(orow, acc0[m][0] * rstd, acc0[m][1] * rstd, acc0[m][2] * rstd, acc0[m][3] * rstd);
            st_bf16x4(orow + 16, acc1[m][0] * rstd, acc1[m][1] * rstd, acc1[m][2] * rstd, acc1[m][3] * rstd); }
        __syncthreads();
    }
    LAS bf16_t* xcs = (LAS bf16_t*)lds;
    LAS float* As = (LAS float*)(lds + 18432);
    LAS bf16_t* Bs = (LAS bf16_t*)(lds + 88064);
    LAS float* Seg = (LAS float*)(lds + 124928);
    bf16_t tz[17];
#define LRU_SLAB_LOAD(h_) do { int tq_ = tid; asm volatile("" : "+v"(tq_)); _Pragma("unroll") for (int i_ = 0; i_ < 17; ++i_) { const int e2_ = tq_ + 512 * i_, q_ = s0 - 1 + (e2_ >> 6); \
        tz[i_] = ((i_ < 16 || e2_ < 131 * 64) && q_ >= 0 && q_ < SEQ) ? c.z()[(size_t)(b * SEQ + q_) * D_INP + 640 + (h_) * 64 + (e2_ & 63)] : (bf16_t)0; } } while (0)
    LRU_SLAB_LOAD(0);
#pragma unroll 1
    for (int h = 0; h < 6; ++h) {
        int cc; float cb, w0, w1, w2, w3; bf16x8 gwa[2], gwx[2]; f32x4 gba, gbx, glam;
        { LAS bf16_t* zs = (LAS bf16_t*)As;
          { int tq = tid; asm volatile("" : "+v"(tq));
            cc = tq & 63; { const int ch = h * 64 + cc; const float* cwp = c.in[I_CONVW] + l * 4 * 384 + ch; cb = c.in[I_CONVB][l * 384 + ch]; w0 = cwp[0]; w1 = cwp[384]; w2 = cwp[768]; w3 = cwp[1152]; }
            { const bf16_t* wbase = c.lruw_t() + ((size_t)(((l * 2 + (wave >> 2)) * 6 + h) * 2) * 64 + (wave & 3) * 16 + (tq & 15)) * 64 + 8 * ((tq >> 4) & 3);
#pragma unroll
              for (int ks = 0; ks < 2; ++ks) { gwa[ks] = *(const bf16x8*)(wbase + 32 * ks); gwx[ks] = *(const bf16x8*)(wbase + 4096 + 32 * ks); }
              const int pi = (l * 2 + (wave >> 2)) * 384 + h * 64 + (wave & 3) * 16 + 4 * ((tq >> 4) & 3);
              gba = *(const f32x4*)(c.in[I_BA] + pi); gbx = *(const f32x4*)(c.in[I_BX] + pi); glam = *(const f32x4*)((const float*)c.ctl() + SP8_OFF / 4 + pi); }
#pragma unroll
            for (int i = 0; i < 17; ++i) { const int e2 = tq + 512 * i; if (i < 16 || e2 < 131 * 64) zs[(e2 >> 6) * 72 + (e2 & 63)] = tz[i]; } }
          __syncthreads();
#pragma unroll 4
          for (int i = 0; i < 16; ++i) { const int t = (tid >> 6) + 8 * i;
              const float a = cb + w0 * bf2f(zs[t * 72 + cc]) + w1 * bf2f(zs[(t + 1) * 72 + cc]) + w2 * bf2f(zs[(t + 2) * 72 + cc]) + w3 * bf2f(zs[(t + 3) * 72 + cc]);
              xcs[t * 72 + cc] = (bf16_t)f2bf(a); } }
        if (h < 5) LRU_SLAB_LOAD(h + 1);
        __syncthreads();
        {
            const int dir = wave >> 2, c16 = (wave & 3) * 16;
            f32x4 accA[8], accX[8];
#pragma unroll
            for (int m = 0; m < 8; ++m) { accA[m] = (f32x4){0.f, 0.f, 0.f, 0.f}; accX[m] = (f32x4){0.f, 0.f, 0.f, 0.f}; }
#pragma unroll
            for (int ks = 0; ks < 2; ++ks) { const bf16x8 wa = gwa[ks], wx = gwx[ks];
#pragma unroll
                for (int m = 0; m < 8; ++m) { const bf16x8 xf = *(const LAS bf16x8*)(lds + (16 * m + fr) * 144 + (32 * ks + 8 * fq) * 2);
                    MFMA16(accA[m], wa, xf); MFMA16(accX[m], wx, xf); } }
            MFMA_FENCE8(accA); MFMA_FENCE8(accX);
            const int cc0 = c16 + 4 * fq;
            const f32x4 ba = gba, bx = gbx, lam = glam;
            f32x4 sp8;
#pragma unroll
            for (int j = 0; j < 4; ++j) sp8[j] = lam[j];
#pragma unroll
            for (int m = 0; m < 8; ++m) { const int t = 16 * m + fr;
                const unsigned long long xw = *(const LAS unsigned long long*)(lds + t * 144 + cc0 * 2);
                f32x4 av; float btv[4];
#pragma unroll
                for (int j = 0; j < 4; ++j) { const float xcv = bf2f((unsigned)(xw >> (16 * j)) & 0xffffu);
                    const float r = sigmoid_fast(accA[m][j] + ba[j]), ig = sigmoid_fast(accX[m][j] + bx[j]), la = r * sp8[j];
                    av[j] = __builtin_amdgcn_exp2f(1.4426950408889634f * la); btv[j] = __builtin_amdgcn_sqrtf(-expm1_dev(2.f * la, av[j])) * (ig * xcv); }
                *(LAS f32x4*)(As + (dir * 128 + t) * 68 + cc0) = av;
                *(LAS unsigned long long*)(Bs + (dir * 128 + t) * 72 + cc0) = (unsigned long long)pk2(btv[0], btv[1]) | ((unsigned long long)pk2(btv[2], btv[3]) << 32); }
        }
        __syncthreads();
        {
            const int dir = tid >> 8, seg = (tid >> 6) & 3, cc = tid & 63, ch = h * 64 + cc;
            const int tfirst = dir ? 127 - seg * 32 : seg * 32, tstep = dir ? -1 : 1;
            const LAS float* ap = As + (dir * 128 + tfirst) * 68 + cc; const LAS bf16_t* bp = Bs + (dir * 128 + tfirst) * 72 + cc;
            float hh = 0.f, P = 1.f;
#pragma unroll 8
            for (int q = 0; q < 32; ++q) { const float a = ap[q * tstep * 68], bt = bf2f(bp[q * tstep * 72]); hh = a * hh + bt; P *= a; }
            Seg[((dir * 64 + cc) * 4 + seg) * 2] = P; Seg[((dir * 64 + cc) * 4 + seg) * 2 + 1] = hh;
            __syncthreads();
            float carry = 0.f, cpre = 1.f;
#pragma unroll
            for (int s2 = 0; s2 < 3; ++s2) if (s2 < seg) { const float P2 = Seg[((dir * 64 + cc) * 4 + s2) * 2], h2 = Seg[((dir * 64 + cc) * 4 + s2) * 2 + 1]; carry = P2 * carry + h2; cpre *= P2; }
            bf16_t* hp = c.hl() + ((size_t)(t0 + tfirst) * 2 + dir) * 384 + ch; bf16_t* cpp = c.cp() + ((size_t)(t0 + tfirst) * 2 + dir) * 384 + ch;
            hh = carry; P = cpre;
#pragma unroll 4
            for (int q = 0; q < 32; ++q) { const float a = ap[q * tstep * 68], bt = bf2f(bp[q * tstep * 72]); hh = a * hh + bt; P *= a;
                hp[(long)q * tstep * 768] = (bf16_t)f2bf(hh); cpp[(long)q * tstep * 768] = (bf16_t)f2bf(P); }
            if (seg == 3) { float2 pe; pe.x = P; pe.y = hh; *(float2*)(c.lrupe() + ((size_t)(b * NT + ct) * 768 + dir * 384 + ch) * 2) = pe; }
        }
        __syncthreads();
    }
}

template <class CT>
__device__ __forceinline__ void row_mix_norm2_dev(const CT& c, const int t, const int lane) {
    bf16_t* orow = c.o() + (size_t)t * D;
    { const unsigned* yb = (const unsigned*)(c.yb() + (size_t)t * 384); unsigned w[3]; float ss = 0.f;
#pragma unroll
      for (int i = 0; i < 3; ++i) { w[i] = yb[lane + 64 * i]; const float a = bf2f(w[i] & 0xffffu), b2 = bf2f(w[i] >> 16); ss += a * a + b2 * b2; }
      const float rstd = 1.f / sqrtf(wsum(ss) * (1.f / 384) + EPS);
#pragma unroll
      for (int i = 0; i < 3; ++i) ((unsigned*)(orow + 256))[lane + 64 * i] = pk2(bf2f(w[i] & 0xffffu) * rstd, bf2f(w[i] >> 16) * rstd); }
    { const unsigned* hl = (const unsigned*)(c.hl() + (size_t)t * 768); const unsigned* cp = (const unsigned*)(c.cp() + (size_t)t * 768); const unsigned* gz = (const unsigned*)(c.z() + (size_t)t * D_INP + 1024);
      const float2* cin = (const float2*)(c.lruin() + (size_t)((t / SEQ) * NT + (t % SEQ) / LC) * 768);
      float y0[3], y1[3]; float ss = 0.f;
#pragma unroll
      for (int i = 0; i < 3; ++i) { const int k2 = lane + 64 * i; const unsigned hf = hl[k2], hb2 = hl[192 + k2], cf = cp[k2], cb2 = cp[192 + k2], gg = gz[k2]; const float2 nf = cin[k2], nb = cin[192 + k2];
          y0[i] = (bf2f(hf & 0xffffu) + bf2f(cf & 0xffffu) * nf.x + bf2f(hb2 & 0xffffu) + bf2f(cb2 & 0xffffu) * nb.x) * gelu_tanh(bf2f(gg & 0xffffu));
          y1[i] = (bf2f(hf >> 16) + bf2f(cf >> 16) * nf.y + bf2f(hb2 >> 16) + bf2f(cb2 >> 16) * nb.y) * gelu_tanh(bf2f(gg >> 16)); ss += y0[i] * y0[i] + y1[i] * y1[i]; }
      const float rstd = 1.f / sqrtf(wsum(ss) * (1.f / 384) + EPS);
#pragma unroll
      for (int i = 0; i < 3; ++i) ((unsigned*)(orow + 640))[lane + 64 * i] = pk2(y0[i] * rstd, y1[i] * rstd); }
}
template <class CT>
__device__ __forceinline__ void row_combine_dev(const CT& c, const int t, const int lane, const bool last, const bool dummy = false) {
    bf16_t* xr = (bf16_t*)c.X() + (size_t)t * D; float ss = 0.f; bf16_t* xw = dummy ? (bf16_t*)c.out + (size_t)t * D : xr; bf16_t* hbw = dummy ? c.o() : c.hb();
    const int d0 = c.tkd()[t * 4], d1 = c.tkd()[t * 4 + 1], d2 = c.tkd()[t * 4 + 2], d3 = c.tkd()[t * 4 + 3];
    const bf16_t* y0 = c.yexp() + (size_t)d0 * 1024; const bf16_t* y1 = c.yexp() + (size_t)d1 * 1024; const bf16_t* y2 = c.yexp() + (size_t)d2 * 1024; const bf16_t* y3 = c.yexp() + (size_t)d3 * 1024;
    f32x4 v[4];
#pragma unroll
    for (int j = 0; j < 4; ++j) { const int k = 4 * lane + 256 * j; { const uint2 xw_ = *(const uint2*)(xr + k);
            v[j] = (f32x4){__builtin_bit_cast(float, xw_.x << 16), __builtin_bit_cast(float, xw_.x & 0xffff0000u), __builtin_bit_cast(float, xw_.y << 16), __builtin_bit_cast(float, xw_.y & 0xffff0000u)}; }
        const uint2 a = *(const uint2*)(y0 + k), b2 = *(const uint2*)(y1 + k), c2 = *(const uint2*)(y2 + k), e2 = *(const uint2*)(y3 + k);
        v[j][0] += bf2f(a.x & 0xffffu); v[j][0] += bf2f(b2.x & 0xffffu); v[j][0] += bf2f(c2.x & 0xffffu); v[j][0] += bf2f(e2.x & 0xffffu);
        v[j][1] += bf2f(a.x >> 16); v[j][1] += bf2f(b2.x >> 16); v[j][1] += bf2f(c2.x >> 16); v[j][1] += bf2f(e2.x >> 16);
        v[j][2] += bf2f(a.y & 0xffffu); v[j][2] += bf2f(b2.y & 0xffffu); v[j][2] += bf2f(c2.y & 0xffffu); v[j][2] += bf2f(e2.y & 0xffffu);
        v[j][3] += bf2f(a.y >> 16); v[j][3] += bf2f(b2.y >> 16); v[j][3] += bf2f(c2.y >> 16); v[j][3] += bf2f(e2.y >> 16);
        ss += v[j][0] * v[j][0] + v[j][1] * v[j][1] + v[j][2] * v[j][2] + v[j][3] * v[j][3]; }
    const float rstd = 1.f / sqrtf(wsum(ss) * (1.f / D) + EPS);
    if (!last) {
#pragma unroll
        for (int j = 0; j < 4; ++j) { const int k = 4 * lane + 256 * j; { uint2 xo; xo.x = pk2(v[j][0], v[j][1]); xo.y = pk2(v[j][2], v[j][3]); *(uint2*)(xw + k) = xo; } uint2 o; o.x = pk2(v[j][0] * rstd, v[j][1] * rstd); o.y = pk2(v[j][2] * rstd, v[j][3] * rstd); *(uint2*)(hbw + (size_t)t * D + k) = o; }
    } else { const float* fg = c.in[I_FING];
#pragma unroll
        for (int j = 0; j < 4; ++j) { const int k = 4 * lane + 256 * j; const f32x4 g = *(const f32x4*)(fg + k); *(f32x4*)((float*)c.out + (size_t)t * D + k) = v[j] * rstd * g; } }
}

constexpr int NPL = 12, NPH = 1 + DEPTH * NPL;
struct Args { const float* in[32]; float* out; unsigned char* ws; int ph_lo, ph_hi; };

__device__ __forceinline__ void st_route_dev(long gtid, long gs, const Ctx& c, int l, LAS int* pre, int tid) {
    LAS int* cn = pre + 64;
    const unsigned* cnt = c.ctl() + CW_CNT + 32 * l * CNT_STRIDE;
    if (tid < NE) cn[tid] = (int)cnt[tid * CNT_STRIDE];
    __syncthreads();
    if (tid == 0) { int s = 0; for (int q = 0; q < NE; ++q) { pre[q] = s; s += (cn[q] + 255) & ~255; } pre[NE] = s; }
    __syncthreads();
    for (long i = gtid; i < (long)T * 4; i += gs) { const int e = c.tke()[i]; const int d = pre[e] + c.tkp()[i];
        c.tkd()[i] = d; c.rowtok()[d] = (int)(i / 4); c.rowgate()[d] = c.tkg()[i]; }
    const int total = pre[NE];
    for (long r = gtid; r < total; r += gs) { int e = 0;
#pragma unroll
        for (int s2 = 16; s2 > 0; s2 >>= 1) e += (pre[e + s2] <= (int)r) ? s2 : 0;
        if ((int)r - pre[e] >= cn[e]) { c.rowtok()[r] = 0; c.rowgate()[r] = 0.f; }
        if ((r & 255) == 0) c.blke()[r >> 8] = e; }
    if (gtid == 0) c.ctl()[CW_NMB + l] = (unsigned)(total / 256);
}
__device__ __forceinline__ void st_carries_dev(long gtid, long gs, const Ctx& c, int l) {
    constexpr int CB = 16;
    const long tl = gtid % (NWAVES * 64), bx = gtid / (NWAVES * 64), Gn = gs / (NWAVES * 64), first = (tl & 63) + 64 * (bx + Gn * (tl >> 6)), step = 64 * Gn * NWAVES;
    for (long i = first; i < (long)BATCH * 3072; i += step) { const int r = (int)(i % 3072), b = (int)(i / 3072), dir = r / 1536; const int ci = l * 3072 + r;
        const float2 a = *(const float2*)(c.s5a128() + 2 * ci); float sr = 0.f, si = 0.f;
        const float* eb = c.s5e() + ((size_t)(b * NT) * 3072 + r) * 2; float* ib = c.s5in() + ((size_t)(b * NT) * 3072 + r) * 2;
#pragma unroll 1
        for (int q0 = 0; q0 < NT; q0 += CB) { float2 e[CB];
#pragma unroll
            for (int q = 0; q < CB; ++q) { const int ct = dir == 0 ? q0 + q : NT - 1 - q0 - q; e[q] = *(const float2*)(eb + (size_t)ct * 6144); }
#pragma unroll
            for (int q = 0; q < CB; ++q) { const int ct = dir == 0 ? q0 + q : NT - 1 - q0 - q; float2 s2; s2.x = sr; s2.y = si; *(float2*)(ib + (size_t)ct * 6144) = s2;
                const float nr = a.x * sr - a.y * si + e[q].x, ni = a.x * si + a.y * sr + e[q].y; sr = nr; si = ni; } } }
    for (long i = first; i < (long)BATCH * 768; i += step) { const int r = (int)(i % 768), b = (int)(i / 768), dir = r / 384; float h = 0.f;
        const float* pb = c.lrupe() + 2 * ((size_t)(b * NT) * 768 + r); float* hb_ = c.lruin() + (size_t)(b * NT) * 768 + r;
#pragma unroll 1
        for (int q0 = 0; q0 < NT; q0 += CB) { float2 pe[CB];
#pragma unroll
            for (int q = 0; q < CB; ++q) { const int ct = dir == 0 ? q0 + q : NT - 1 - q0 - q; pe[q] = *(const float2*)(pb + (size_t)ct * 1536); }
#pragma unroll
            for (int q = 0; q < CB; ++q) { const int ct = dir == 0 ? q0 + q : NT - 1 - q0 - q; hb_[(size_t)ct * 768] = h; h = pe[q].x * h + pe[q].y; } } }
}
template <class Tp> __device__ __forceinline__ Tp* uniform_ptr(Tp* p) { const unsigned long long v = (unsigned long long)p;
    return (Tp*)(((unsigned long long)(unsigned)__builtin_amdgcn_readfirstlane((int)(v >> 32)) << 32) | (unsigned)__builtin_amdgcn_readfirstlane((int)v)); }
template <int PH>
__device__ __forceinline__ void run_phase(const Ctx& c0, LAS unsigned char* lds, const int wave, const int G) {
    int lane_o = (int)__builtin_amdgcn_mbcnt_hi(~0u, __builtin_amdgcn_mbcnt_lo(~0u, 0u)); asm volatile("" : "+v"(lane_o));
    const int lane = lane_o, tid_o = wave * 64 + lane_o; const long gtid = (long)blockIdx.x * (NWAVES * 64) + tid_o, gs = (long)G * (NWAVES * 64);
    const int gw = blockIdx.x * NWAVES + wave, NGW = G * NWAVES;
    Ctx c = c0; { unsigned long long a_ = (unsigned long long)c0.ws, b_ = (unsigned long long)c0.out, d_ = (unsigned long long)c0.in; asm volatile("" : "+s"(a_), "+s"(b_), "+s"(d_));
        c.ws = (unsigned char*)a_; c.out = (float*)b_; c.in = (const float* const*)d_; }
#ifndef GSEL
#define GSEL 0x1Fu
#endif
    const CtxG cg(c);
    if constexpr (PH == 0) {
        LAS float* scr = (LAS float*)(lds + wave * 16640);
        constexpr int I_IN = 16 * 22, I_GLU = 6 * 12, I_OUT = 16 * 16, I_GU = 16 * 32, I_DN = 16 * 16;
        constexpr int NITEMS = 2 * (I_IN + I_GLU + I_OUT) + 64 * (I_GU + I_DN);
        for (int it = gw; it < NITEMS; it += NGW) { int r = it;
            if (r < 2 * I_IN) { const int l = r / I_IN; transpose_item(c.in[I_WIN] + (size_t)l * D * D_IN, D, D_IN, c.win_t() + (size_t)l * D_INP * D, 0, c.in[I_N1G] + l * D, scr, r % I_IN, lane); continue; } r -= 2 * I_IN;
            if (r < 2 * I_GLU) { const int l = r / I_GLU; transpose_item(c.in[I_WGLU] + (size_t)l * 384 * 768, 384, 768, c.wglu_t() + (size_t)l * 768 * 384, 1, nullptr, scr, r % I_GLU, lane); continue; } r -= 2 * I_GLU;
            if (r < 2 * I_OUT) { const int l = r / I_OUT; transpose_item(c.in[I_WOUT] + (size_t)l * D * D, D, D, c.wout_t() + (size_t)l * D * D, 0, c.in[I_MIXG] + l * D, scr, r % I_OUT, lane); continue; } r -= 2 * I_OUT;
            if (r < 64 * I_GU) { const int le = r / I_GU; transpose_item8(c.in[I_WGU] + (size_t)le * 1024 * 2048, 1024, 2048, c.wgu8() + (size_t)le * 2048 * 1024, c.in[I_N2G] + (le / 32) * D, scr, r % I_GU, lane); continue; } r -= 64 * I_GU;
            { const int le = r / I_DN; transpose_item8(c.in[I_WDN] + (size_t)le * 1024 * 1024, 1024, 1024, c.wdn8() + (size_t)le * 1024 * 1024, nullptr, scr, r % I_DN, lane); }
        }
        st_prep_small(gtid, gs, c); st_prep_mixw(gtid, gs, c);
        for (int t = gw; t < T; t += NGW) row_norm_bf16(c.in[I_X] + (size_t)t * D, c.hb() + (size_t)t * D, lane);
    } else {
        constexpr int l = (PH - 1) / NPL, q = (PH - 1) % NPL;
        if constexpr (q == 0) {
            if constexpr (l == 0) st_prep_s5mat(gtid, gs, c);
            pg8::SchedPlain S; S.so.init(T / 256, D_INP / 256, G, blockIdx.x); S.Bt = (const char*)(c.win_t() + (size_t)l * D_INP * D); S.tstepB = (size_t)256 * D * 2; S.rowtab = nullptr;
            EpiInW E{c.z()}; pg8::gemm_phase<EpiInW, pg8::SchedPlain, false, false, true>(lds, wave, c.hb(), D, S, E);
        } else if constexpr (q == 1) {
            for (int tile = blockIdx.x; tile < BATCH * NT; tile += G) { if constexpr ((GSEL & 1u) != 0) mixer_tile_dev(cg, l, tile, lds, wave, lane); else mixer_tile_dev(c, l, tile, lds, wave, lane); }
            for (int it = gw; it < BATCH * NT * 24; it += NGW) { if constexpr ((GSEL & 2u) != 0) s5_tile_dev<false>(cg, l, it / 24, it % 24, lds + wave * S5_LDS_WAVE, lane); else s5_tile_dev<false>(c, l, it / 24, it % 24, lds + wave * S5_LDS_WAVE, lane); }
        } else if constexpr (q == 2) { st_carries_dev(gtid, gs, c, l);
        } else if constexpr (q == 3) {
            for (int it = gw; it < BATCH * NT * 24; it += NGW) { if constexpr ((GSEL & 2u) != 0) s5_tile_dev<true>(cg, l, it / 24, it % 24, lds + wave * S5_LDS_WAVE, lane); else s5_tile_dev<true>(c, l, it / 24, it % 24, lds + wave * S5_LDS_WAVE, lane); }
        } else if constexpr (q == 4) {
            pg8::SchedPlain S; S.so.init(T / 256, 3, G, blockIdx.x); S.Bt = (const char*)(c.wglu_t() + (size_t)l * 768 * 384); S.tstepB = (size_t)256 * 384 * 2; S.rowtab = nullptr;
            EpiGluW E{c.yb(), uniform_ptr(c.in[I_BGLU]) + l * 768}; pg8::gemm_phase<EpiGluW, pg8::SchedPlain, false, false, true>(lds, wave, c.v(), 384, S, E);
        } else if constexpr (q == 5) { for (int t = gw; t < T; t += NGW) { if constexpr ((GSEL & 4u) != 0) row_mix_norm2_dev(cg, t, lane); else row_mix_norm2_dev(c, t, lane); }
        } else if constexpr (q == 6) {
            pg8::SchedPlain S; S.so.init(T / 256, 4, G, blockIdx.x); S.Bt = (const char*)(c.wout_t() + (size_t)l * D * D); S.tstepB = (size_t)256 * D * 2; S.rowtab = nullptr;
            EpiOutW<l == 0> E{l == 0 ? (const void*)uniform_ptr(c.in[I_X]) : (const void*)c.X(), (bf16_t*)c.X()}; pg8::gemm_phase<EpiOutW<l == 0>, pg8::SchedPlain, false, false, true>(lds, wave, c.o(), D, S, E);
        } else if constexpr (q == 7) {
            static_assert(T % (NWAVES * RB * 4) == 0, "router: 128 rows per workgroup pass");
            LAS int* park = (LAS int*)lds;
            LAS int* hist = (LAS int*)(lds + 2048);
            for (int tb = blockIdx.x * 128; tb < T; tb += G * 128) {
                if (tid_o < 64) hist[tid_o] = 0;
                LAS float* lgs = (LAS float*)(lds + 4096 + wave * 2048);
                router_logits16(cg, l, tb + wave * 16, lane, lgs);
#pragma unroll 1
                for (int i = 0; i < 4; ++i) { if constexpr ((GSEL & 16u) != 0) router_rows(cg, l, tb + wave * 16 + i * RB, lane, park + wave * 64 + i * RB * 4, lgs + i * RB * 32); else router_rows(c, l, tb + wave * 16 + i * RB, lane, park + wave * 64 + i * RB * 4, lgs + i * RB * 32); }
                __syncthreads();
                const int ex_ = park[tid_o]; const int rank = __hip_atomic_fetch_add(hist + ex_, 1, __ATOMIC_RELAXED, __HIP_MEMORY_SCOPE_WORKGROUP);
                __syncthreads();
                if (tid_o < 32) hist[32 + tid_o] = (int)atomicAdd(c.ctl() + CW_CNT + (32 * l + tid_o) * CNT_STRIDE, (unsigned)hist[tid_o]);
                __syncthreads();
                c.tkp()[tb * 4 + tid_o] = hist[32 + ex_] + rank;
                __syncthreads(); }
        } else if constexpr (q == 8) { st_route_dev(gtid, gs, c, l, (LAS int*)lds, tid_o);
        } else if constexpr (q == 9) {
            const int nmb = (int)c.ctl()[CW_NMB + l];
            pg8::SchedMoe S; S.so.init(nmb, 8, G, blockIdx.x); S.Bt = (const char*)(c.wgu8() + (size_t)l * NE * 2048 * 1024); S.tstepB = (size_t)256 * 1024; S.estride = (size_t)2048 * 1024; S.rowtab = c.rowtok(); S.blke = c.blke();
            { LAS int* ue = (LAS int*)(lds + pg8::STAGE_BYTES + 4096); if (tid_o < 32) { Unit u_; ue[tid_o] = S.so.next(tid_o, u_) ? c.blke()[u_.pm] : 0; } __syncthreads(); S.ue = ue; }
            EpiMoe1F8 E{c.act8(), uniform_ptr(c.in[I_BGU]) + (size_t)l * NE * 2048}; pg8::gemm_phase<EpiMoe1F8, pg8::SchedMoe, true, true, true>(lds, wave, (const bf16_t*)c.hq(), 512, S, E);
#ifdef PROBE_MOENULL
            { __syncthreads(); EpiNullW E2; pg8::gemm_phase<EpiNullW, pg8::SchedMoe, true, true, true>(lds, wave, (const bf16_t*)c.hq(), 512, S, E2); }
#endif
        } else if constexpr (q == 10) {
            const int nmb = (int)c.ctl()[CW_NMB + l];
            pg8::SchedMoe S; S.so.init(nmb, 4, G, blockIdx.x); S.Bt = (const char*)(c.wdn8() + (size_t)l * NE * 1024 * 1024); S.tstepB = (size_t)256 * 1024; S.estride = (size_t)1024 * 1024; S.rowtab = nullptr; S.blke = c.blke();
            { LAS int* ue = (LAS int*)(lds + pg8::STAGE_BYTES + 4096); if (tid_o < 32) { Unit u_; ue[tid_o] = S.so.next(tid_o, u_) ? c.blke()[u_.pm] : 0; } __syncthreads(); S.ue = ue; }
            EpiMoe2F8 E{c.yexp(), uniform_ptr(c.in[I_BDN]) + (size_t)l * NE * 1024, c.rowgate()}; pg8::gemm_phase<EpiMoe2F8, pg8::SchedMoe, false, true, true>(lds, wave, (const bf16_t*)c.act8(), 512, S, E);
#ifdef PROBE_MOENULL
            { __syncthreads(); EpiNullW E2; pg8::gemm_phase<EpiNullW, pg8::SchedMoe, false, true, true>(lds, wave, (const bf16_t*)c.act8(), 512, S, E2); }
#endif
        } else {
#ifdef PROBE_COMBINE
            if (l == 0) { for (int t = gw; t < T; t += NGW) row_combine_dev(c, t, lane, false, true); __syncthreads(); }
#endif
            for (int t = gw; t < T; t += NGW) { if constexpr ((GSEL & 8u) != 0) row_combine_dev(cg, t, lane, l == DEPTH - 1); else row_combine_dev(c, t, lane, l == DEPTH - 1); } }
    }
}
template <int PH>
__device__ __forceinline__ void run_from(const Ctx& c0, LAS unsigned char* lds, const int wave, const int G, const int lo, const int hi, const XcdBarrier& bar) {
    if (lo <= PH && PH < hi) {
        run_phase<PH>(c0, lds, wave, G);
#ifdef PROBE_REP
        if constexpr (((PROBE_REP >> (PH == 0 ? 0 : 1 + (PH - 1) % NPL)) & 1u) != 0) { __syncthreads(); run_phase<PH>(c0, lds, wave, G); }
#endif
        if (PH + 1 < hi) { const int lane = (int)__builtin_amdgcn_mbcnt_hi(~0u, __builtin_amdgcn_mbcnt_lo(~0u, 0u)); xcd_barrier(bar, wave == 0 && lane == 0); }
    }
    if constexpr (PH + 1 < NPH) run_from<PH + 1>(c0, lds, wave, G, lo, hi, bar);
}

__global__ void __launch_bounds__(NWAVES * 64, 2) mk_fwd(Args args) {
    extern __shared__ __attribute__((aligned(16))) unsigned char lds_raw[];
    LAS unsigned char* lds = (LAS unsigned char*)lds_raw;
    const int tid = threadIdx.x, wave = __builtin_amdgcn_readfirstlane(tid >> 6), G = gridDim.x;
    LAS unsigned long long* ptab = (LAS unsigned long long*)(lds + LDSCTL_OFF + 1024);
    volatile LAS unsigned* MISC = (volatile LAS unsigned*)(lds + LDSCTL_OFF);
    for (int u = tid; u < 256; u += NWAVES * 64) ((LAS unsigned*)(lds + LDSCTL_OFF))[u] = 0u;
    if (tid < 32) ptab[tid] = (unsigned long long)args.in[tid];
    if (tid == 32) ptab[32] = (unsigned long long)args.out;
    if (tid == 33) ptab[33] = (unsigned long long)args.ws;
    __syncthreads();
    Ctx c0; c0.in = (const float* const*)(const void*)(lds_raw + LDSCTL_OFF + 1024);
    { unsigned long long o = ptab[32], w = ptab[33];
      c0.out = (float*)(((unsigned long long)(unsigned)__builtin_amdgcn_readfirstlane((int)(o >> 32)) << 32) | (unsigned)__builtin_amdgcn_readfirstlane((int)o));
      c0.ws = (unsigned char*)(((unsigned long long)(unsigned)__builtin_amdgcn_readfirstlane((int)(w >> 32)) << 32) | (unsigned)__builtin_amdgcn_readfirstlane((int)w)); }
    XcdBarrier bar; bar.bar = (unsigned*)(args.ws + WS_CTL) + CW_BAR; bar.x = 0; bar.st = nullptr;
    if (args.ph_hi - args.ph_lo > 1) bar = xcd_barrier_post((unsigned*)(args.ws + WS_CTL) + CW_BAR, MISC + 8);
    run_from<0>(c0, lds, wave, G, args.ph_lo, args.ph_hi, bar);
}

extern "C" void kernel_launch(void* const* d_in, const int* in_sizes, int n_in, void* d_out, int out_size, void* d_ws, size_t ws_size, hipStream_t stream) {
    static int grid = 0;
    if (grid == 0) {
        if (n_in != 32 || in_sizes[0] != T * D || out_size != T * D || ws_size < WS_END) { fprintf(stderr, "kernel_launch: unexpected shapes (n_in %d in0 %d out %d ws %zu need %zu)\n", n_in, n_in > 0 ? in_sizes[0] : -1, out_size, ws_size, (size_t)WS_END); grid = -1; return; }
        int dev = 0, cus = 0, per_cu = 0;
        if (hipGetDevice(&dev) != hipSuccess || hipDeviceGetAttribute(&cus, hipDeviceAttributeMultiprocessorCount, dev) != hipSuccess) { grid = -1; return; }
        if (hipFuncSetAttribute((const void*)mk_fwd, hipFuncAttributeMaxDynamicSharedMemorySize, LDS_BYTES) != hipSuccess) { fprintf(stderr, "kernel_launch: hipFuncSetAttribute failed\n"); grid = -1; return; }
        if (hipOccupancyMaxActiveBlocksPerMultiprocessor(&per_cu, (const void*)mk_fwd, NWAVES * 64, LDS_BYTES) != hipSuccess || per_cu < 1) { fprintf(stderr, "kernel_launch: occupancy query reports %d blocks per CU\n", per_cu); per_cu = 1; }
        (void)hipGetLastError();
        grid = cus;
    }
    if (grid < 0) return;
    (void)hipMemsetAsync((char*)d_ws + WS_CTL, 0, CTL_BYTES, stream);
    Args a; memset(&a, 0, sizeof(a));
    for (int i = 0; i < 32; ++i) a.in[i] = (const float*)d_in[i];
    a.out = (float*)d_out; a.ws = (unsigned char*)d_ws;
#if MK_PER_PHASE
    for (int ph = 0; ph < NPH; ++ph) { a.ph_lo = ph; a.ph_hi = ph + 1; hipLaunchKernelGGL(mk_fwd, dim3(grid), dim3(NWAVES * 64), LDS_BYTES, stream, a); }
#else
    a.ph_lo = 0; a.ph_hi = NPH;
    void* kargs[] = {&a};
    hipError_t e = hipLaunchCooperativeKernel((const void*)mk_fwd, dim3(grid), dim3(NWAVES * 64), kargs, LDS_BYTES, stream);
    if (e != hipSuccess) fprintf(stderr, "kernel_launch: cooperative launch failed: %s\n", hipGetErrorString(e));
#endif
}
#endif
```

```cpp
#ifndef HOST_TEST
#include <hip/hip_runtime.h>
#endif
#include <cstdio>
#include <cstdint>
#include <cstring>
#include <cmath>

#ifndef CFG_B
#define CFG_B 4
#endif
#ifndef CFG_S
#define CFG_S 8192
#endif
#ifndef MK_PER_PHASE
#define MK_PER_PHASE 0
#define GSEL 0x1Du
#endif

#ifdef HOST_TEST
#define HD inline
#define DEV inline
#else
#define HD __host__ __device__ __forceinline__
#define DEV __device__ __forceinline__
#endif

typedef unsigned short bf16_t;
constexpr int BATCH = CFG_B, SEQ = CFG_S, T = BATCH * SEQ, D = 1024, DEPTH = 2;
constexpr int D_POOL = 256, D_S5 = 384, D_LRU = 384, D_IN = 1408, D_INP = 1536;
constexpr int NE = 32, TOPK = 4;
constexpr int LC = 128, NT = SEQ / LC;
constexpr int NROWS = T * TOPK + NE * 256;
constexpr int NMB_MAX = NROWS / 256;
constexpr float EPS = 1e-5f;
static_assert(SEQ % LC == 0 && T % 256 == 0, "shape");

constexpr size_t AL(size_t x) { return (x + 255) & ~size_t(255); }
constexpr size_t WS_CTL = 0, CTL_BYTES = 1u << 20;
constexpr size_t WS_WIN = WS_CTL + CTL_BYTES;
constexpr size_t WS_WGLU = WS_WIN + (size_t)2 * D_INP * D * 2;
constexpr size_t WS_WOUT = AL(WS_WGLU + (size_t)2 * 768 * 384 * 2);
constexpr size_t WS_WGU = WS_WOUT + (size_t)2 * D * D * 2;
constexpr size_t WS_WDN = WS_WGU + (size_t)2 * NE * 2048 * 1024 * 2;
constexpr size_t WS_RWT = WS_WDN + (size_t)2 * NE * 1024 * 1024 * 2;
constexpr size_t WS_S5A = WS_RWT + (size_t)2 * NE * 1024 * 4;
constexpr size_t WS_S5A128 = WS_S5A + 6144 * 8;
constexpr size_t WS_S5BB = WS_S5A128 + 6144 * 8;
constexpr size_t WS_S5POW = WS_S5BB + (size_t)6144 * 16 * 8;
constexpr size_t WS_W4T = AL(WS_S5POW + (size_t)6144 * 8 * 4);
constexpr size_t WS_YMAT = WS_W4T + (size_t)2 * 24 * 2 * 128 * 64 * 2;
constexpr size_t WS_LRUWT = AL(WS_YMAT + (size_t)2 * 24 * 64 * 320 * 2);
constexpr size_t WS_POOLWT = WS_LRUWT + (size_t)2 * 2 * 6 * 2 * 4096 * 2;
constexpr size_t WS_HB = AL(WS_POOLWT + (size_t)2 * 4 * 4096 * 2);
constexpr size_t WS_Z = WS_HB + (size_t)T * D * 2;
constexpr size_t WS_X = WS_Z + (size_t)T * D_INP * 2;
constexpr size_t WS_O = WS_X + (size_t)T * D * 4;
constexpr size_t WS_V = WS_O + (size_t)T * D * 2;
constexpr size_t WS_YB = WS_V + (size_t)T * 384 * 2;
constexpr size_t WS_PD = WS_YB + (size_t)T * 384 * 2;
constexpr size_t WS_YA = WS_PD + (size_t)T * 256 * 4;
constexpr size_t WS_XC = WS_YA + (size_t)T * 256 * 4;
constexpr size_t WS_HDIR = WS_XC + (size_t)T * 384 * 4;
constexpr size_t WS_S5E = WS_HDIR + (size_t)T * 768 * 4;
constexpr size_t WS_S5IN = WS_S5E + (size_t)BATCH * NT * 3072 * 8;
constexpr size_t WS_LRUPE = WS_S5IN + (size_t)BATCH * NT * 3072 * 8;
constexpr size_t WS_LRUIN = WS_LRUPE + (size_t)BATCH * NT * 768 * 8;
constexpr size_t WS_TKE = AL(WS_LRUIN + (size_t)BATCH * NT * 768 * 4);
constexpr size_t WS_TKG = WS_TKE + (size_t)T * 16;
constexpr size_t WS_TKP = WS_TKG + (size_t)T * 16;
constexpr size_t WS_TKD = WS_TKP + (size_t)T * 16;
constexpr size_t WS_ROWTOK = WS_TKD + (size_t)T * 16;
constexpr size_t WS_ROWGATE = AL(WS_ROWTOK + (size_t)NROWS * 4);
constexpr size_t WS_BLKE = AL(WS_ROWGATE + (size_t)NROWS * 4);
constexpr size_t WS_SCR = AL(WS_BLKE + (size_t)NMB_MAX * 4);
constexpr size_t WS_XBUF = WS_SCR;
constexpr size_t WS_LRUAB = WS_XBUF + (size_t)T * 3072 * 4;
constexpr size_t WS_ACT = WS_SCR;
constexpr size_t WS_YEXP = WS_ACT + (size_t)NROWS * 1024 * 2;
constexpr size_t SCR_A = (size_t)T * 3072 * 4 + (size_t)T * 768 * 8, SCR_B = (size_t)NROWS * 1024 * 2 * 2;
constexpr size_t WS_END = WS_SCR + (SCR_A > SCR_B ? SCR_A : SCR_B);
constexpr int CW_CNT = 8192, CNT_STRIDE = 64;
constexpr int CW_NMB = 192;
constexpr int CW_BAR = 4096;
constexpr size_t SP8_OFF = 524288;

#if defined(__HIP_DEVICE_COMPILE__) && !defined(HOST_TEST)
typedef __bf16 bf16v2_ __attribute__((ext_vector_type(2))); typedef float f32v2_ __attribute__((ext_vector_type(2)));
HD unsigned pk2(float lo, float hi) { const f32v2_ v = {lo, hi}; return __builtin_bit_cast(unsigned, __builtin_convertvector(v, bf16v2_)); }
HD unsigned f2bf(float f) { return (unsigned)__builtin_bit_cast(unsigned short, (__bf16)f); }
#else
HD unsigned f2bf(float f) { unsigned u; memcpy(&u, &f, 4); return (u + 0x7fffu + ((u >> 16) & 1u)) >> 16; }
HD unsigned pk2(float lo, float hi) { return f2bf(lo) | (f2bf(hi) << 16); }
#endif
HD float bf2f(unsigned b) { unsigned u = (b & 0xffffu) << 16; float f; memcpy(&f, &u, 4); return f; }
HD float sigmoidf_(float x) { return 1.f / (1.f + expf(-x)); }
#ifdef HOST_TEST
HD float sigmoid_fast(float x) { return 1.f / (1.f + expf(-x)); }
#else
__device__ __forceinline__ float sigmoid_fast(float x) { return __builtin_amdgcn_rcpf(1.f + __builtin_amdgcn_exp2f(-1.4426950408889634f * x)); }
__device__ __forceinline__ float expm1_dev(float x, float ex) { const float s = x * (1.f + x * (0.5f + x * (0.16666667f + x * (0.041666668f + x * 0.0083333338f)))); const float e = ex * ex - 1.f; return x > -0.3f ? s : e; }
#endif
#if defined(__HIP_DEVICE_COMPILE__) && !defined(HOST_TEST)
HD float gelu_tanh(float x) { return x * sigmoid_fast(1.5957691216057308f * (x + 0.044715f * x * x * x)); }
#else
HD float gelu_tanh(float x) { return 0.5f * x * (1.f + tanhf(0.7978845608028654f * (x + 0.044715f * x * x * x))); }
#endif

#ifdef HOST_TEST
struct f32x4 { float v[4]; float& operator[](int i) { return v[i]; } const float& operator[](int i) const { return v[i]; } };
#else
typedef float f32x4 __attribute__((ext_vector_type(4)));
#endif

struct Unit { int pm, pn, e; };

struct Ctx {
    const float* const* in;
    float* out;
    unsigned char* ws;
#define WSP(T_, name, off) HD T_* name() const { return (T_*)(ws + (off)); }
    WSP(unsigned, ctl, WS_CTL) WSP(bf16_t, win_t, WS_WIN) WSP(bf16_t, wglu_t, WS_WGLU) WSP(bf16_t, wout_t, WS_WOUT) WSP(bf16_t, wgu_t, WS_WGU) WSP(bf16_t, wdn_t, WS_WDN)
    WSP(unsigned char, hq, WS_O) WSP(unsigned char, act8, WS_ACT) WSP(unsigned char, wgu8, WS_WGU) WSP(unsigned char, wdn8, WS_WDN)
    WSP(bf16_t, lruw_t, WS_LRUWT) WSP(bf16_t, poolw_t, WS_POOLWT) WSP(bf16_t, hl, WS_HDIR) WSP(bf16_t, cp, WS_HDIR + (size_t)T * 768 * 2)
    WSP(float, rwt, WS_RWT) WSP(float, s5a, WS_S5A) WSP(float, s5a128, WS_S5A128) WSP(float, s5bb, WS_S5BB) WSP(float, s5pow, WS_S5POW) WSP(bf16_t, w4t, WS_W4T) WSP(bf16_t, ymat, WS_YMAT)
    WSP(bf16_t, hb, WS_HB) WSP(bf16_t, z, WS_Z) WSP(bf16_t, o, WS_O) WSP(bf16_t, v, WS_V) WSP(bf16_t, yb, WS_YB) WSP(bf16_t, act, WS_ACT) WSP(bf16_t, yexp, WS_YEXP)
    WSP(float, X, WS_X) WSP(float, pd, WS_PD) WSP(float, ya, WS_YA) WSP(float, xc, WS_XC) WSP(float, hdir, WS_HDIR) WSP(float, s5e, WS_S5E) WSP(float, s5in, WS_S5IN)
    WSP(float, lrupe, WS_LRUPE) WSP(float, lruin, WS_LRUIN) WSP(float, tkg, WS_TKG) WSP(float, rowgate, WS_ROWGATE) WSP(float, lruab, WS_LRUAB)
    WSP(int, tke, WS_TKE) WSP(int, tkp, WS_TKP) WSP(int, tkd, WS_TKD) WSP(int, rowtok, WS_ROWTOK) WSP(int, blke, WS_BLKE) WSP(unsigned, xbuf, WS_XBUF)
#undef WSP
};
#ifndef HOST_TEST
struct CtxG {
    const __attribute__((address_space(3))) unsigned long long* tab; __attribute__((address_space(1))) float* outg; __attribute__((address_space(1))) unsigned char* wsg;
    struct InProxy { const __attribute__((address_space(3))) unsigned long long* tab; __device__ __forceinline__ const float* operator[](int i) const { return (const float*)(__attribute__((address_space(1))) const float*)tab[i]; } } in;
    float* out;
    __device__ __forceinline__ explicit CtxG(const Ctx& c) { tab = (const __attribute__((address_space(3))) unsigned long long*)(const unsigned long long*)(const void*)c.in; in.tab = tab; outg = (__attribute__((address_space(1))) float*)(unsigned long long)c.out; wsg = (__attribute__((address_space(1))) unsigned char*)(unsigned long long)c.ws; out = (float*)outg; }
#define WSPG(T_, name, off) __device__ __forceinline__ T_* name() const { return (T_*)(__attribute__((address_space(1))) T_*)(wsg + (off)); }
    WSPG(unsigned, ctl, WS_CTL) WSPG(bf16_t, win_t, WS_WIN) WSPG(bf16_t, wglu_t, WS_WGLU) WSPG(bf16_t, wout_t, WS_WOUT) WSPG(bf16_t, wgu_t, WS_WGU) WSPG(bf16_t, wdn_t, WS_WDN)
    WSPG(unsigned char, hq, WS_O) WSPG(unsigned char, act8, WS_ACT) WSPG(unsigned char, wgu8, WS_WGU) WSPG(unsigned char, wdn8, WS_WDN)
    WSPG(bf16_t, lruw_t, WS_LRUWT) WSPG(bf16_t, poolw_t, WS_POOLWT) WSPG(bf16_t, hl, WS_HDIR) WSPG(bf16_t, cp, WS_HDIR + (size_t)T * 768 * 2)
    WSPG(float, rwt, WS_RWT) WSPG(float, s5a, WS_S5A) WSPG(float, s5a128, WS_S5A128) WSPG(float, s5bb, WS_S5BB) WSPG(float, s5pow, WS_S5POW) WSPG(bf16_t, w4t, WS_W4T) WSPG(bf16_t, ymat, WS_YMAT)
    WSPG(bf16_t, hb, WS_HB) WSPG(bf16_t, z, WS_Z) WSPG(bf16_t, o, WS_O) WSPG(bf16_t, v, WS_V) WSPG(bf16_t, yb, WS_YB) WSPG(bf16_t, act, WS_ACT) WSPG(bf16_t, yexp, WS_YEXP)
    WSPG(float, X, WS_X) WSPG(float, pd, WS_PD) WSPG(float, ya, WS_YA) WSPG(float, xc, WS_XC) WSPG(float, hdir, WS_HDIR) WSPG(float, s5e, WS_S5E) WSPG(float, s5in, WS_S5IN)
    WSPG(float, lrupe, WS_LRUPE) WSPG(float, lruin, WS_LRUIN) WSPG(float, tkg, WS_TKG) WSPG(float, rowgate, WS_ROWGATE) WSPG(float, lruab, WS_LRUAB)
    WSPG(int, tke, WS_TKE) WSPG(int, tkp, WS_TKP) WSPG(int, tkd, WS_TKD) WSPG(int, rowtok, WS_ROWTOK) WSPG(int, blke, WS_BLKE) WSPG(unsigned, xbuf, WS_XBUF)
#undef WSPG
};
#endif
enum { I_X = 0, I_N1G, I_WIN, I_POOLW, I_POOLS, I_LAMRE, I_LAMIM, I_LOGSTEP, I_BRE, I_BIM, I_CRE, I_CIM, I_S5D, I_WGLU, I_BGLU, I_CONVW, I_CONVB, I_WA, I_BA, I_WX, I_BX, I_LAM,
       I_MIXG, I_WOUT, I_N2G, I_RW, I_RB, I_WGU, I_BGU, I_WDN, I_BDN, I_FING };

HD void st_prep_small(long gtid, long gs, const Ctx& c) {
    for (long i = gtid; i < 6144; i += gs) {
        const float lr = c.in[I_LAMRE][i], li = c.in[I_LAMIM][i], dt = expf(c.in[I_LOGSTEP][i / 64]);
        const float mag = expf(lr * dt), ar = mag * cosf(li * dt), ai = mag * sinf(li * dt);
        const float den = lr * lr + li * li, nr = ar - 1.f, ni = ai, qr = (nr * lr + ni * li) / den, qi = (ni * lr - nr * li) / den;
        c.s5a()[2 * i] = ar; c.s5a()[2 * i + 1] = ai;
        float pr = ar, pi = ai;
        for (int k = 0; k < 7; ++k) { const float t = pr * pr - pi * pi; pi = 2.f * pr * pi; pr = t; }
        c.s5a128()[2 * i] = pr; c.s5a128()[2 * i + 1] = pi;
        for (int cc = 0; cc < 16; ++cc) { const float br = c.in[I_BRE][i * 16 + cc], bi = c.in[I_BIM][i * 16 + cc];
            c.s5bb()[(i * 16 + cc) * 2] = qr * br - qi * bi; c.s5bb()[(i * 16 + cc) * 2 + 1] = qr * bi + qi * br; }
    }
    for (long i = gtid; i < 2 * NE * 1024; i += gs) { const int l = (int)(i / (NE * 1024)), e = (int)(i / 1024) % NE, k = (int)(i % 1024);
        const float f_ = c.in[I_N2G][l * 1024 + k] * c.in[I_RW][((size_t)l * 1024 + k) * NE + e];
#ifdef HOST_TEST
        c.rwt()[i] = f_; }
#else
        { bf16_t* rh = (bf16_t*)c.rwt(); const unsigned hi_ = f2bf(f_); const float lo_ = f_ - bf2f(hi_);
          rh[((size_t)(l * 2) * NE + e) * 1024 + k] = (bf16_t)hi_; rh[((size_t)(l * 2 + 1) * NE + e) * 1024 + k] = (bf16_t)f2bf(lo_); } }
#endif
    for (long i = gtid; i < (long)2 * 128 * 1024; i += gs) { const int l = (int)(i / (128 * 1024)); const long r = i % (128 * 1024);
        c.win_t()[(size_t)l * D_INP * D + (size_t)D_IN * D + r] = 0; }
}
HD void cpowi(float ar, float ai, int e, float& pr, float& pi) { pr = 1.f; pi = 0.f; for (int k = 0; k < e; ++k) { const float t = pr * ar - pi * ai; pi = pr * ai + pi * ar; pr = t; } }
HD void st_prep_s5mat(long gtid, long gs, const Ctx& c) {
    const float* cre_ = c.in[I_CRE]; const float* cim_ = c.in[I_CIM]; const float* s5d_ = c.in[I_S5D];
    for (long i = gtid; i < 6144; i += gs) { const float ar = c.s5a()[2 * i], ai = c.s5a()[2 * i + 1]; float pr, pi;
        cpowi(ar, ai, 4, pr, pi); c.s5pow()[i * 8 + 0] = pr; c.s5pow()[i * 8 + 1] = pi;
        cpowi(ar, ai, 16, pr, pi); c.s5pow()[i * 8 + 2] = pr; c.s5pow()[i * 8 + 3] = pi;
        cpowi(ar, ai, 32, pr, pi); c.s5pow()[i * 8 + 4] = pr; c.s5pow()[i * 8 + 5] = pi;
        cpowi(ar, ai, 64, pr, pi); c.s5pow()[i * 8 + 6] = pr; c.s5pow()[i * 8 + 7] = pi; }
    for (long i = gtid; i < (long)2 * 24 * 2 * 128 * 64; i += gs) { const int k = (int)(i % 64), pp = (int)(i / 64) % 128, dir = (int)(i / 8192) % 2, g = (int)(i / 16384) % 24, l = (int)(i / 16384 / 24);
        const int p = pp & 63, j = k >> 4, cc = k & 15, ci = ((l * 2 + dir) * 24 + g) * 64 + p; float pr, pi; cpowi(c.s5a()[2 * ci], c.s5a()[2 * ci + 1], dir ? j : 3 - j, pr, pi);
        const float br = c.s5bb()[(ci * 16 + cc) * 2], bi = c.s5bb()[(ci * 16 + cc) * 2 + 1];
        c.w4t()[i] = (bf16_t)f2bf(pp < 64 ? pr * br - pi * bi : pr * bi + pi * br); }
    for (long i = gtid; i < (long)2 * 24 * 64 * 256; i += gs) { const int k = (int)(i % 256), row = (int)(i / 256) % 64, g = (int)(i / 16384) % 24, l = (int)(i / 16384 / 24); const int j = row >> 4, cc = row & 15;
        const int dir = k >> 7, kk = k & 127, nt = kk < 64 ? 0 : 4, p = kk & 63, ci = ((l * 2 + dir) * 24 + g) * 64 + p; float pr, pi; cpowi(c.s5a()[2 * ci], c.s5a()[2 * ci + 1], dir ? 4 - j : j + 1, pr, pi);
        const size_t co = ((size_t)((l * 2 + dir) * 24 + g) * 16 + cc) * 64 + p; const float cr = cre_[co], cim = cim_[co];
        const float val = nt < 4 ? cr * pr - cim * pi : -(cr * pi + cim * pr);
        c.ymat()[((size_t)(l * 24 + g) * 64 + row) * 320 + k] = (bf16_t)f2bf(val); }
    for (long i = gtid; i < (long)2 * 24 * 7 * 256; i += gs) { const int c2 = (int)(i % 16), cc = (int)(i / 16) % 16, dd = (int)(i / 256) % 7, g = (int)(i / 1792) % 24, l = (int)(i / 1792 / 24); const int d = dd - 3;
        float val = (d == 0 && c2 == cc) ? s5d_[l * 384 + g * 16 + cc] : 0.f;
        for (int dir = 0; dir < 2; ++dir) { if (dir == 0 ? d < 0 : d > 0) continue; const int e = d < 0 ? -d : d;
            for (int p = 0; p < 64; ++p) { const int ci = ((l * 2 + dir) * 24 + g) * 64 + p; float pr, pi; cpowi(c.s5a()[2 * ci], c.s5a()[2 * ci + 1], e, pr, pi);
                const size_t co = ((size_t)((l * 2 + dir) * 24 + g) * 16 + cc) * 64 + p; const float cr = cre_[co], cim = cim_[co]; const float xr = cr * pr - cim * pi, xi = cr * pi + cim * pr;
                val += xr * c.s5bb()[(ci * 16 + c2) * 2] - xi * c.s5bb()[(ci * 16 + c2) * 2 + 1]; } }
        const bf16_t vb = (bf16_t)f2bf(val);
        for (int j = 0; j < 4; ++j) { const int ii = j - d; if (ii < 0 || ii > 3) continue; c.ymat()[((size_t)(l * 24 + g) * 64 + j * 16 + cc) * 320 + 256 + ii * 16 + c2] = vb; } }
}
HD void s5_tile_ref(const Ctx& c, int l, int tile, int g, bool final_pass) {
    const int b = tile / NT, ct = tile % NT, t0 = b * SEQ + ct * LC;
    float U[32][64];
    for (int n = 0; n < 32; ++n) for (int k = 0; k < 64; ++k) U[n][k] = bf2f(c.z()[(size_t)(t0 + 4 * n + (k >> 4)) * D_INP + 256 + 16 * g + (k & 15)]);
    float S[2][33][128];
    for (int dir = 0; dir < 2; ++dir) {
        const bf16_t* w = c.w4t() + (size_t)((l * 24 + g) * 2 + dir) * 128 * 64;
        for (int p = 0; p < 64; ++p) { const int ci = ((l * 2 + dir) * 24 + g) * 64 + p; const float a4r = c.s5pow()[ci * 8], a4i = c.s5pow()[ci * 8 + 1];
            float sr = 0.f, si = 0.f; const size_t io = ((size_t)(b * NT + ct) * 3072 + dir * 1536 + g * 64 + p) * 2;
            if (final_pass) { sr = c.s5in()[io]; si = c.s5in()[io + 1]; }
            if (dir == 0) { S[0][0][p] = sr; S[0][0][64 + p] = si; } else { S[1][32][p] = sr; S[1][32][64 + p] = si; }
            for (int q = 0; q < 32; ++q) { const int n = dir == 0 ? q : 31 - q; float gr = 0.f, gi = 0.f;
                for (int k = 0; k < 64; ++k) { gr += U[n][k] * bf2f(w[p * 64 + k]); gi += U[n][k] * bf2f(w[(64 + p) * 64 + k]); }
                const float nr = a4r * sr - a4i * si + gr, ni = a4r * si + a4i * sr + gi; sr = nr; si = ni;
                const int row = dir == 0 ? n + 1 : n; S[dir][row][p] = sr; S[dir][row][64 + p] = si; }
            if (!final_pass) { c.s5e()[io] = sr; c.s5e()[io + 1] = si; } } }
    if (!final_pass) return;
    const bf16_t* ym = c.ymat() + (size_t)(l * 24 + g) * 64 * 320;
    for (int n = 0; n < 32; ++n) for (int row = 0; row < 64; ++row) { float y = 0.f;
        for (int k = 0; k < 256; ++k) { const int dir = k >> 7, pp = k & 127; const float s = dir == 0 ? S[0][n][pp] : S[1][n + 1][pp];
            y += bf2f(ym[row * 320 + k]) * bf2f(f2bf(s)); }
        for (int k = 0; k < 64; ++k) y += bf2f(ym[row * 320 + 256 + k]) * U[n][k];
        c.v()[(size_t)(t0 + 4 * n + (row >> 4)) * 384 + 16 * g + (row & 15)] = (bf16_t)f2bf(gelu_tanh(y)); }
}
HD void st_mix1(long gtid, long gs, const Ctx& c, int l) {
    for (long i = gtid; i < (long)T * 256; i += gs) { const int t = (int)(i / 256), ch = (int)(i % 256), g = ch / 64, half = 1 << g, s = t % SEQ, b0 = t - s;
        const int lo = s - half < 0 ? 0 : s - half, hi = s + half > SEQ ? SEQ : s + half; float sum = 0.f;
        for (int q = lo; q < hi; ++q) sum += bf2f(c.z()[(size_t)(b0 + q) * D_INP + ch]);
        c.pd()[i] = sum / (float)(hi - lo) - bf2f(c.z()[(size_t)t * D_INP + ch]); }
    const float* cw = c.in[I_CONVW] + l * 4 * 384; const float* cb = c.in[I_CONVB] + l * 384;
    for (long i = gtid; i < (long)T * 384; i += gs) { const int t = (int)(i / 384), ch = (int)(i % 384), s = t % SEQ; float a = cb[ch];
        for (int j = 0; j < 4; ++j) { const int q = s - 1 + j; if (q >= 0 && q < SEQ) a += cw[j * 384 + ch] * bf2f(c.z()[(size_t)(t - 1 + j) * D_INP + 640 + ch]); }
        c.xc()[i] = a; }
}
HD void st_s5_scan(long gtid, long gs, const Ctx& c, int l, bool final_pass) {
    for (long i = gtid; i < (long)BATCH * NT * 3072; i += gs) {
        const int p = (int)(i % 64), g = (int)(i / 64) % 24, dir = (int)(i / 1536) % 2, ct = (int)(i / 3072) % NT, b = (int)(i / 3072 / NT);
        const int ci = ((l * 2 + dir) * 24 + g) * 64 + p;
        const float ar = c.s5a()[2 * ci], ai = c.s5a()[2 * ci + 1];
        float bbr[16], bbi[16];
        for (int cc = 0; cc < 16; ++cc) { bbr[cc] = c.s5bb()[(ci * 16 + cc) * 2]; bbi[cc] = c.s5bb()[(ci * 16 + cc) * 2 + 1]; }
        float xr = 0.f, xi = 0.f;
        if (final_pass) { xr = c.s5in()[2 * i]; xi = c.s5in()[2 * i + 1]; }
        for (int q = 0; q < LC; ++q) { const int tt = b * SEQ + ct * LC + (dir == 0 ? q : LC - 1 - q);
            const bf16_t* u = c.z() + (size_t)tt * D_INP + 256 + 16 * g; float bur = 0.f, bui = 0.f;
            for (int cc = 0; cc < 16; ++cc) { const float uv = bf2f(u[cc]); bur += bbr[cc] * uv; bui += bbi[cc] * uv; }
            const float nr = ar * xr - ai * xi + bur, ni = ar * xi + ai * xr + bui; xr = nr; xi = ni;
            if (final_pass) c.xbuf()[((size_t)tt * 2 + dir) * 1536 + g * 64 + p] = pk2(xr, xi); }
        if (!final_pass) { c.s5e()[2 * i] = xr; c.s5e()[2 * i + 1] = xi; }
    }
}
HD void st_mix2(long gtid, long gs, const Ctx& c, int l) {
    const float* pw = c.in[I_POOLW] + l * 4 * 64 * 64; const float* ps = c.in[I_POOLS] + l * 256;
    for (long i = gtid; i < (long)T * 256; i += gs) { const int t = (int)(i / 256), ch = (int)(i % 256), g = ch / 64, dd = ch % 64; float a = 0.f;
        for (int k = 0; k < 64; ++k) a += c.pd()[(size_t)t * 256 + g * 64 + k] * pw[(g * 64 + k) * 64 + dd];
        c.ya()[i] = a * ps[ch]; }
    for (long i = gtid; i < (long)T * 768; i += gs) { const int t = (int)(i / 768), dir = (int)(i / 384) % 2, ch = (int)(i % 384), h = ch / 64, j = ch % 64;
        const float* wa = c.in[I_WA] + (((size_t)(l * 2 + dir) * 6 + h) * 64) * 64; const float* wx = c.in[I_WX] + (((size_t)(l * 2 + dir) * 6 + h) * 64) * 64;
        float ra = c.in[I_BA][(l * 2 + dir) * 384 + ch], rx = c.in[I_BX][(l * 2 + dir) * 384 + ch];
        const float* xr = c.xc() + (size_t)t * 384 + h * 64;
        for (int k = 0; k < 64; ++k) { const float xv = xr[k]; ra += xv * wa[k * 64 + j]; rx += xv * wx[k * 64 + j]; }
        const float r = sigmoidf_(ra), ig = sigmoidf_(rx), sp = log1pf(expf(-c.in[I_LAM][(l * 2 + dir) * 384 + ch]));
        const float la = -8.f * r * sp, a = expf(la), bt = sqrtf(-expm1f(2.f * la)) * (ig * c.xc()[(size_t)t * 384 + ch]);
        c.lruab()[2 * i] = a; c.lruab()[2 * i + 1] = bt; }
    for (long i = gtid; i < (long)BATCH * 3072; i += gs) { const int r = (int)(i % 3072), b = (int)(i / 3072), dir = r / 1536; const int ci = l * 3072 + r;
        const float ar = c.s5a128()[2 * ci], ai = c.s5a128()[2 * ci + 1]; float sr = 0.f, si = 0.f;
        for (int q = 0; q < NT; ++q) { const int ct = dir == 0 ? q : NT - 1 - q; const size_t o = ((size_t)(b * NT + ct) * 3072 + r) * 2;
            c.s5in()[o] = sr; c.s5in()[o + 1] = si; const float er = c.s5e()[o], ei = c.s5e()[o + 1];
            const float nr = ar * sr - ai * si + er, ni = ar * si + ai * sr + ei; sr = nr; si = ni; } }
}
HD void st_lru_scan(long gtid, long gs, const Ctx& c, bool final_pass) {
    for (long i = gtid; i < (long)BATCH * NT * 768; i += gs) { const int r = (int)(i % 768), dir = r / 384, ch = r % 384, ct = (int)(i / 768) % NT, b = (int)(i / 768 / NT);
        float h = final_pass ? c.lruin()[i] : 0.f, P = 1.f;
        for (int q = 0; q < LC; ++q) { const int tt = b * SEQ + ct * LC + (dir == 0 ? q : LC - 1 - q); const size_t o = ((size_t)tt * 768 + r) * 2;
            const float a = c.lruab()[o], bt = c.lruab()[o + 1]; h = a * h + bt; P *= a;
            if (final_pass) c.hdir()[(size_t)tt * 768 + dir * 384 + ch] = h; }
        if (!final_pass) { c.lrupe()[2 * i] = P; c.lrupe()[2 * i + 1] = h; } }
}
HD void st_mix4(long gtid, long gs, const Ctx& c, int l, bool s5_naive) {
    for (long i = gtid; i < (long)BATCH * 768; i += gs) { const int r = (int)(i % 768), b = (int)(i / 768), dir = r / 384; float h = 0.f;
        for (int q = 0; q < NT; ++q) { const int ct = dir == 0 ? q : NT - 1 - q; const size_t o = (size_t)(b * NT + ct) * 768 + r;
            c.lruin()[o] = h; h = c.lrupe()[2 * o] * h + c.lrupe()[2 * o + 1]; } }
    if (s5_naive) for (long i = gtid; i < (long)T * 384; i += gs) { const int t = (int)(i / 384), ch = (int)(i % 384), g = ch / 16, cc = ch % 16;
        float y = c.in[I_S5D][l * 384 + ch] * bf2f(c.z()[(size_t)t * D_INP + 256 + ch]);
        for (int dir = 0; dir < 2; ++dir) { const float* cr = c.in[I_CRE] + ((size_t)((l * 2 + dir) * 24 + g) * 16 + cc) * 64; const float* cim = c.in[I_CIM] + ((size_t)((l * 2 + dir) * 24 + g) * 16 + cc) * 64;
            const unsigned* xb = c.xbuf() + ((size_t)t * 2 + dir) * 1536 + g * 64;
            for (int p = 0; p < 64; ++p) { const unsigned w = xb[p]; y += cr[p] * bf2f(w & 0xffffu) - cim[p] * bf2f(w >> 16); } }
        c.v()[i] = (bf16_t)f2bf(gelu_tanh(y)); }
}
HD float expm1_small(float x) { return x > -0.3f ? x * (1.f + x * (0.5f + x * (0.16666667f + x * (0.041666668f + x * 0.0083333338f)))) : expf(x) - 1.f; }
HD void st_prep_mixw(long gtid, long gs, const Ctx& c) {
    for (long i = gtid; i < (long)2 * 2 * 6 * 2 * 4096; i += gs) { const int ii = (int)(i % 64), j = (int)(i / 64) % 64, which = (int)(i / 4096) % 2; const long ldh = i / 8192;
        const float* w = (which ? c.in[I_WX] : c.in[I_WA]) + ldh * 4096; c.lruw_t()[i] = (bf16_t)f2bf(w[ii * 64 + j]); }
    for (long i = gtid; i < (long)2 * 4 * 4096; i += gs) { const int cc = (int)(i % 64), dd = (int)(i / 64) % 64; const long lg = i / 4096; c.poolw_t()[i] = (bf16_t)f2bf(c.in[I_POOLW][lg * 4096 + cc * 64 + dd]); }
    for (long i = gtid; i < (long)2 * 2 * 384; i += gs) ((float*)c.ctl() + SP8_OFF / 4)[i] = -8.f * log1pf(expf(-c.in[I_LAM][i]));
}
HD void mixer_tile_ref(const Ctx& c, int l, int tile) {
    const int b = tile / NT, ct = tile % NT, s0 = ct * LC, t0 = b * SEQ + s0;
    for (int t = 0; t < LC; ++t) { float ya[256]; float ss = 0.f;
        for (int ch = 0; ch < 256; ++ch) ya[ch] = 0.f;
        for (int g = 0; g < 4; ++g) { const int half = 1 << g, s = s0 + t, lo = s - half < 0 ? 0 : s - half, hi = s + half > SEQ ? SEQ : s + half; float d[64];
            for (int cc = 0; cc < 64; ++cc) { float sum = 0.f; for (int q = lo; q < hi; ++q) sum += bf2f(c.z()[(size_t)(b * SEQ + q) * D_INP + g * 64 + cc]);
                d[cc] = bf2f(f2bf(sum / (float)(hi - lo) - bf2f(c.z()[(size_t)(t0 + t) * D_INP + g * 64 + cc]))); }
            for (int dd = 0; dd < 64; ++dd) { float a = 0.f; for (int cc = 0; cc < 64; ++cc) a += d[cc] * bf2f(c.poolw_t()[((size_t)(l * 4 + g) * 64 + dd) * 64 + cc]);
                ya[g * 64 + dd] = a * c.in[I_POOLS][l * 256 + g * 64 + dd]; } }
        for (int ch = 0; ch < 256; ++ch) ss += ya[ch] * ya[ch];
        const float rstd = 1.f / sqrtf(ss * (1.f / 256) + EPS);
        for (int ch = 0; ch < 256; ++ch) c.o()[(size_t)(t0 + t) * D + ch] = (bf16_t)f2bf(ya[ch] * rstd); }
    for (int h = 0; h < 6; ++h) {
        float xc[LC][64];
        for (int t = 0; t < LC; ++t) for (int cc = 0; cc < 64; ++cc) { const int ch = h * 64 + cc; float a = c.in[I_CONVB][l * 384 + ch];
            for (int j = 0; j < 4; ++j) { const int q = s0 + t - 1 + j; if (q >= 0 && q < SEQ) a += c.in[I_CONVW][(l * 4 + j) * 384 + ch] * bf2f(c.z()[(size_t)(b * SEQ + q) * D_INP + 640 + ch]); }
            xc[t][cc] = bf2f(f2bf(a)); }
        for (int dir = 0; dir < 2; ++dir) for (int cc = 0; cc < 64; ++cc) { const int ch = h * 64 + cc, pi = (l * 2 + dir) * 384 + ch;
            const bf16_t* wa = c.lruw_t() + ((size_t)(((l * 2 + dir) * 6 + h) * 2 + 0) * 64 + cc) * 64; const bf16_t* wx = wa + 4096;
            const float sp = log1pf(expf(-c.in[I_LAM][pi])); float hh = 0.f, P = 1.f;
            for (int q = 0; q < LC; ++q) { const int t = dir == 0 ? q : LC - 1 - q; float ra = c.in[I_BA][pi], rx = c.in[I_BX][pi];
                for (int k = 0; k < 64; ++k) { ra += xc[t][k] * bf2f(wa[k]); rx += xc[t][k] * bf2f(wx[k]); }
                const float r = sigmoidf_(ra), ig = sigmoidf_(rx), la = -8.f * r * sp, a = expf(la), bt = sqrtf(-expm1_small(2.f * la)) * (ig * xc[t][cc]);
                hh = a * hh + bf2f(f2bf(bt)); P *= a;
                c.hl()[((size_t)(t0 + t) * 2 + dir) * 384 + ch] = (bf16_t)f2bf(hh); c.cp()[((size_t)(t0 + t) * 2 + dir) * 384 + ch] = (bf16_t)f2bf(P); }
            const size_t o = ((size_t)(b * NT + ct) * 768 + dir * 384 + ch) * 2; c.lrupe()[o] = P; c.lrupe()[o + 1] = hh; } }
}
HD void st_carries(long gtid, long gs, const Ctx& c, int l) {
    for (long i = gtid; i < (long)BATCH * 3072; i += gs) { const int r = (int)(i % 3072), b = (int)(i / 3072), dir = r / 1536; const int ci = l * 3072 + r;
        const float ar = c.s5a128()[2 * ci], ai = c.s5a128()[2 * ci + 1]; float sr = 0.f, si = 0.f;
        for (int q = 0; q < NT; ++q) { const int ct = dir == 0 ? q : NT - 1 - q; const size_t o = ((size_t)(b * NT + ct) * 3072 + r) * 2;
            c.s5in()[o] = sr; c.s5in()[o + 1] = si; const float er = c.s5e()[o], ei = c.s5e()[o + 1];
            const float nr = ar * sr - ai * si + er, ni = ar * si + ai * sr + ei; sr = nr; si = ni; } }
    for (long i = gtid; i < (long)BATCH * 768; i += gs) { const int r = (int)(i % 768), b = (int)(i / 768), dir = r / 384; float h = 0.f;
        for (int q = 0; q < NT; ++q) { const int ct = dir == 0 ? q : NT - 1 - q; const size_t o = (size_t)(b * NT + ct) * 768 + r;
            c.lruin()[o] = h; h = c.lrupe()[2 * o] * h + c.lrupe()[2 * o + 1]; } }
}
HD void expert_range(const unsigned* cnt, int e, int& start, int& count) { int s = 0; for (int q = 0; q < e; ++q) s += ((int)cnt[q * CNT_STRIDE] + 255) & ~255; start = s; count = (int)cnt[e * CNT_STRIDE]; }
HD void st_route(long gtid, long gs, const Ctx& c, int l) {
    const unsigned* cnt = c.ctl() + CW_CNT + 32 * l * CNT_STRIDE;
    for (long i = gtid; i < (long)T * 4; i += gs) { const int e = c.tke()[i]; int st, n; expert_range(cnt, e, st, n); const int d = st + c.tkp()[i];
        c.tkd()[i] = d; c.rowtok()[d] = (int)(i / 4); c.rowgate()[d] = c.tkg()[i]; }
    int total = 0; for (int q = 0; q < NE; ++q) total += ((int)cnt[q * CNT_STRIDE] + 255) & ~255;
    for (long r = gtid; r < total; r += gs) { int e = 0, st = 0; for (;;) { const int pe = ((int)cnt[e * CNT_STRIDE] + 255) & ~255; if (r < st + pe) break; st += pe; ++e; }
        if (r - st >= (long)cnt[e * CNT_STRIDE]) { c.rowtok()[r] = 0; c.rowgate()[r] = 0.f; }
        if ((r & 255) == 0) c.blke()[r >> 8] = e; }
    if (gtid == 0) c.ctl()[CW_NMB + l] = (unsigned)(total / 256);
}

#ifdef HOST_TEST
constexpr int NL = 1;
inline float wsum(float v) { return v; }
#else
constexpr int NL = 64;
DEV float wsum(float v) {
#pragma unroll
    for (int o = 1; o < 64; o <<= 1) v += __shfl_xor(v, o);
    return v;
}
#endif
HD void row_norm_bf16(const float* xr, bf16_t* orow, int lane) {
    float ss = 0.f;
    for (int k = lane * 4; k < D; k += NL * 4) { const float a = xr[k], b = xr[k + 1], cc = xr[k + 2], d = xr[k + 3]; ss += a * a + b * b + cc * cc + d * d; }
    const float rstd = 1.f / sqrtf(wsum(ss) * (1.f / D) + EPS);
    for (int k = lane * 4; k < D; k += NL * 4) { unsigned* o = (unsigned*)(orow + k); o[0] = pk2(xr[k] * rstd, xr[k + 1] * rstd); o[1] = pk2(xr[k + 2] * rstd, xr[k + 3] * rstd); }
}
HD void row_mix_norm(const Ctx& c, int t, int lane) {
    bf16_t* orow = c.o() + (size_t)t * D;
    { float ss = 0.f; const float* ya = c.ya() + (size_t)t * 256;
      for (int k = lane; k < 256; k += NL) ss += ya[k] * ya[k];
      const float rstd = 1.f / sqrtf(wsum(ss) * (1.f / 256) + EPS);
      for (int k = lane; k < 256; k += NL) orow[k] = (bf16_t)f2bf(ya[k] * rstd); }
    { float ss = 0.f; const bf16_t* yb = c.yb() + (size_t)t * 384;
      for (int k = lane; k < 384; k += NL) { const float y = bf2f(yb[k]); ss += y * y; }
      const float rstd = 1.f / sqrtf(wsum(ss) * (1.f / 384) + EPS);
      for (int k = lane; k < 384; k += NL) orow[256 + k] = (bf16_t)f2bf(bf2f(yb[k]) * rstd); }
    { float ss = 0.f; const float* hd = c.hdir() + (size_t)t * 768; const bf16_t* gz = c.z() + (size_t)t * D_INP + 1024;
      for (int k = lane; k < 384; k += NL) { const float y = (hd[k] + hd[384 + k]) * gelu_tanh(bf2f(gz[k])); ss += y * y; }
      const float rstd = 1.f / sqrtf(wsum(ss) * (1.f / 384) + EPS);
      for (int k = lane; k < 384; k += NL) { const float y = (hd[k] + hd[384 + k]) * gelu_tanh(bf2f(gz[k])); orow[640 + k] = (bf16_t)f2bf(y * rstd); } }
}
HD void row_mix_norm2(const Ctx& c, int t, int lane) {
    bf16_t* orow = c.o() + (size_t)t * D;
    { float ss = 0.f; const bf16_t* yb = c.yb() + (size_t)t * 384;
      for (int k = lane; k < 384; k += NL) { const float y = bf2f(yb[k]); ss += y * y; }
      const float rstd = 1.f / sqrtf(wsum(ss) * (1.f / 384) + EPS);
      for (int k = lane; k < 384; k += NL) orow[256 + k] = (bf16_t)f2bf(bf2f(yb[k]) * rstd); }
    { float ss = 0.f; const bf16_t* hl = c.hl() + (size_t)t * 768; const bf16_t* cp = c.cp() + (size_t)t * 768; const bf16_t* gz = c.z() + (size_t)t * D_INP + 1024;
      const float* cin = c.lruin() + (size_t)((t / SEQ) * NT + (t % SEQ) / LC) * 768;
      for (int k = lane; k < 384; k += NL) { const float y = (bf2f(hl[k]) + bf2f(cp[k]) * cin[k] + bf2f(hl[384 + k]) + bf2f(cp[384 + k]) * cin[384 + k]) * gelu_tanh(bf2f(gz[k])); ss += y * y; }
      const float rstd = 1.f / sqrtf(wsum(ss) * (1.f / 384) + EPS);
      for (int k = lane; k < 384; k += NL) { const float y = (bf2f(hl[k]) + bf2f(cp[k]) * cin[k] + bf2f(hl[384 + k]) + bf2f(cp[384 + k]) * cin[384 + k]) * gelu_tanh(bf2f(gz[k])); orow[640 + k] = (bf16_t)f2bf(y * rstd); } }
}
HD void row_combine(const Ctx& c, int t, int lane, bool last) {
    float* xr = c.X() + (size_t)t * D; float ss = 0.f;
    const int d0 = c.tkd()[t * 4], d1 = c.tkd()[t * 4 + 1], d2 = c.tkd()[t * 4 + 2], d3 = c.tkd()[t * 4 + 3];
    for (int k = lane * 4; k < D; k += NL * 4) {
        for (int j = 0; j < 4; ++j) { float a = xr[k + j];
            a += bf2f(c.yexp()[(size_t)d0 * 1024 + k + j]); a += bf2f(c.yexp()[(size_t)d1 * 1024 + k + j]); a += bf2f(c.yexp()[(size_t)d2 * 1024 + k + j]); a += bf2f(c.yexp()[(size_t)d3 * 1024 + k + j]);
            xr[k + j] = a; ss += a * a; } }
    const float rstd = 1.f / sqrtf(wsum(ss) * (1.f / D) + EPS);
    if (!last) { bf16_t* orow = c.hb() + (size_t)t * D;
        for (int k = lane * 4; k < D; k += NL * 4) { unsigned* o = (unsigned*)(orow + k); o[0] = pk2(xr[k] * rstd, xr[k + 1] * rstd); o[1] = pk2(xr[k + 2] * rstd, xr[k + 3] * rstd); } }
    else { float* orow = c.out + (size_t)t * D; const float* fg = c.in[I_FING];
        for (int k = lane * 4; k < D; k += NL * 4) for (int j = 0; j < 4; ++j) orow[k + j] = xr[k + j] * rstd * fg[k + j]; }
}

HD void st_bf16x4(bf16_t* p, float a, float b, float cc, float d) { unsigned* o = (unsigned*)p; o[0] = pk2(a, b); o[1] = pk2(cc, d); }
struct EpiIn { static constexpr bool SIDE = false; bf16_t* z; HD void operator()(const Unit&, int row, int col, const f32x4& v) const { st_bf16x4(z + (size_t)row * D_INP + col, v[0], v[1], v[2], v[3]); } };
struct EpiGlu { static constexpr bool SIDE = false; bf16_t* yb; const float* b;
    HD void operator()(const Unit&, int row, int col, const f32x4& v) const { const int j = col >> 1;
        const float y0 = (v[0] + b[j]) * sigmoid_fast(v[1] + b[384 + j]), y1 = (v[2] + b[j + 1]) * sigmoid_fast(v[3] + b[384 + j + 1]);
        *(unsigned*)(yb + (size_t)row * 384 + j) = pk2(y0, y1); } };
struct EpiOut { static constexpr bool SIDE = false; const float* base; float* X;
#ifdef HOST_TEST
    HD void operator()(const Unit&, int row, int col, const f32x4& v) const { const size_t o = (size_t)row * D + col; for (int j = 0; j < 4; ++j) X[o + j] = base[o + j] + v[j]; } };
#else
    __device__ __forceinline__ void operator()(const Unit&, int row, int col, const f32x4& v) const { const size_t o = (size_t)row * D + col; const f32x4 r = *(const __attribute__((address_space(1))) f32x4*)(base + o) + v; *(__attribute__((address_space(1))) f32x4*)(X + o) = r; } };
#endif
#ifndef HOST_TEST
template <bool BASE_F32>
struct EpiOutW { static constexpr bool SIDE = false; const void* base; bf16_t* X;
    __device__ __forceinline__ void wide(const Unit&, int row, int col, const f32x4& a, const f32x4& b) const { typedef unsigned u4_ __attribute__((ext_vector_type(4)));
        const size_t o = (size_t)row * D + col; f32x4 r0, r1;
        if constexpr (BASE_F32) { const __attribute__((address_space(1))) f32x4* p = (const __attribute__((address_space(1))) f32x4*)((const float*)base + o); r0 = p[0]; r1 = p[1]; }
        else { const u4_ w = *(const __attribute__((address_space(1))) u4_*)((const bf16_t*)base + o);
            r0 = (f32x4){__builtin_bit_cast(float, w.x << 16), __builtin_bit_cast(float, w.x & 0xffff0000u), __builtin_bit_cast(float, w.y << 16), __builtin_bit_cast(float, w.y & 0xffff0000u)};
            r1 = (f32x4){__builtin_bit_cast(float, w.z << 16), __builtin_bit_cast(float, w.z & 0xffff0000u), __builtin_bit_cast(float, w.w << 16), __builtin_bit_cast(float, w.w & 0xffff0000u)}; }
        r0 += a; r1 += b;
        u4_ q; q.x = pk2(r0[0], r0[1]); q.y = pk2(r0[2], r0[3]); q.z = pk2(r1[0], r1[1]); q.w = pk2(r1[2], r1[3]);
        *(__attribute__((address_space(1))) u4_*)(X + o) = q; } };
#endif
struct EpiMoe1 { static constexpr bool SIDE = false; bf16_t* act; const float* bgu;
    HD void operator()(const Unit& u, int row, int col, const f32x4& v) const { const float* b = bgu + (size_t)u.e * 2048 + col; float r[2];
        for (int q = 0; q < 2; ++q) { float g = v[2 * q] + b[2 * q], up = v[2 * q + 1] + b[2 * q + 1]; g = g < 7.f ? g : 7.f; up = up < -7.f ? -7.f : (up > 7.f ? 7.f : up);
            r[q] = (up + 1.f) * (g * sigmoid_fast(1.702f * g)); }
        *(unsigned*)(act + (size_t)row * 1024 + (col >> 1)) = pk2(r[0], r[1]); } };
struct EpiMoe2 { static constexpr bool SIDE = false; bf16_t* yexp; const float* bdn; const float* rowgate;
    HD void operator()(const Unit& u, int row, int col, const f32x4& v) const { const float* b = bdn + (size_t)u.e * 1024 + col; const float g = rowgate[row];
        st_bf16x4(yexp + (size_t)row * 1024 + col, (v[0] + b[0]) * g, (v[1] + b[1]) * g, (v[2] + b[2]) * g, (v[3] + b[3]) * g); } };

#ifndef HOST_TEST
#define LAS __attribute__((address_space(3)))
__device__ __forceinline__ unsigned f32x2_to_fp8(float a, float b) { return (unsigned)__builtin_amdgcn_cvt_pk_fp8_f32(a, b, 0, false) & 0xffffu; }
constexpr float W8_SCALE = 64.f, W8_INV = 1.f / 64.f;
struct EpiInW { static constexpr bool SIDE = false; bf16_t* z;
    __device__ __forceinline__ void wide(const Unit&, int row, int col, const f32x4& a, const f32x4& b) const { typedef unsigned u4_ __attribute__((ext_vector_type(4))); u4_ w; w.x = pk2(a[0], a[1]); w.y = pk2(a[2], a[3]); w.z = pk2(b[0], b[1]); w.w = pk2(b[2], b[3]);
        if (col < D_IN) *(__attribute__((address_space(1))) u4_*)(z + (size_t)row * D_INP + col) = w; } };
struct EpiGluW { static constexpr bool SIDE = true; bf16_t* yb; const float* b;
    __device__ __forceinline__ void load_side(const Unit& u, LAS unsigned char* sp, int par, int tid) const { if (tid < 256) { const int col = u.pn * 256 + tid; ((LAS float*)(sp + par * 1024))[tid] = b[(col & 1) * 384 + (col >> 1)]; } }
    __device__ __forceinline__ void wide_side(const Unit&, int row, int col, const f32x4& a, const f32x4& c2, LAS unsigned char* sp, int par) const { const LAS float* bp = (const LAS float*)(sp + par * 1024) + (col & 255); const f32x4 b0 = *(const LAS f32x4*)bp, b1 = *(const LAS f32x4*)(bp + 4);
        const float y0 = (a[0] + b0[0]) * sigmoid_fast(a[1] + b0[1]), y1 = (a[2] + b0[2]) * sigmoid_fast(a[3] + b0[3]), y2 = (c2[0] + b1[0]) * sigmoid_fast(c2[1] + b1[1]), y3 = (c2[2] + b1[2]) * sigmoid_fast(c2[3] + b1[3]);
        typedef unsigned u2_ __attribute__((ext_vector_type(2))); u2_ w; w.x = pk2(y0, y1); w.y = pk2(y2, y3); *(__attribute__((address_space(1))) u2_*)(yb + (size_t)row * 384 + (col >> 1)) = w; } };
struct EpiNullW { static constexpr bool SIDE = false; __device__ __forceinline__ void wide(const Unit&, int, int, const f32x4&, const f32x4&) const {} };
struct EpiMoe1F8 { static constexpr bool SIDE = true; unsigned char* act8; const float* bgu;
    __device__ __forceinline__ void load_side(const Unit& u, LAS unsigned char* sp, int par, int tid) const { if (tid < 256) ((LAS float*)(sp + par * 1024))[tid] = bgu[(size_t)u.e * 2048 + u.pn * 256 + tid]; }
    __device__ __forceinline__ void wide_side(const Unit& u, int row, int col, const f32x4& a, const f32x4& c2, LAS unsigned char* sp, int par) const { const LAS float* bp = (const LAS float*)(sp + par * 1024) + (col & 255); const f32x4 b0 = *(const LAS f32x4*)bp, b1 = *(const LAS f32x4*)(bp + 4); float r[4];
#pragma unroll
        for (int q = 0; q < 4; ++q) { float g = (q < 2 ? a[2 * q] : c2[2 * q - 4]) * W8_INV + (q < 2 ? b0[2 * q] : b1[2 * q - 4]), up = (q < 2 ? a[2 * q + 1] : c2[2 * q - 3]) * W8_INV + (q < 2 ? b0[2 * q + 1] : b1[2 * q - 3]);
            g = __builtin_fminf(g, 7.f); up = __builtin_amdgcn_fmed3f(up, -7.f, 7.f); r[q] = (up + 1.f) * (g * __builtin_amdgcn_rcpf(1.f + __builtin_amdgcn_exp2f(g * -2.4554669595930157f))); }
        *(__attribute__((address_space(1))) unsigned*)(act8 + (size_t)row * 1024 + (col >> 1)) = f32x2_to_fp8(r[0], r[1]) | (f32x2_to_fp8(r[2], r[3]) << 16); }
    __device__ __forceinline__ void wide(const Unit& u, int row, int col, const f32x4& a, const f32x4& c2) const { const float* bp = bgu + (size_t)u.e * 2048 + col; const f32x4 b0 = *(const f32x4*)bp, b1 = *(const f32x4*)(bp + 4); float r[4];
#pragma unroll
        for (int q = 0; q < 4; ++q) { float g = (q < 2 ? a[2 * q] : c2[2 * q - 4]) * W8_INV + (q < 2 ? b0[2 * q] : b1[2 * q - 4]), up = (q < 2 ? a[2 * q + 1] : c2[2 * q - 3]) * W8_INV + (q < 2 ? b0[2 * q + 1] : b1[2 * q - 3]);
            g = __builtin_fminf(g, 7.f); up = __builtin_amdgcn_fmed3f(up, -7.f, 7.f); r[q] = (up + 1.f) * (g * __builtin_amdgcn_rcpf(1.f + __builtin_amdgcn_exp2f(g * -2.4554669595930157f))); }
        *(unsigned*)(act8 + (size_t)row * 1024 + (col >> 1)) = f32x2_to_fp8(r[0], r[1]) | (f32x2_to_fp8(r[2], r[3]) << 16); }
    __device__ __forceinline__ void operator()(const Unit& u, int row, int col, const f32x4& v) const { const float* b = bgu + (size_t)u.e * 2048 + col; float r[2];
        for (int q = 0; q < 2; ++q) { float g = v[2 * q] * W8_INV + b[2 * q], up = v[2 * q + 1] * W8_INV + b[2 * q + 1]; g = g < 7.f ? g : 7.f; up = up < -7.f ? -7.f : (up > 7.f ? 7.f : up);
            r[q] = (up + 1.f) * (g * sigmoid_fast(1.702f * g)); }
        *(unsigned short*)(act8 + (size_t)row * 1024 + (col >> 1)) = (unsigned short)f32x2_to_fp8(r[0], r[1]); } };
struct EpiMoe2F8 { static constexpr bool SIDE = true; bf16_t* yexp; const float* bdn; const float* rowgate;
    __device__ __forceinline__ void load_side(const Unit& u, LAS unsigned char* sp, int par, int tid) const { if (tid < 256) ((LAS float*)(sp + par * 1024))[tid] = bdn[(size_t)u.e * 1024 + u.pn * 256 + tid]; else ((LAS float*)(sp + 2048 + par * 1024))[tid - 256] = rowgate[u.pm * 256 + tid - 256]; }
    __device__ __forceinline__ void wide_side(const Unit& u, int row, int col, const f32x4& a, const f32x4& c2, LAS unsigned char* sp, int par) const { typedef unsigned u4_ __attribute__((ext_vector_type(4))); const LAS float* bp = (const LAS float*)(sp + par * 1024) + (col & 255); const f32x4 b0 = *(const LAS f32x4*)bp, b1 = *(const LAS f32x4*)(bp + 4);
        const float g = ((const LAS float*)(sp + 2048 + par * 1024))[row & 255];
        u4_ w; w.x = pk2((a[0] * W8_INV + b0[0]) * g, (a[1] * W8_INV + b0[1]) * g); w.y = pk2((a[2] * W8_INV + b0[2]) * g, (a[3] * W8_INV + b0[3]) * g); w.z = pk2((c2[0] * W8_INV + b1[0]) * g, (c2[1] * W8_INV + b1[1]) * g); w.w = pk2((c2[2] * W8_INV + b1[2]) * g, (c2[3] * W8_INV + b1[3]) * g);
        *(__attribute__((address_space(1))) u4_*)(yexp + (size_t)row * 1024 + col) = w; }
    __device__ __forceinline__ void wide(const Unit& u, int row, int col, const f32x4& a, const f32x4& c2) const { typedef unsigned u4_ __attribute__((ext_vector_type(4))); const float* bp = bdn + (size_t)u.e * 1024 + col; const f32x4 b0 = *(const f32x4*)bp, b1 = *(const f32x4*)(bp + 4); const float g = rowgate[row];
        u4_ w; w.x = pk2((a[0] * W8_INV + b0[0]) * g, (a[1] * W8_INV + b0[1]) * g); w.y = pk2((a[2] * W8_INV + b0[2]) * g, (a[3] * W8_INV + b0[3]) * g); w.z = pk2((c2[0] * W8_INV + b1[0]) * g, (c2[1] * W8_INV + b1[1]) * g); w.w = pk2((c2[2] * W8_INV + b1[2]) * g, (c2[3] * W8_INV + b1[3]) * g);
        *(u4_*)(yexp + (size_t)row * 1024 + col) = w; }
    __device__ __forceinline__ void operator()(const Unit& u, int row, int col, const f32x4& v) const { const float* b = bdn + (size_t)u.e * 1024 + col; const float g = rowgate[row];
        st_bf16x4(yexp + (size_t)row * 1024 + col, (v[0] * W8_INV + b[0]) * g, (v[1] * W8_INV + b[1]) * g, (v[2] * W8_INV + b[2]) * g, (v[3] * W8_INV + b[3]) * g); } };
#endif
HD int wmap_row(int mode, int n) { return mode == 0 ? n : (n < 384 ? 2 * n : 2 * (n - 384) + 1); }

#ifndef HOST_TEST
#ifndef LAS
#define LAS __attribute__((address_space(3)))
#endif
#define GAS __attribute__((address_space(1)))
typedef short bf16x8 __attribute__((ext_vector_type(8)));
typedef unsigned v4u __attribute__((ext_vector_type(4)));
constexpr int NWAVES = 8;

namespace pg8 {
constexpr int BM = 256, BK = 64, HALF = 128, HTB = HALF * BK * 2, STAGE_BYTES = 8 * HTB, NXCD = 8, WGM = 8;
__host__ __device__ __forceinline__ int lds_byte(int r, int c) { const int st = (r >> 4) * 2 + (c >> 5), rr = r & 15, cc = c & 31, ob = rr * 64 + cc * 2; return st * 1024 + (ob ^ (((ob >> 9) & 1) << 5)); }
__host__ __device__ __forceinline__ void stage_rc(int b, int& R, int& C) { const int st = b / 1024, sb = b % 1024, swz = sb ^ (((sb >> 9) & 1) << 5); R = (st >> 1) * 16 + swz / 64; C = (st & 1) * 32 + (swz % 64) / 2; }
struct StaticOrder {
    int nM, nN, nwg, G, c;
    __device__ __forceinline__ void init(int nM_, int nN_, int G_, int c_) { nM = nM_; nN = nN_; nwg = nM * nN; G = G_; c = c_; }
    __device__ __forceinline__ bool next(int i, Unit& u) const {
        const long L = (long)i * G + c; if (L >= nwg) return false;
        int wgid = (int)L; { const int q = nwg / NXCD, r = nwg % NXCD, xcd = wgid % NXCD, off = wgid / NXCD; wgid = (xcd < r ? xcd * (q + 1) : r * (q + 1) + (xcd - r) * q) + off; }
        const int nig = WGM * nN, gid = wgid / nig, fm = gid * WGM, gsz = (nM - fm) < WGM ? (nM - fm) : WGM;
        u.pm = fm + ((wgid % nig) % gsz); u.pn = (wgid % nig) / gsz; u.e = 0; return true;
    }
};
struct SchedPlain { StaticOrder so; const char* Bt; size_t tstepB; const int* rowtab;
    __device__ __forceinline__ bool next(int i, Unit& u) const { return so.next(i, u); }
    __device__ __forceinline__ const char* bptr(const Unit& u) const { return Bt + (size_t)u.pn * tstepB; } };
struct SchedMoe { StaticOrder so; const char* Bt; size_t tstepB, estride; const int* rowtab; const int* blke;
    __device__ __forceinline__ bool next(int i, Unit& u) const { if (!so.next(i, u)) return false; u.e = blke[u.pm]; return true; }
    __device__ __forceinline__ const char* bptr(const Unit& u) const { return Bt + (size_t)u.e * estride + (size_t)u.pn * tstepB; } };

__host__ __device__ __forceinline__ int perm32(int rho) { const int n = rho >> 4, i = rho & 15; return 8 * (i >> 2) + 4 * n + (i & 3); }
template <class Epi, class Sched, bool GATHER, bool F8 = false, bool PERM = false>
__device__ __forceinline__ void gemm_phase(LAS unsigned char* lds, const int wave_id, const bf16_t* A, const int K, const Sched& S, const Epi& E) {
    int lane_ = (int)__builtin_amdgcn_mbcnt_hi(~0u, __builtin_amdgcn_mbcnt_lo(~0u, 0u)); asm volatile("" : "+v"(lane_));
    const int wid = wave_id, lane = lane_, tid = wid * 64 + lane, wr = wid >> 2, wc = wid & 3, fr = lane & 15, fq = lane >> 4;
    const int nt = K / BK;
    unsigned voffA[2], voffB[2];
#pragma unroll
    for (int i = 0; i < 2; ++i) { int R, C; stage_rc(tid * 16 + i * 8192, R, C); voffA[i] = (unsigned)(R * K + C) * 2u; const int Rb = PERM ? ((R & ~31) + perm32(R & 31)) : R; voffB[i] = (unsigned)(Rb * K + C) * 2u; }
    const size_t kstep = (size_t)(BK * 2);
    const size_t hstep = (size_t)HALF * K * 2;
    const unsigned ldsw = (unsigned)wid * 1024u;
    const int aoff = lds_byte(wr * 64 + fr, fq * 8), boff = lds_byte(wc * 32 + fr, fq * 8);
#define PG8_SA(b, h) (((b) * 2 + (h)) * HTB)
#define PG8_SB(b, h) ((4 + (b) * 2 + (h)) * HTB)
#define PG8_STAGE(bufoff, gbase, voff) do { _Pragma("unroll") for (int _i = 0; _i < 2; ++_i) \
        __builtin_amdgcn_global_load_lds((const unsigned*)((const char*)(gbase) + (voff)[_i]), (LAS unsigned*)(lds + (bufoff) + ldsw + _i * 8192), 16, 0, 0); } while (0)
#define PG8_LDA(dst, b, h) do { _Pragma("unroll") for (int m = 0; m < 4; ++m) _Pragma("unroll") for (int k = 0; k < 2; ++k) dst[m][k] = *(const LAS bf16x8*)(lds + PG8_SA(b, h) + aoff + m * 2048 + k * 1024); } while (0)
#define PG8_LDB(dst, b, h) do { _Pragma("unroll") for (int n = 0; n < 2; ++n) _Pragma("unroll") for (int k = 0; k < 2; ++k) dst[n][k] = *(const LAS bf16x8*)(lds + PG8_SB(b, h) + boff + n * 2048 + k * 1024); } while (0)
#define PG8_MMA(ai, bj, At, Bt) do { __builtin_amdgcn_s_setprio(1); _Pragma("unroll") for (int m = 0; m < 4; ++m) _Pragma("unroll") for (int n = 0; n < 2; ++n) _Pragma("unroll") for (int k = 0; k < 2; ++k) \
        asm volatile("s_nop 1\n\tv_mfma_f32_16x16x32_bf16 %0, %1, %2, %0" : "+v"(acc[ai][bj][m][n]) : "v"(Bt[n][k]), "v"(At[m][k])); __builtin_amdgcn_s_setprio(0); } while (0)
    typedef int v4i_ __attribute__((ext_vector_type(4))); typedef int v8i_ __attribute__((ext_vector_type(8)));
    int sc1 = 0x7f7f7f7f; asm volatile("" : "+v"(sc1));
#define PG8_MMA8(ai, bj, At, Bt) do { __builtin_amdgcn_s_setprio(1); _Pragma("unroll") for (int m = 0; m < 4; ++m) _Pragma("unroll") for (int n = 0; n < 2; ++n) { \
        const v8i_ a8_ = __builtin_shufflevector(__builtin_bit_cast(v4i_, At[m][0]), __builtin_bit_cast(v4i_, At[m][1]), 0, 1, 2, 3, 4, 5, 6, 7), b8_ = __builtin_shufflevector(__builtin_bit_cast(v4i_, Bt[n][0]), __builtin_bit_cast(v4i_, Bt[n][1]), 0, 1, 2, 3, 4, 5, 6, 7); \
        asm volatile("s_nop 1\n\tv_mfma_scale_f32_16x16x128_f8f6f4 %0, %1, %2, %0, %3, %3 op_sel_hi:[0,0,0]" : "+v"(acc[ai][bj][m][n]) : "v"(b8_), "v"(a8_), "v"(sc1)); } __builtin_amdgcn_s_setprio(0); } while (0)
#define PG8_MM(ai, bj, At, Bt) do { if constexpr (F8) PG8_MMA8(ai, bj, At, Bt); else PG8_MMA(ai, bj, At, Bt); } while (0)
#define PG8_WAIT_V(n) asm volatile("s_waitcnt vmcnt(" #n ")" ::: "memory")
#define PG8_WAIT_L(n) asm volatile("s_waitcnt lgkmcnt(" #n ")" ::: "memory")
#define PG8_BAR __builtin_amdgcn_s_barrier()
#define PG8_SCHED __builtin_amdgcn_sched_barrier(0)
#define PG8_ROWS(u, dst) do { _Pragma("unroll") for (int h = 0; h < 2; ++h) _Pragma("unroll") for (int i = 0; i < 2; ++i) { int R, C; stage_rc(tid * 16 + i * 8192, R, C); \
        const int rix = S.rowtab[(u).pm * BM + h * HALF + R]; dst[h][i] = (unsigned)rix * (unsigned)(K * 2) + (unsigned)C * 2u; } } while (0)
#define PG8_STAGE_A(bufoff, h, koff, nx) do { if constexpr (GATHER) { _Pragma("unroll") for (int _i = 0; _i < 2; ++_i) \
            __builtin_amdgcn_global_load_lds((const unsigned*)((const char*)A + (koff) + ((nx) ? vn[h][_i] : vc[h][_i])), (LAS unsigned*)(lds + (bufoff) + ldsw + _i * 8192), 16, 0, 0); } \
        else { const char* _b = ((nx) ? nA : cA) + (h) * hstep + (koff); _Pragma("unroll") for (int _i = 0; _i < 2; ++_i) \
            __builtin_amdgcn_global_load_lds((const unsigned*)(_b + voffA[_i]), (LAS unsigned*)(lds + (bufoff) + ldsw + _i * 8192), 16, 0, 0); } } while (0)
    Unit cur, nxt; int ui = 0;
    if (!S.next(0, cur)) return;
    if constexpr (Epi::SIDE) E.load_side(cur, lds + STAGE_BYTES, 0, tid);
    f32x4 acc[2][2][4][2];
#pragma unroll
    for (int a = 0; a < 2; ++a)
#pragma unroll
        for (int b = 0; b < 2; ++b)
#pragma unroll
            for (int m = 0; m < 4; ++m)
#pragma unroll
                for (int n = 0; n < 2; ++n) acc[a][b][m][n] = (f32x4){0.f, 0.f, 0.f, 0.f};
    bf16x8 At[4][2], B0[2][2], B1[2][2];
    unsigned vc[2][2], vn[2][2];
    const size_t tstepA = 2 * hstep;
    const char* cA = (const char*)A; const char* nA = cA;
    if constexpr (GATHER) { PG8_ROWS(cur, vc); } else { cA = (const char*)A + (size_t)cur.pm * tstepA; }
    const char* cB = S.bptr(cur);
    PG8_STAGE(PG8_SB(0, 0), cB, voffB); PG8_STAGE_A(PG8_SA(0, 0), 0, 0, false); PG8_STAGE(PG8_SB(0, 1), cB + hstep, voffB); PG8_STAGE_A(PG8_SA(0, 1), 1, 0, false);
    if (wr == 1) PG8_BAR;
    PG8_WAIT_V(4); PG8_BAR;
    PG8_STAGE(PG8_SB(1, 0), cB + kstep, voffB); PG8_STAGE_A(PG8_SA(1, 0), 0, kstep, false); PG8_STAGE(PG8_SB(1, 1), cB + hstep + kstep, voffB);
    PG8_WAIT_V(6); PG8_BAR;
    for (;;) {
        const bool has_next = S.next(ui + 1, nxt);
        if constexpr (GATHER) {
            if (has_next) { PG8_ROWS(nxt, vn); } else {
#pragma unroll
                for (int h = 0; h < 2; ++h)
#pragma unroll
                    for (int i = 0; i < 2; ++i) vn[h][i] = vc[h][i]; }
        } else { nA = has_next ? (const char*)A + (size_t)nxt.pm * tstepA : cA; }
        const char* nB = has_next ? S.bptr(nxt) : cB;
        for (int t = 0; t < nt; t += 2) {
            const bool last = (t == nt - 2);
            const size_t k1 = (size_t)(t + 1) * kstep, k2 = last ? 0 : (size_t)(t + 2) * kstep, k3 = k2 + kstep;
            const char* b2 = last ? nB : cB + (size_t)(t + 2) * kstep; const char* b3 = b2 + kstep;
            PG8_LDB(B0, 0, 0); PG8_SCHED; PG8_LDA(At, 0, 0); PG8_STAGE_A(PG8_SA(1, 1), 1, k1, false);
            PG8_WAIT_L(8); PG8_BAR; PG8_WAIT_L(0); PG8_MM(0, 0, At, B0); PG8_BAR; PG8_SCHED;
            PG8_LDB(B1, 0, 1); PG8_STAGE(PG8_SB(0, 0), b2, voffB);
            PG8_BAR; PG8_WAIT_L(0); PG8_MM(0, 1, At, B1); PG8_BAR;
            PG8_LDA(At, 0, 1); PG8_STAGE_A(PG8_SA(0, 0), 0, k2, last);
            PG8_BAR; PG8_WAIT_L(0); PG8_MM(1, 0, At, B0); PG8_BAR; PG8_SCHED;
            PG8_STAGE(PG8_SB(0, 1), b2 + hstep, voffB);
            PG8_WAIT_V(6); PG8_BAR; PG8_MM(1, 1, At, B1); PG8_BAR;
            PG8_LDB(B0, 1, 0); PG8_SCHED; PG8_LDA(At, 1, 0); PG8_STAGE_A(PG8_SA(0, 1), 1, k2, last);
            PG8_WAIT_L(8); PG8_BAR; PG8_WAIT_L(0); PG8_MM(0, 0, At, B0); PG8_BAR; PG8_SCHED;
            PG8_LDB(B1, 1, 1); PG8_STAGE(PG8_SB(1, 0), b3, voffB);
            PG8_BAR; PG8_WAIT_L(0); PG8_MM(0, 1, At, B1); PG8_BAR;
            PG8_LDA(At, 1, 1); PG8_STAGE_A(PG8_SA(1, 0), 0, k3, last);
            PG8_BAR; PG8_WAIT_L(0); PG8_MM(1, 0, At, B0); PG8_BAR; PG8_SCHED;
            PG8_STAGE(PG8_SB(1, 1), b3 + hstep, voffB);
            PG8_WAIT_V(6); PG8_BAR; PG8_MM(1, 1, At, B1); PG8_BAR;
        }
        asm volatile("s_nop 15\n\ts_nop 15" : "+v"(acc[0][0][0][0]), "+v"(acc[1][1][3][1]));
        Unit eu; eu.pm = __builtin_amdgcn_readfirstlane(cur.pm); eu.pn = __builtin_amdgcn_readfirstlane(cur.pn); eu.e = __builtin_amdgcn_readfirstlane(cur.e); int rbase = wr * 64 + fr, cbase = wc * 32 + 4 * fq;
        asm volatile("" : "+s"(eu.pm), "+s"(eu.pn), "+s"(eu.e), "+v"(rbase), "+v"(cbase));
#pragma unroll
        for (int ai = 0; ai < 2; ++ai)
#pragma unroll
            for (int m = 0; m < 4; ++m) { const int row = eu.pm * BM + ai * HALF + m * 16 + rbase;
                if constexpr (PERM) {
#pragma unroll
                    for (int bj = 0; bj < 2; ++bj) { if constexpr (Epi::SIDE) E.wide_side(eu, row, eu.pn * BM + bj * HALF + 2 * cbase - (cbase & ~31), acc[ai][bj][m][0], acc[ai][bj][m][1], lds + STAGE_BYTES, ui & 1);
                        else E.wide(eu, row, eu.pn * BM + bj * HALF + 2 * cbase - (cbase & ~31), acc[ai][bj][m][0], acc[ai][bj][m][1]);
                        if constexpr (Epi::SIDE) asm volatile("" ::: "memory"); }
                } else {
#pragma unroll
                for (int bj = 0; bj < 2; ++bj)
#pragma unroll
                    for (int n = 0; n < 2; ++n) E(eu, row, eu.pn * BM + bj * HALF + n * 16 + cbase, acc[ai][bj][m][n]);
                }
                asm volatile("" ::: "memory"); }
        if (!has_next) break;
#pragma unroll
        for (int a = 0; a < 2; ++a)
#pragma unroll
            for (int b = 0; b < 2; ++b)
#pragma unroll
                for (int m = 0; m < 4; ++m)
#pragma unroll
                    for (int n = 0; n < 2; ++n) acc[a][b][m][n] = (f32x4){0.f, 0.f, 0.f, 0.f};
        cur = nxt; cB = nB; cA = nA; ++ui;
        if constexpr (Epi::SIDE) { int tid_s = tid; asm volatile("" : "+v"(tid_s)); E.load_side(cur, lds + STAGE_BYTES, ui & 1, tid_s); }
        if constexpr (GATHER) {
#pragma unroll
            for (int h = 0; h < 2; ++h)
#pragma unroll
                for (int i = 0; i < 2; ++i) vc[h][i] = vn[h][i]; }
    }
    PG8_WAIT_V(0);
    if (wr == 0) PG8_BAR;
    PG8_BAR;
#undef PG8_SA
#undef PG8_SB
#undef PG8_STAGE
#undef PG8_LDA
#undef PG8_LDB
#undef PG8_MMA
#undef PG8_MMA8
#undef PG8_MM
#undef PG8_WAIT_V
#undef PG8_WAIT_L
#undef PG8_BAR
#undef PG8_SCHED
#undef PG8_ROWS
#undef PG8_STAGE_A
}
}

#define XB_TMO      128
#define XB_XCNT(j)  (256  + 64 * (j))
#define XB_XSUB(j)  (1280 + 64 * (j))
#define XB_XGEN(j)  (2304 + 64 * (j))
#define XB_TOP      3328
#define XB_TOPGEN   3392
#define XCD_BAR_WORDS 3456
#define XB_SPIN_CAP (1u << 18)
__device__ __forceinline__ unsigned xb_ld(unsigned* p)              { return __hip_atomic_load(p, __ATOMIC_RELAXED, __HIP_MEMORY_SCOPE_AGENT); }
__device__ __forceinline__ unsigned xb_add(unsigned* p, unsigned v) { return __hip_atomic_fetch_add(p, v, __ATOMIC_RELAXED, __HIP_MEMORY_SCOPE_AGENT); }
__device__ __forceinline__ unsigned xb_xcc_id() { return (unsigned)__builtin_amdgcn_s_getreg((3 << 11) | 20) & 0xFu; }
#define XB_SPIN(cond, bar) do { unsigned _sp = 0; while (cond) { __builtin_amdgcn_s_sleep(1); \
    if ((++_sp & 255u) == 0u) { if (xb_ld(&(bar)[XB_TMO])) break; if (_sp > XB_SPIN_CAP) { atomicAdd(&(bar)[XB_TMO], 1u); break; } } } } while (0)
struct XcdBarrier { unsigned* bar; unsigned x; volatile LAS unsigned* st; };
__device__ __forceinline__ XcdBarrier xcd_barrier_post(unsigned* bar, volatile LAS unsigned* st) {
    XcdBarrier b; b.bar = bar; b.x = xb_xcc_id(); b.st = st;
    if (threadIdx.x == 0) (void)xb_add(&bar[XB_XCNT(b.x)], 1u);
    return b;
}
__device__ __forceinline__ void xcd_barrier_complete(unsigned* bar, unsigned x, unsigned& nloc, unsigned& nx) {
    const unsigned G = gridDim.x * gridDim.y * gridDim.z;
    unsigned sum, cnt, mine, sp = 0u;
    for (;;) {
        sum = 0u; cnt = 0u; mine = 0u;
#pragma unroll
        for (unsigned j = 0; j < 16; ++j) { const unsigned c = xb_ld(&bar[XB_XCNT(j)]); sum += c; cnt += (c > 0u) ? 1u : 0u; mine = (j == x) ? c : mine; }
        if (sum == G) break;
        __builtin_amdgcn_s_sleep(1);
        if ((++sp & 255u) == 0u) { if (xb_ld(&bar[XB_TMO])) break; if (sp > XB_SPIN_CAP) { atomicAdd(&bar[XB_TMO], 1u); break; } }
    }
    nloc = mine > 0u ? mine : 1u; nx = cnt > 0u ? cnt : 1u;
}
__device__ __forceinline__ void xcd_barrier(const XcdBarrier& b, const bool leader) {
    asm volatile("s_waitcnt vmcnt(0)" ::: "memory");
    __syncthreads();
    if (leader) {
        unsigned* bar = b.bar;
        __builtin_amdgcn_s_waitcnt(0);
        unsigned nloc = b.st[0], nx = b.st[1];
        if (nloc == 0u) { xcd_barrier_complete(bar, b.x, nloc, nx); b.st[0] = nloc; b.st[1] = nx; }
        const unsigned old = xb_add(&bar[XB_XSUB(b.x)], 1u);
        const unsigned gen = old / nloc;
        if (old + 1u == (gen + 1u) * nloc) {
            __builtin_amdgcn_fence(__ATOMIC_RELEASE, "agent");
            asm volatile("s_waitcnt vmcnt(0)" ::: "memory");
            const unsigned og = xb_add(&bar[XB_TOP], 1u);
            const unsigned tg = og / nx;
            if (og + 1u == (tg + 1u) * nx) xb_add(&bar[XB_TOPGEN], 1u);
            else XB_SPIN(xb_ld(&bar[XB_TOPGEN]) == tg, bar);
            __builtin_amdgcn_fence(__ATOMIC_ACQUIRE, "agent");
            xb_add(&bar[XB_XGEN(b.x)], 1u);
            asm volatile("s_waitcnt vmcnt(0)" ::: "memory");
        } else {
            XB_SPIN(xb_ld(&bar[XB_XGEN(b.x)]) == gen, bar);
            __builtin_amdgcn_fence(__ATOMIC_ACQUIRE, "agent");
            asm volatile("s_waitcnt vmcnt(0)" ::: "memory");
        }
    }
    __syncthreads();
}

constexpr int RING_BYTES = 131072, LDSCTL_OFF = 143616, LDS_BYTES = 147456;

__device__ __forceinline__ void transpose_item(const float* W, int K, int N, bf16_t* WT, int mode, const float* scale, LAS float* scr, int item, int lane) {
    const int nblk = N / 64, kb = item / nblk, nb = item % nblk, k0 = 64 * kb, n0 = 64 * nb;
    const int n4 = (lane & 15) * 4, kr = lane >> 4;
#pragma unroll 8
    for (int i = 0; i < 16; ++i) { const int kk = 4 * i + kr; f32x4 w = __builtin_nontemporal_load((const __attribute__((address_space(1))) f32x4*)(W + (size_t)(k0 + kk) * N + n0 + n4)); if (scale) w = w * *(const __attribute__((address_space(1))) float*)(scale + k0 + kk);
        scr[kk * 65 + n4] = w[0]; scr[kk * 65 + n4 + 1] = w[1]; scr[kk * 65 + n4 + 2] = w[2]; scr[kk * 65 + n4 + 3] = w[3]; }
    asm volatile("s_waitcnt lgkmcnt(0)" ::: "memory");
    const int c = lane & 7;
#pragma unroll
    for (int j = 0; j < 8; ++j) { const int n = (lane >> 3) + 8 * j; const LAS float* s = scr + (8 * c) * 65 + n;
        v4u o; o.x = pk2(s[0 * 65], s[1 * 65]); o.y = pk2(s[2 * 65], s[3 * 65]); o.z = pk2(s[4 * 65], s[5 * 65]); o.w = pk2(s[6 * 65], s[7 * 65]);
        *(__attribute__((address_space(1))) v4u*)(WT + (size_t)wmap_row(mode, n0 + n) * K + k0 + 8 * c) = o; }
    asm volatile("s_waitcnt lgkmcnt(0)" ::: "memory");
}

__device__ __forceinline__ void transpose_item8(const float* W, int K, int N, unsigned char* WT, const float* scale, LAS float* scr, int item, int lane) {
    const int nblk = N / 64, kb = item / nblk, nb = item % nblk, k0 = 64 * kb, n0 = 64 * nb;
    const int n4 = (lane & 15) * 4, kr = lane >> 4;
#pragma unroll 8
    for (int i = 0; i < 16; ++i) { const int kk = 4 * i + kr; f32x4 w = __builtin_nontemporal_load((const __attribute__((address_space(1))) f32x4*)(W + (size_t)(k0 + kk) * N + n0 + n4)); w = w * (scale ? *(const __attribute__((address_space(1))) float*)(scale + k0 + kk) * W8_SCALE : W8_SCALE);
        scr[kk * 65 + n4] = w[0]; scr[kk * 65 + n4 + 1] = w[1]; scr[kk * 65 + n4 + 2] = w[2]; scr[kk * 65 + n4 + 3] = w[3]; }
    asm volatile("s_waitcnt lgkmcnt(0)" ::: "memory");
    const int c = lane & 3;
#pragma unroll
    for (int j = 0; j < 4; ++j) { const int n = (lane >> 2) + 16 * j; const LAS float* s = scr + (16 * c) * 65 + n; v4u o;
        o.x = f32x2_to_fp8(s[0 * 65], s[1 * 65]) | (f32x2_to_fp8(s[2 * 65], s[3 * 65]) << 16); o.y = f32x2_to_fp8(s[4 * 65], s[5 * 65]) | (f32x2_to_fp8(s[6 * 65], s[7 * 65]) << 16);
        o.z = f32x2_to_fp8(s[8 * 65], s[9 * 65]) | (f32x2_to_fp8(s[10 * 65], s[11 * 65]) << 16); o.w = f32x2_to_fp8(s[12 * 65], s[13 * 65]) | (f32x2_to_fp8(s[14 * 65], s[15 * 65]) << 16);
        *(__attribute__((address_space(1))) v4u*)(WT + (size_t)(n0 + n) * K + k0 + 16 * c) = o; }
    asm volatile("s_waitcnt lgkmcnt(0)" ::: "memory");
}

template <class CT>
__device__ __forceinline__ void router_logits16(const CT& c, int l, int t0, int lane, LAS float* lgs) {
    const int fr = lane & 15, fq = lane >> 4;
    const bf16_t* xa = (const bf16_t*)c.X() + (size_t)(t0 + fr) * D + 8 * fq;
    const bf16_t* wh = (const bf16_t*)c.rwt() + ((size_t)(l * 2) * NE + fr) * 1024 + 8 * fq;
    f32x4 acc0 = (f32x4){0.f, 0.f, 0.f, 0.f}, acc1 = (f32x4){0.f, 0.f, 0.f, 0.f};
#pragma unroll 8
    for (int ks = 0; ks < 32; ++ks) {
        const bf16x8 a = *(const bf16x8*)(xa + 32 * ks);
        const bf16x8 bh0 = *(const bf16x8*)(wh + 32 * ks), bh1 = *(const bf16x8*)(wh + 16 * 1024 + 32 * ks), bl0 = *(const bf16x8*)(wh + NE * 1024 + 32 * ks), bl1 = *(const bf16x8*)(wh + (NE + 16) * 1024 + 32 * ks);
        asm volatile("s_nop 1\n\tv_mfma_f32_16x16x32_bf16 %0, %1, %2, %0" : "+v"(acc0) : "v"(a), "v"(bh0));
        asm volatile("s_nop 1\n\tv_mfma_f32_16x16x32_bf16 %0, %1, %2, %0" : "+v"(acc1) : "v"(a), "v"(bh1));
        asm volatile("s_nop 1\n\tv_mfma_f32_16x16x32_bf16 %0, %1, %2, %0" : "+v"(acc0) : "v"(a), "v"(bl0));
        asm volatile("s_nop 1\n\tv_mfma_f32_16x16x32_bf16 %0, %1, %2, %0" : "+v"(acc1) : "v"(a), "v"(bl1)); }
    asm volatile("s_nop 15\n\ts_nop 15" : "+v"(acc0), "+v"(acc1));
#pragma unroll
    for (int j = 0; j < 4; ++j) { lgs[(4 * fq + j) * 32 + fr] = acc0[j]; lgs[(4 * fq + j) * 32 + 16 + fr] = acc1[j]; }
    asm volatile("s_waitcnt lgkmcnt(0)" ::: "memory");
}

constexpr int RB = 4;
template <class CT>
__device__ __forceinline__ void router_rows(const CT& c, int l, int t0, int lane, LAS int* park, const LAS float* lgs, const bool dummy = false) {
    float rstd_r[RB];
#pragma unroll
    for (int r = 0; r < RB; ++r) { const bf16_t* xr = (const bf16_t*)c.X() + (size_t)(t0 + r) * D; float ss = 0.f; f32x4 v[4];
#pragma unroll
        for (int j = 0; j < 4; ++j) { const uint2 xw_ = *(const uint2*)(xr + 4 * lane + 256 * j);
            v[j] = (f32x4){__builtin_bit_cast(float, xw_.x << 16), __builtin_bit_cast(float, xw_.x & 0xffff0000u), __builtin_bit_cast(float, xw_.y << 16), __builtin_bit_cast(float, xw_.y & 0xffff0000u)}; ss += v[j][0] * v[j][0] + v[j][1] * v[j][1] + v[j][2] * v[j][2] + v[j][3] * v[j][3]; }
        const float rstd = 1.f / sqrtf(wsum(ss) * (1.f / D) + EPS); rstd_r[r] = rstd;
        unsigned char* orow = (dummy ? (unsigned char*)c.yexp() : c.hq()) + (size_t)(t0 + r) * D;
#pragma unroll
        for (int j = 0; j < 4; ++j) { v[j] = v[j] * rstd; *(unsigned*)(orow + 4 * lane + 256 * j) = f32x2_to_fp8(v[j][0], v[j][1]) | (f32x2_to_fp8(v[j][2], v[j][3]) << 16); } }
    float lg[RB];
#pragma unroll
    for (int r = 0; r < RB; ++r) lg[r] = lgs[r * 32 + (lane & 7) * 4 + (lane >> 4)] * rstd_r[r];
    const int e = (lane & 7) * 4 + (lane >> 4);
    const float rb = c.in[I_RB][l * NE + e];
#pragma unroll
    for (int r = 0; r < RB; ++r) { const int t = t0 + r;
        const float lgr = lg[r] + rb;
        unsigned ub = __builtin_bit_cast(unsigned, lgr); ub ^= (ub >> 31) ? 0xffffffffu : 0x80000000u;
        unsigned long long key = ((unsigned long long)ub << 32) | (unsigned)(31 - e);
        int se[4]; float sv[4];
#pragma unroll
        for (int q = 0; q < 4; ++q) { unsigned long long m = key;
#pragma unroll
            for (int o = 1; o < 64; o <<= 1) { const unsigned long long qq = __shfl_xor(m, o); m = qq > m ? qq : m; }
            const int we = 31 - (int)(m & 31u); unsigned wb = (unsigned)(m >> 32); wb ^= (wb >> 31) ? 0x80000000u : 0xffffffffu;
            se[q] = we; sv[q] = __builtin_bit_cast(float, wb); if (e == we) key = 0ull; }
        const float mx = sv[0]; float ex[4], sum = 0.f;
#pragma unroll
        for (int q = 0; q < 4; ++q) { ex[q] = __builtin_amdgcn_exp2f((sv[q] - mx) * 1.4426950408889634f); sum += ex[q]; }
        const float rsum = __builtin_amdgcn_rcpf(sum);
        if (lane == 0) {
#pragma unroll
            for (int q = 0; q < 4; ++q) { if (!dummy) { c.tke()[t * 4 + q] = se[q]; c.tkg()[t * 4 + q] = ex[q] * rsum; } park[r * 4 + q] = se[q]; } }
    }
}

constexpr int S5_PITCH = 272, S5_ROWS = 33, S5_LDS_WAVE = 2 * S5_ROWS * S5_PITCH;
template <bool FINAL, class CT>
__device__ __forceinline__ void s5_tile_dev(const CT& c, const int l, const int tile, const int g, LAS unsigned char* sl, const int lane) {
    const int fr = lane & 15, fq = lane >> 4;
    const int b = tile / NT, ct = tile % NT, t0 = b * SEQ + ct * LC;
    bf16x8 uf[2][2];
#pragma unroll
    for (int m = 0; m < 2; ++m)
#pragma unroll
        for (int ks = 0; ks < 2; ++ks) uf[m][ks] = *(const bf16x8*)(c.z() + (size_t)(t0 + 4 * (16 * m + fr) + 2 * ks + (fq >> 1)) * D_INP + 256 + 16 * g + 8 * (fq & 1));
#pragma unroll
    for (int dir = 0; dir < 2; ++dir) {
        f32x4 acc[2][8];
#pragma unroll
        for (int m = 0; m < 2; ++m)
#pragma unroll
            for (int nt = 0; nt < 8; ++nt) acc[m][nt] = (f32x4){0.f, 0.f, 0.f, 0.f};
        const bf16_t* w = c.w4t() + (size_t)((l * 24 + g) * 2 + dir) * 128 * 64;
#pragma unroll
        for (int ks = 0; ks < 2; ++ks)
#pragma unroll
            for (int nt = 0; nt < 8; ++nt) { const bf16x8 wf = *(const bf16x8*)(w + (16 * nt + fr) * 64 + 32 * ks + 8 * fq);
#pragma unroll
                for (int m = 0; m < 2; ++m) asm volatile("s_nop 1\n\tv_mfma_f32_16x16x32_bf16 %0, %1, %2, %0" : "+v"(acc[m][nt]) : "v"(wf), "v"(uf[m][ks])); }
        asm volatile("s_nop 15\n\ts_nop 15\n\ts_nop 15\n\ts_nop 15" : "+v"(acc[0][0]), "+v"(acc[0][1]), "+v"(acc[0][2]), "+v"(acc[0][3]), "+v"(acc[0][4]), "+v"(acc[0][5]), "+v"(acc[0][6]), "+v"(acc[0][7]),
                                               "+v"(acc[1][0]), "+v"(acc[1][1]), "+v"(acc[1][2]), "+v"(acc[1][3]), "+v"(acc[1][4]), "+v"(acc[1][5]), "+v"(acc[1][6]), "+v"(acc[1][7]));
#pragma unroll
        for (int m = 0; m < 2; ++m)
#pragma unroll
            for (int nt = 0; nt < 8; ++nt) { const int row = 16 * m + fr + (dir ? 0 : 1);
                unsigned lo = pk2(acc[m][nt][0], acc[m][nt][1]), hi = pk2(acc[m][nt][2], acc[m][nt][3]);
                *(LAS unsigned long long*)(sl + (dir * S5_ROWS + row) * S5_PITCH + (16 * nt + 4 * fq) * 2) = (unsigned long long)lo | ((unsigned long long)hi << 32); }
    }
    asm volatile("s_waitcnt lgkmcnt(0)" ::: "memory");
    {
        const int p = lane;
#pragma unroll
        for (int dir = 0; dir < 2; ++dir) {
            const int ci = ((l * 2 + dir) * 24 + g) * 64 + p;
            const float a4r = c.s5pow()[(size_t)ci * 8], a4i = c.s5pow()[(size_t)ci * 8 + 1];
            const size_t io = ((size_t)(b * NT + ct) * 3072 + dir * 1536 + g * 64 + p) * 2;
            float sr = 0.f, si = 0.f;
            LAS bf16_t* base = (LAS bf16_t*)(sl + dir * S5_ROWS * S5_PITCH);
            if (FINAL) { const float2 cin = *(const float2*)(c.s5in() + io); sr = cin.x; si = cin.y;
                const int crow = dir ? 32 : 0; base[crow * (S5_PITCH / 2) + p] = (bf16_t)f2bf(sr); base[crow * (S5_PITCH / 2) + 64 + p] = (bf16_t)f2bf(si); }
#pragma unroll 8
            for (int q = 0; q < 32; ++q) { const int row = dir ? 31 - q : q + 1;
                const float gr = bf2f(base[row * (S5_PITCH / 2) + p]), gi = bf2f(base[row * (S5_PITCH / 2) + 64 + p]);
                const float nr = a4r * sr - a4i * si + gr, ni = a4r * si + a4i * sr + gi; sr = nr; si = ni;
                if (FINAL) { base[row * (S5_PITCH / 2) + p] = (bf16_t)f2bf(sr); base[row * (S5_PITCH / 2) + 64 + p] = (bf16_t)f2bf(si); } }
            if (!FINAL) { float2 e2; e2.x = sr; e2.y = si; *(float2*)(c.s5e() + io) = e2; }
        }
    }
    if (FINAL) {
        asm volatile("s_waitcnt lgkmcnt(0)" ::: "memory");
        f32x4 ya[4][2];
#pragma unroll
        for (int mj = 0; mj < 4; ++mj)
#pragma unroll
            for (int nt = 0; nt < 2; ++nt) ya[mj][nt] = (f32x4){0.f, 0.f, 0.f, 0.f};
        const bf16_t* ym = c.ymat() + (size_t)(l * 24 + g) * 64 * 320;
#pragma unroll
        for (int ks = 0; ks < 10; ++ks) {
            bf16x8 af[4], bfr[2];
#pragma unroll
            for (int mj = 0; mj < 4; ++mj) af[mj] = *(const bf16x8*)(ym + (16 * mj + fr) * 320 + 32 * ks + 8 * fq);
#pragma unroll
            for (int nt = 0; nt < 2; ++nt) { if (ks < 4) bfr[nt] = *(const LAS bf16x8*)(sl + (16 * nt + fr) * S5_PITCH + (32 * ks + 8 * fq) * 2);
                else if (ks < 8) bfr[nt] = *(const LAS bf16x8*)(sl + (S5_ROWS + 16 * nt + fr + 1) * S5_PITCH + (32 * (ks - 4) + 8 * fq) * 2);
                else bfr[nt] = uf[nt][ks - 8]; }
#pragma unroll
            for (int mj = 0; mj < 4; ++mj)
#pragma unroll
                for (int nt = 0; nt < 2; ++nt) asm volatile("s_nop 1\n\tv_mfma_f32_16x16x32_bf16 %0, %1, %2, %0" : "+v"(ya[mj][nt]) : "v"(af[mj]), "v"(bfr[nt]));
        }
        asm volatile("s_nop 15\n\ts_nop 15\n\ts_nop 15\n\ts_nop 15" : "+v"(ya[0][0]), "+v"(ya[0][1]), "+v"(ya[1][0]), "+v"(ya[1][1]), "+v"(ya[2][0]), "+v"(ya[2][1]), "+v"(ya[3][0]), "+v"(ya[3][1]));
#pragma unroll
        for (int mj = 0; mj < 4; ++mj)
#pragma unroll
            for (int nt = 0; nt < 2; ++nt) { const f32x4 y = ya[mj][nt];
                st_bf16x4(c.v() + (size_t)(t0 + 4 * (16 * nt + fr) + mj) * 384 + 16 * g + 4 * fq, gelu_tanh(y[0]), gelu_tanh(y[1]), gelu_tanh(y[2]), gelu_tanh(y[3])); }
    }
    asm volatile("s_waitcnt lgkmcnt(0)" ::: "memory");
}

#define MFMA16(acc_, a_, b_) asm volatile("s_nop 1\n\tv_mfma_f32_16x16x32_bf16 %0, %1, %2, %0" : "+v"(acc_) : "v"(a_), "v"(b_))
#define MFMA_FENCE8(x_) asm volatile("s_nop 15\n\ts_nop 15" : "+v"(x_[0]), "+v"(x_[1]), "+v"(x_[2]), "+v"(x_[3]), "+v"(x_[4]), "+v"(x_[5]), "+v"(x_[6]), "+v"(x_[7]))
template <class CT>
__device__ __forceinline__ void mixer_tile_dev(const CT& c, const int l, const int tile, LAS unsigned char* lds, const int wave, const int lane) {
    const int tid = wave * 64 + lane, fr = lane & 15, fq = lane >> 4;
    const int b = tile / NT, ct = tile % NT, s0 = ct * LC, t0 = b * SEQ + s0;
    {
        LAS bf16_t* dt = (LAS bf16_t*)lds;
        LAS float* ssqp = (LAS float*)(lds + 67584);
        LAS bf16_t* zp = (LAS bf16_t*)(lds + 71680);
#pragma unroll 1
        for (int g4 = 0; g4 < 4; ++g4) {
            { v4u pz[3];
#pragma unroll
              for (int i = 0; i < 3; ++i) { const int p = tid + 512 * i, q = s0 - 8 + (p >> 3);
                  pz[i] = (p < 1152 && q >= 0 && q < SEQ) ? *(const GAS v4u*)(c.z() + (size_t)(b * SEQ + q) * D_INP + g4 * 64 + (p & 7) * 8) : (v4u){0u, 0u, 0u, 0u}; }
#pragma unroll
              for (int i = 0; i < 3; ++i) { const int p = tid + 512 * i; if (p < 1152) *(LAS v4u*)(zp + (p >> 3) * 72 + (p & 7) * 8) = pz[i]; } }
            __syncthreads();
            { const int cc = tid & 63, tq = tid >> 6, half = 1 << g4, tb = tq * 16, sb = s0 + tb;
              int lo = sb - half < 0 ? 0 : sb - half, hi = sb + half > SEQ ? SEQ : sb + half; float sum = 0.f;
              for (int q = lo; q < hi; ++q) sum += bf2f(zp[(q - s0 + 8) * 72 + cc]);
#pragma unroll 4
              for (int t = tb; t < tb + 16; ++t) { const int s = s0 + t;
                  dt[t * 264 + g4 * 64 + cc] = (bf16_t)f2bf(sum * __builtin_amdgcn_rcpf((float)(hi - lo)) - bf2f(zp[(t + 8) * 72 + cc]));
                  const int nlo = s + 1 - half < 0 ? 0 : s + 1 - half, nhi = s + 1 + half > SEQ ? SEQ : s + 1 + half;
                  if (nhi > hi) sum += bf2f(zp[(hi - s0 + 8) * 72 + cc]);
                  if (nlo > lo) sum -= bf2f(zp[(lo - s0 + 8) * 72 + cc]);
                  lo = nlo; hi = nhi; } }
            __syncthreads();
        }
        const int g = wave >> 1, nbase = (wave & 1) * 32;
        f32x4 acc0[8], acc1[8];
#pragma unroll
        for (int m = 0; m < 8; ++m) { acc0[m] = (f32x4){0.f, 0.f, 0.f, 0.f}; acc1[m] = (f32x4){0.f, 0.f, 0.f, 0.f}; }
#pragma unroll
        for (int ks = 0; ks < 2; ++ks) {
            const bf16x8 w0 = *(const bf16x8*)(c.poolw_t() + ((size_t)(l * 4 + g) * 64 + nbase + fr) * 64 + 32 * ks + 8 * fq);
            const bf16x8 w1 = *(const bf16x8*)(c.poolw_t() + ((size_t)(l * 4 + g) * 64 + nbase + 16 + fr) * 64 + 32 * ks + 8 * fq);
#pragma unroll
            for (int m = 0; m < 8; ++m) { const bf16x8 df = *(const LAS bf16x8*)(lds + (16 * m + fr) * 528 + (g * 64 + 32 * ks + 8 * fq) * 2);
                MFMA16(acc0[m], w0, df); MFMA16(acc1[m], w1, df); } }
        MFMA_FENCE8(acc0); MFMA_FENCE8(acc1);
        const int ch0 = g * 64 + nbase + 4 * fq;
        const f32x4 sc0 = *(const f32x4*)(c.in[I_POOLS] + l * 256 + ch0), sc1 = *(const f32x4*)(c.in[I_POOLS] + l * 256 + ch0 + 16);
#pragma unroll
        for (int m = 0; m < 8; ++m) { acc0[m] = acc0[m] * sc0; acc1[m] = acc1[m] * sc1;
            float s = acc0[m][0] * acc0[m][0] + acc0[m][1] * acc0[m][1] + acc0[m][2] * acc0[m][2] + acc0[m][3] * acc0[m][3] + acc1[m][0] * acc1[m][0] + acc1[m][1] * acc1[m][1] + acc1[m][2] * acc1[m][2] + acc1[m][3] * acc1[m][3];
            s += __shfl_xor(s, 16); s += __shfl_xor(s, 32);
            if (fq == 0) ssqp[(16 * m + fr) * 8 + wave] = s; }
        __syncthreads();
#pragma unroll
        for (int m = 0; m < 8; ++m) { const f32x4 pa = *(const LAS f32x4*)(ssqp + (16 * m + fr) * 8), pb = *(const LAS f32x4*)(ssqp + (16 * m + fr) * 8 + 4);
            const float rstd = 1.f / sqrtf(((pa[0] + pa[1]) + (pa[2] + pa[3]) + (pb[0] + pb[1]) + (pb[2] + pb[3])) * (1.f / 256) + EPS);
            bf16_t* orow = c.o() + (size_t)(t0 + 16 * m + fr) * D + ch0;
            st_bf16x4(orow, acc0[m][0] * rstd, acc0[m][1] * rstd, acc0[m][2] * rstd, acc0[m][3] * rstd);
            st_bf16x4(orow + 16, acc1[m][0] * rstd, acc1[m][1] * rstd, acc1[m][2] * rstd, acc1[m][3] * rstd); }
        __syncthreads();
    }
    LAS bf16_t* xcs = (LAS bf16_t*)lds;
    LAS float* As = (LAS float*)(lds + 18432);
    LAS bf16_t* Bs = (LAS bf16_t*)(lds + 88064);
    LAS float* Seg = (LAS float*)(lds + 124928);
    bf16_t tz[17];
#define LRU_SLAB_LOAD(h_) do { int tq_ = tid; asm volatile("" : "+v"(tq_)); _Pragma("unroll") for (int i_ = 0; i_ < 17; ++i_) { const int e2_ = tq_ + 512 * i_, q_ = s0 - 1 + (e2_ >> 6); \
        tz[i_] = ((i_ < 16 || e2_ < 131 * 64) && q_ >= 0 && q_ < SEQ) ? c.z()[(size_t)(b * SEQ + q_) * D_INP + 640 + (h_) * 64 + (e2_ & 63)] : (bf16_t)0; } } while (0)
    LRU_SLAB_LOAD(0);
#pragma unroll 1
    for (int h = 0; h < 6; ++h) {
        int cc; float cb, w0, w1, w2, w3; bf16x8 gwa[2], gwx[2]; f32x4 gba, gbx, glam;
        { LAS bf16_t* zs = (LAS bf16_t*)As;
          { int tq = tid; asm volatile("" : "+v"(tq));
            cc = tq & 63; { const int ch = h * 64 + cc; const float* cwp = c.in[I_CONVW] + l * 4 * 384 + ch; cb = c.in[I_CONVB][l * 384 + ch]; w0 = cwp[0]; w1 = cwp[384]; w2 = cwp[768]; w3 = cwp[1152]; }
            { const bf16_t* wbase = c.lruw_t() + ((size_t)(((l * 2 + (wave >> 2)) * 6 + h) * 2) * 64 + (wave & 3) * 16 + (tq & 15)) * 64 + 8 * ((tq >> 4) & 3);
#pragma unroll
              for (int ks = 0; ks < 2; ++ks) { gwa[ks] = *(const bf16x8*)(wbase + 32 * ks); gwx[ks] = *(const bf16x8*)(wbase + 4096 + 32 * ks); }
              const int pi = (l * 2 + (wave >> 2)) * 384 + h * 64 + (wave & 3) * 16 + 4 * ((tq >> 4) & 3);
              gba = *(const f32x4*)(c.in[I_BA] + pi); gbx = *(const f32x4*)(c.in[I_BX] + pi); glam = *(const f32x4*)((const float*)c.ctl() + SP8_OFF / 4 + pi); }
#pragma unroll
            for (int i = 0; i < 17; ++i) { const int e2 = tq + 512 * i; if (i < 16 || e2 < 131 * 64) zs[(e2 >> 6) * 72 + (e2 & 63)] = tz[i]; } }
          __syncthreads();
#pragma unroll 4
          for (int i = 0; i < 16; ++i) { const int t = (tid >> 6) + 8 * i;
              const float a = cb + w0 * bf2f(zs[t * 72 + cc]) + w1 * bf2f(zs[(t + 1) * 72 + cc]) + w2 * bf2f(zs[(t + 2) * 72 + cc]) + w3 * bf2f(zs[(t + 3) * 72 + cc]);
              xcs[t * 72 + cc] = (bf16_t)f2bf(a); } }
        if (h < 5) LRU_SLAB_LOAD(h + 1);
        __syncthreads();
        {
            const int dir = wave >> 2, c16 = (wave & 3) * 16;
            f32x4 accA[8], accX[8];
#pragma unroll
            for (int m = 0; m < 8; ++m) { accA[m] = (f32x4){0.f, 0.f, 0.f, 0.f}; accX[m] = (f32x4){0.f, 0.f, 0.f, 0.f}; }
#pragma unroll
            for (int ks = 0; ks < 2; ++ks) { const bf16x8 wa = gwa[ks], wx = gwx[ks];
#pragma unroll
                for (int m = 0; m < 8; ++m) { const bf16x8 xf = *(const LAS bf16x8*)(lds + (16 * m + fr) * 144 + (32 * ks + 8 * fq) * 2);
                    MFMA16(accA[m], wa, xf); MFMA16(accX[m], wx, xf); } }
            MFMA_FENCE8(accA); MFMA_FENCE8(accX);
            const int cc0 = c16 + 4 * fq;
            const f32x4 ba = gba, bx = gbx, lam = glam;
            f32x4 sp8;
#pragma unroll
            for (int j = 0; j < 4; ++j) sp8[j] = lam[j];
#pragma unroll
            for (int m = 0; m < 8; ++m) { const int t = 16 * m + fr;
                const unsigned long long xw = *(const LAS unsigned long long*)(lds + t * 144 + cc0 * 2);
                f32x4 av; float btv[4];
#pragma unroll
                for (int j = 0; j < 4; ++j) { const float xcv = bf2f((unsigned)(xw >> (16 * j)) & 0xffffu);
                    const float r = sigmoid_fast(accA[m][j] + ba[j]), ig = sigmoid_fast(accX[m][j] + bx[j]), la = r * sp8[j];
                    av[j] = __builtin_amdgcn_exp2f(1.4426950408889634f * la); btv[j] = __builtin_amdgcn_sqrtf(-expm1_dev(2.f * la, av[j])) * (ig * xcv); }
                *(LAS f32x4*)(As + (dir * 128 + t) * 68 + cc0) = av;
                *(LAS unsigned long long*)(Bs + (dir * 128 + t) * 72 + cc0) = (unsigned long long)pk2(btv[0], btv[1]) | ((unsigned long long)pk2(btv[2], btv[3]) << 32); }
        }
        __syncthreads();
        {
            const int dir = tid >> 8, seg = (tid >> 6) & 3, cc = tid & 63, ch = h * 64 + cc;
            const int tfirst = dir ? 127 - seg * 32 : seg * 32, tstep = dir ? -1 : 1;
            const LAS float* ap = As + (dir * 128 + tfirst) * 68 + cc; const LAS bf16_t* bp = Bs + (dir * 128 + tfirst) * 72 + cc;
            float hh = 0.f, P = 1.f;
#pragma unroll 8
            for (int q = 0; q < 32; ++q) { const float a = ap[q * tstep * 68], bt = bf2f(bp[q * tstep * 72]); hh = a * hh + bt; P *= a; }
            Seg[((dir * 64 + cc) * 4 + seg) * 2] = P; Seg[((dir * 64 + cc) * 4 + seg) * 2 + 1] = hh;
            __syncthreads();
            float carry = 0.f, cpre = 1.f;
#pragma unroll
            for (int s2 = 0; s2 < 3; ++s2) if (s2 < seg) { const float P2 = Seg[((dir * 64 + cc) * 4 + s2) * 2], h2 = Seg[((dir * 64 + cc) * 4 + s2) * 2 + 1]; carry = P2 * carry + h2; cpre *= P2; }
            bf16_t* hp = c.hl() + ((size_t)(t0 + tfirst) * 2 + dir) * 384 + ch; bf16_t* cpp = c.cp() + ((size_t)(t0 + tfirst) * 2 + dir) * 384 + ch;
            hh = carry; P = cpre;
#pragma unroll 4
            for (int q = 0; q < 32; ++q) { const float a = ap[q * tstep * 68], bt = bf2f(bp[q * tstep * 72]); hh = a * hh + bt; P *= a;
                hp[(long)q * tstep * 768] = (bf16_t)f2bf(hh); cpp[(long)q * tstep * 768] = (bf16_t)f2bf(P); }
            if (seg == 3) { float2 pe; pe.x = P; pe.y = hh; *(float2*)(c.lrupe() + ((size_t)(b * NT + ct) * 768 + dir * 384 + ch) * 2) = pe; }
        }
        __syncthreads();
    }
}

template <class CT>
__device__ __forceinline__ void row_mix_norm2_dev(const CT& c, const int t, const int lane) {
    bf16_t* orow = c.o() + (size_t)t * D;
    { const unsigned* yb = (const unsigned*)(c.yb() + (size_t)t * 384); unsigned w[3]; float ss = 0.f;
#pragma unroll
      for (int i = 0; i < 3; ++i) { w[i] = yb[lane + 64 * i]; const float a = bf2f(w[i] & 0xffffu), b2 = bf2f(w[i] >> 16); ss += a * a + b2 * b2; }
      const float rstd = 1.f / sqrtf(wsum(ss) * (1.f / 384) + EPS);
#pragma unroll
      for (int i = 0; i < 3; ++i) ((unsigned*)(orow + 256))[lane + 64 * i] = pk2(bf2f(w[i] & 0xffffu) * rstd, bf2f(w[i] >> 16) * rstd); }
    { const unsigned* hl = (const unsigned*)(c.hl() + (size_t)t * 768); const unsigned* cp = (const unsigned*)(c.cp() + (size_t)t * 768); const unsigned* gz = (const unsigned*)(c.z() + (size_t)t * D_INP + 1024);
      const float2* cin = (const float2*)(c.lruin() + (size_t)((t / SEQ) * NT + (t % SEQ) / LC) * 768);
      float y0[3], y1[3]; float ss = 0.f;
#pragma unroll
      for (int i = 0; i < 3; ++i) { const int k2 = lane + 64 * i; const unsigned hf = hl[k2], hb2 = hl[192 + k2], cf = cp[k2], cb2 = cp[192 + k2], gg = gz[k2]; const float2 nf = cin[k2], nb = cin[192 + k2];
          y0[i] = (bf2f(hf & 0xffffu) + bf2f(cf & 0xffffu) * nf.x + bf2f(hb2 & 0xffffu) + bf2f(cb2 & 0xffffu) * nb.x) * gelu_tanh(bf2f(gg & 0xffffu));
          y1[i] = (bf2f(hf >> 16) + bf2f(cf >> 16) * nf.y + bf2f(hb2 >> 16) + bf2f(cb2 >> 16) * nb.y) * gelu_tanh(bf2f(gg >> 16)); ss += y0[i] * y0[i] + y1[i] * y1[i]; }
      const float rstd = 1.f / sqrtf(wsum(ss) * (1.f / 384) + EPS);
#pragma unroll
      for (int i = 0; i < 3; ++i) ((unsigned*)(orow + 640))[lane + 64 * i] = pk2(y0[i] * rstd, y1[i] * rstd); }
}
template <class CT>
__device__ __forceinline__ void row_combine_dev(const CT& c, const int t, const int lane, const bool last, const bool dummy = false) {
    bf16_t* xr = (bf16_t*)c.X() + (size_t)t * D; float ss = 0.f; bf16_t* xw = dummy ? (bf16_t*)c.out + (size_t)t * D : xr; bf16_t* hbw = dummy ? c.o() : c.hb();
    const int d0 = c.tkd()[t * 4], d1 = c.tkd()[t * 4 + 1], d2 = c.tkd()[t * 4 + 2], d3 = c.tkd()[t * 4 + 3];
    const bf16_t* y0 = c.yexp() + (size_t)d0 * 1024; const bf16_t* y1 = c.yexp() + (size_t)d1 * 1024; const bf16_t* y2 = c.yexp() + (size_t)d2 * 1024; const bf16_t* y3 = c.yexp() + (size_t)d3 * 1024;
    f32x4 v[4];
#pragma unroll
    for (int j = 0; j < 4; ++j) { const int k = 4 * lane + 256 * j; { const uint2 xw_ = *(const uint2*)(xr + k);
            v[j] = (f32x4){__builtin_bit_cast(float, xw_.x << 16), __builtin_bit_cast(float, xw_.x & 0xffff0000u), __builtin_bit_cast(float, xw_.y << 16), __builtin_bit_cast(float, xw_.y & 0xffff0000u)}; }
        const uint2 a = *(const uint2*)(y0 + k), b2 = *(const uint2*)(y1 + k), c2 = *(const uint2*)(y2 + k), e2 = *(const uint2*)(y3 + k);
        v[j][0] += bf2f(a.x & 0xffffu); v[j][0] += bf2f(b2.x & 0xffffu); v[j][0] += bf2f(c2.x & 0xffffu); v[j][0] += bf2f(e2.x & 0xffffu);
        v[j][1] += bf2f(a.x >> 16); v[j][1] += bf2f(b2.x >> 16); v[j][1] += bf2f(c2.x >> 16); v[j][1] += bf2f(e2.x >> 16);
        v[j][2] += bf2f(a.y & 0xffffu); v[j][2] += bf2f(b2.y & 0xffffu); v[j][2] += bf2f(c2.y & 0xffffu); v[j][2] += bf2f(e2.y & 0xffffu);
        v[j][3] += bf2f(a.y >> 16); v[j][3] += bf2f(b2.y >> 16); v[j][3] += bf2f(c2.y >> 16); v[j][3] += bf2f(e2.y >> 16);
        ss += v[j][0] * v[j][0] + v[j][1] * v[j][1] + v[j][2] * v[j][2] + v[j][3] * v[j][3]; }
    const float rstd = 1.f / sqrtf(wsum(ss) * (1.f / D) + EPS);
    if (!last) {
#pragma unroll
        for (int j = 0; j < 4; ++j) { const int k = 4 * lane + 256 * j; { uint2 xo; xo.x = pk2(v[j][0], v[j][1]); xo.y = pk2(v[j][2], v[j][3]); *(uint2*)(xw + k) = xo; } uint2 o; o.x = pk2(v[j][0] * rstd, v[j][1] * rstd); o.y = pk2(v[j][2] * rstd, v[j][3] * rstd); *(uint2*)(hbw + (size_t)t * D + k) = o; }
    } else { const float* fg = c.in[I_FING];
#pragma unroll
        for (int j = 0; j < 4; ++j) { const int k = 4 * lane + 256 * j; const f32x4 g = *(const f32x4*)(fg + k); *(f32x4*)((float*)c.out + (size_t)t * D + k) = v[j] * rstd * g; } }
}

constexpr int NPL = 12, NPH = 1 + DEPTH * NPL;
struct Args { const float* in[32]; float* out; unsigned char* ws; int ph_lo, ph_hi; };

__device__ __forceinline__ void st_route_dev(long gtid, long gs, const Ctx& c, int l, LAS int* pre, int tid) {
    LAS int* cn = pre + 64;
    const unsigned* cnt = c.ctl() + CW_CNT + 32 * l * CNT_STRIDE;
    if (tid < NE) cn[tid] = (int)cnt[tid * CNT_STRIDE];
    __syncthreads();
    if (tid == 0) { int s = 0; for (int q = 0; q < NE; ++q) { pre[q] = s; s += (cn[q] + 255) & ~255; } pre[NE] = s; }
    __syncthreads();
    for (long i = gtid; i < (long)T * 4; i += gs) { const int e = c.tke()[i]; const int d = pre[e] + c.tkp()[i];
        c.tkd()[i] = d; c.rowtok()[d] = (int)(i / 4); c.rowgate()[d] = c.tkg()[i]; }
    const int total = pre[NE];
    for (long r = gtid; r < total; r += gs) { int e = 0;
#pragma unroll
        for (int s2 = 16; s2 > 0; s2 >>= 1) e += (pre[e + s2] <= (int)r) ? s2 : 0;
        if ((int)r - pre[e] >= cn[e]) { c.rowtok()[r] = 0; c.rowgate()[r] = 0.f; }
        if ((r & 255) == 0) c.blke()[r >> 8] = e; }
    if (gtid == 0) c.ctl()[CW_NMB + l] = (unsigned)(total / 256);
}
__device__ __forceinline__ void st_carries_dev(long gtid, long gs, const Ctx& c, int l) {
    constexpr int CB = 16;
    const long tl = gtid % (NWAVES * 64), bx = gtid / (NWAVES * 64), Gn = gs / (NWAVES * 64), first = (tl & 63) + 64 * (bx + Gn * (tl >> 6)), step = 64 * Gn * NWAVES;
    for (long i = first; i < (long)BATCH * 3072; i += step) { const int r = (int)(i % 3072), b = (int)(i / 3072), dir = r / 1536; const int ci = l * 3072 + r;
        const float2 a = *(const float2*)(c.s5a128() + 2 * ci); float sr = 0.f, si = 0.f;
        const float* eb = c.s5e() + ((size_t)(b * NT) * 3072 + r) * 2; float* ib = c.s5in() + ((size_t)(b * NT) * 3072 + r) * 2;
#pragma unroll 1
        for (int q0 = 0; q0 < NT; q0 += CB) { float2 e[CB];
#pragma unroll
            for (int q = 0; q < CB; ++q) { const int ct = dir == 0 ? q0 + q : NT - 1 - q0 - q; e[q] = *(const float2*)(eb + (size_t)ct * 6144); }
#pragma unroll
            for (int q = 0; q < CB; ++q) { const int ct = dir == 0 ? q0 + q : NT - 1 - q0 - q; float2 s2; s2.x = sr; s2.y = si; *(float2*)(ib + (size_t)ct * 6144) = s2;
                const float nr = a.x * sr - a.y * si + e[q].x, ni = a.x * si + a.y * sr + e[q].y; sr = nr; si = ni; } } }
    for (long i = first; i < (long)BATCH * 768; i += step) { const int r = (int)(i % 768), b = (int)(i / 768), dir = r / 384; float h = 0.f;
        const float* pb = c.lrupe() + 2 * ((size_t)(b * NT) * 768 + r); float* hb_ = c.lruin() + (size_t)(b * NT) * 768 + r;
#pragma unroll 1
        for (int q0 = 0; q0 < NT; q0 += CB) { float2 pe[CB];
#pragma unroll
            for (int q = 0; q < CB; ++q) { const int ct = dir == 0 ? q0 + q : NT - 1 - q0 - q; pe[q] = *(const float2*)(pb + (size_t)ct * 1536); }
#pragma unroll
            for (int q = 0; q < CB; ++q) { const int ct = dir == 0 ? q0 + q : NT - 1 - q0 - q; hb_[(size_t)ct * 768] = h; h = pe[q].x * h + pe[q].y; } } }
}
template <class Tp> __device__ __forceinline__ Tp* uniform_ptr(Tp* p) { const unsigned long long v = (unsigned long long)p;
    return (Tp*)(((unsigned long long)(unsigned)__builtin_amdgcn_readfirstlane((int)(v >> 32)) << 32) | (unsigned)__builtin_amdgcn_readfirstlane((int)v)); }
template <int PH>
__device__ __forceinline__ void run_phase(const Ctx& c0, LAS unsigned char* lds, const int wave, const int G) {
    int lane_o = (int)__builtin_amdgcn_mbcnt_hi(~0u, __builtin_amdgcn_mbcnt_lo(~0u, 0u)); asm volatile("" : "+v"(lane_o));
    const int lane = lane_o, tid_o = wave * 64 + lane_o; const long gtid = (long)blockIdx.x * (NWAVES * 64) + tid_o, gs = (long)G * (NWAVES * 64);
    const int gw = blockIdx.x * NWAVES + wave, NGW = G * NWAVES;
    Ctx c = c0; { unsigned long long a_ = (unsigned long long)c0.ws, b_ = (unsigned long long)c0.out, d_ = (unsigned long long)c0.in; asm volatile("" : "+s"(a_), "+s"(b_), "+s"(d_));
        c.ws = (unsigned char*)a_; c.out = (float*)b_; c.in = (const float* const*)d_; }
#ifndef GSEL
#define GSEL 0x1Fu
#endif
    const CtxG cg(c);
    if constexpr (PH == 0) {
        LAS float* scr = (LAS float*)(lds + wave * 16640);
        constexpr int I_IN = 16 * 22, I_GLU = 6 * 12, I_OUT = 16 * 16, I_GU = 16 * 32, I_DN = 16 * 16;
        constexpr int NITEMS = 2 * (I_IN + I_GLU + I_OUT) + 64 * (I_GU + I_DN);
        for (int it = gw; it < NITEMS; it += NGW) { int r = it;
            if (r < 2 * I_IN) { const int l = r / I_IN; transpose_item(c.in[I_WIN] + (size_t)l * D * D_IN, D, D_IN, c.win_t() + (size_t)l * D_INP * D, 0, c.in[I_N1G] + l * D, scr, r % I_IN, lane); continue; } r -= 2 * I_IN;
            if (r < 2 * I_GLU) { const int l = r / I_GLU; transpose_item(c.in[I_WGLU] + (size_t)l * 384 * 768, 384, 768, c.wglu_t() + (size_t)l * 768 * 384, 1, nullptr, scr, r % I_GLU, lane); continue; } r -= 2 * I_GLU;
            if (r < 2 * I_OUT) { const int l = r / I_OUT; transpose_item(c.in[I_WOUT] + (size_t)l * D * D, D, D, c.wout_t() + (size_t)l * D * D, 0, c.in[I_MIXG] + l * D, scr, r % I_OUT, lane); continue; } r -= 2 * I_OUT;
            if (r < 64 * I_GU) { const int le = r / I_GU; transpose_item8(c.in[I_WGU] + (size_t)le * 1024 * 2048, 1024, 2048, c.wgu8() + (size_t)le * 2048 * 1024, c.in[I_N2G] + (le / 32) * D, scr, r % I_GU, lane); continue; } r -= 64 * I_GU;
            { const int le = r / I_DN; transpose_item8(c.in[I_WDN] + (size_t)le * 1024 * 1024, 1024, 1024, c.wdn8() + (size_t)le * 1024 * 1024, nullptr, scr, r % I_DN, lane); }
        }
        st_prep_small(gtid, gs, c); st_prep_mixw(gtid, gs, c);
        { const float* xin = uniform_ptr(c.in[I_X]); bf16_t* hbp = c.hb();
#pragma unroll 1
          for (int t = gw; t < T; t += 4 * NGW) { f32x4 v[4][4];
#pragma unroll
              for (int r = 0; r < 4; ++r) { const int tt = t + r * NGW;
#pragma unroll
                  for (int j = 0; j < 4; ++j) v[r][j] = tt < T ? *(const __attribute__((address_space(1))) f32x4*)(xin + (size_t)tt * D + 4 * lane + 256 * j) : (f32x4){0.f, 0.f, 0.f, 0.f}; }
#pragma unroll
              for (int r = 0; r < 4; ++r) { const int tt = t + r * NGW; float ss = 0.f;
#pragma unroll
                  for (int j = 0; j < 4; ++j) ss += v[r][j][0] * v[r][j][0] + v[r][j][1] * v[r][j][1] + v[r][j][2] * v[r][j][2] + v[r][j][3] * v[r][j][3];
                  const float rstd = 1.f / sqrtf(wsum(ss) * (1.f / D) + EPS);
                  if (tt < T) {
#pragma unroll
                      for (int j = 0; j < 4; ++j) { typedef unsigned u2x_ __attribute__((ext_vector_type(2))); u2x_ o; o.x = pk2(v[r][j][0] * rstd, v[r][j][1] * rstd); o.y = pk2(v[r][j][2] * rstd, v[r][j][3] * rstd);
                          *(__attribute__((address_space(1))) u2x_*)(hbp + (size_t)tt * D + 4 * lane + 256 * j) = o; } } } } }
    } else {
        constexpr int l = (PH - 1) / NPL, q = (PH - 1) % NPL;
        if constexpr (q == 0) {
            if constexpr (l == 0) st_prep_s5mat(gtid, gs, c);
            pg8::SchedPlain S; S.so.init(T / 256, D_INP / 256, G, blockIdx.x); S.Bt = (const char*)(c.win_t() + (size_t)l * D_INP * D); S.tstepB = (size_t)256 * D * 2; S.rowtab = nullptr;
            EpiInW E{c.z()}; pg8::gemm_phase<EpiInW, pg8::SchedPlain, false, false, true>(lds, wave, c.hb(), D, S, E);
        } else if constexpr (q == 1) {
            for (int tile = blockIdx.x; tile < BATCH * NT; tile += G) { if constexpr ((GSEL & 1u) != 0) mixer_tile_dev(cg, l, tile, lds, wave, lane); else mixer_tile_dev(c, l, tile, lds, wave, lane); }
            for (int it = gw; it < BATCH * NT * 24; it += NGW) { if constexpr ((GSEL & 2u) != 0) s5_tile_dev<false>(cg, l, it / 24, it % 24, lds + wave * S5_LDS_WAVE, lane); else s5_tile_dev<false>(c, l, it / 24, it % 24, lds + wave * S5_LDS_WAVE, lane); }
        } else if constexpr (q == 2) { st_carries_dev(gtid, gs, c, l);
        } else if constexpr (q == 3) {
            for (int it = gw; it < BATCH * NT * 24; it += NGW) { if constexpr ((GSEL & 2u) != 0) s5_tile_dev<true>(cg, l, it / 24, it % 24, lds + wave * S5_LDS_WAVE, lane); else s5_tile_dev<true>(c, l, it / 24, it % 24, lds + wave * S5_LDS_WAVE, lane); }
        } else if constexpr (q == 4) {
            pg8::SchedPlain S; S.so.init(T / 256, 3, G, blockIdx.x); S.Bt = (const char*)(c.wglu_t() + (size_t)l * 768 * 384); S.tstepB = (size_t)256 * 384 * 2; S.rowtab = nullptr;
            EpiGluW E{c.yb(), uniform_ptr(c.in[I_BGLU]) + l * 768}; pg8::gemm_phase<EpiGluW, pg8::SchedPlain, false, false, true>(lds, wave, c.v(), 384, S, E);
        } else if constexpr (q == 5) { for (int t = gw; t < T; t += NGW) { if constexpr ((GSEL & 4u) != 0) row_mix_norm2_dev(cg, t, lane); else row_mix_norm2_dev(c, t, lane); }
        } else if constexpr (q == 6) {
            pg8::SchedPlain S; S.so.init(T / 256, 4, G, blockIdx.x); S.Bt = (const char*)(c.wout_t() + (size_t)l * D * D); S.tstepB = (size_t)256 * D * 2; S.rowtab = nullptr;
            EpiOutW<l == 0> E{l == 0 ? (const void*)uniform_ptr(c.in[I_X]) : (const void*)c.X(), (bf16_t*)c.X()}; pg8::gemm_phase<EpiOutW<l == 0>, pg8::SchedPlain, false, false, true>(lds, wave, c.o(), D, S, E);
        } else if constexpr (q == 7) {
            static_assert(T % (NWAVES * RB * 4) == 0, "router: 128 rows per workgroup pass");
            LAS int* park = (LAS int*)lds;
            LAS int* hist = (LAS int*)(lds + 2048);
            for (int tb = blockIdx.x * 128; tb < T; tb += G * 128) {
                if (tid_o < 64) hist[tid_o] = 0;
                LAS float* lgs = (LAS float*)(lds + 4096 + wave * 2048);
                router_logits16(cg, l, tb + wave * 16, lane, lgs);
#pragma unroll 1
                for (int i = 0; i < 4; ++i) { if constexpr ((GSEL & 16u) != 0) router_rows(cg, l, tb + wave * 16 + i * RB, lane, park + wave * 64 + i * RB * 4, lgs + i * RB * 32); else router_rows(c, l, tb + wave * 16 + i * RB, lane, park + wave * 64 + i * RB * 4, lgs + i * RB * 32); }
                __syncthreads();
                const int ex_ = park[tid_o]; const int rank = __hip_atomic_fetch_add(hist + ex_, 1, __ATOMIC_RELAXED, __HIP_MEMORY_SCOPE_WORKGROUP);
                __syncthreads();
                if (tid_o < 32) hist[32 + tid_o] = (int)atomicAdd(c.ctl() + CW_CNT + (32 * l + tid_o) * CNT_STRIDE, (unsigned)hist[tid_o]);
                __syncthreads();
                c.tkp()[tb * 4 + tid_o] = hist[32 + ex_] + rank;
                __syncthreads(); }
        } else if constexpr (q == 8) { st_route_dev(gtid, gs, c, l, (LAS int*)lds, tid_o);
        } else if constexpr (q == 9) {
            const int nmb = (int)c.ctl()[CW_NMB + l];
            pg8::SchedMoe S; S.so.init(nmb, 8, G, blockIdx.x); S.Bt = (const char*)(c.wgu8() + (size_t)l * NE * 2048 * 1024); S.tstepB = (size_t)256 * 1024; S.estride = (size_t)2048 * 1024; S.rowtab = c.rowtok(); S.blke = c.blke();
            EpiMoe1F8 E{c.act8(), uniform_ptr(c.in[I_BGU]) + (size_t)l * NE * 2048}; pg8::gemm_phase<EpiMoe1F8, pg8::SchedMoe, true, true, true>(lds, wave, (const bf16_t*)c.hq(), 512, S, E);
#ifdef PROBE_MOENULL
            { __syncthreads(); EpiNullW E2; pg8::gemm_phase<EpiNullW, pg8::SchedMoe, true, true, true>(lds, wave, (const bf16_t*)c.hq(), 512, S, E2); }
#endif
        } else if constexpr (q == 10) {
            const int nmb = (int)c.ctl()[CW_NMB + l];
            pg8::SchedMoe S; S.so.init(nmb, 4, G, blockIdx.x); S.Bt = (const char*)(c.wdn8() + (size_t)l * NE * 1024 * 1024); S.tstepB = (size_t)256 * 1024; S.estride = (size_t)1024 * 1024; S.rowtab = nullptr; S.blke = c.blke();
            EpiMoe2F8 E{c.yexp(), uniform_ptr(c.in[I_BDN]) + (size_t)l * NE * 1024, c.rowgate()}; pg8::gemm_phase<EpiMoe2F8, pg8::SchedMoe, false, true, true>(lds, wave, (const bf16_t*)c.act8(), 512, S, E);
#ifdef PROBE_MOENULL
            { __syncthreads(); EpiNullW E2; pg8::gemm_phase<EpiNullW, pg8::SchedMoe, false, true, true>(lds, wave, (const bf16_t*)c.act8(), 512, S, E2); }
#endif
        } else {
#ifdef PROBE_COMBINE
            if (l == 0) { for (int t = gw; t < T; t += NGW) row_combine_dev(c, t, lane, false, true); __syncthreads(); }
#endif
            for (int t = gw; t < T; t += NGW) { if constexpr ((GSEL & 8u) != 0) row_combine_dev(cg, t, lane, l == DEPTH - 1); else row_combine_dev(c, t, lane, l == DEPTH - 1); } }
    }
}
template <int PH>
__device__ __forceinline__ void run_from(const Ctx& c0, LAS unsigned char* lds, const int wave, const int G, const int lo, const int hi, const XcdBarrier& bar) {
    if (lo <= PH && PH < hi) {
        run_phase<PH>(c0, lds, wave, G);
#ifdef PROBE_REP
        if constexpr (((PROBE_REP >> (PH == 0 ? 0 : 1 + (PH - 1) % NPL)) & 1u) != 0) { __syncthreads(); run_phase<PH>(c0, lds, wave, G); }
#endif
        if (PH + 1 < hi) { const int lane = (int)__builtin_amdgcn_mbcnt_hi(~0u, __builtin_amdgcn_mbcnt_lo(~0u, 0u)); xcd_barrier(bar, wave == 0 && lane == 0); }
    }
    if constexpr (PH + 1 < NPH) run_from<PH + 1>(c0, lds, wave, G, lo, hi, bar);
}

__global__ void __launch_bounds__(NWAVES * 64, 2) mk_fwd(Args args) {
    extern __shared__ __attribute__((aligned(16))) unsigned char lds_raw[];
    LAS unsigned char* lds = (LAS unsigned char*)lds_raw;
    const int tid = threadIdx.x, wave = __builtin_amdgcn_readfirstlane(tid >> 6), G = gridDim.x;
    LAS unsigned long long* ptab = (LAS unsigned long long*)(lds + LDSCTL_OFF + 1024);
    volatile LAS unsigned* MISC = (volatile LAS unsigned*)(lds + LDSCTL_OFF);
    for (int u = tid; u < 256; u += NWAVES * 64) ((LAS unsigned*)(lds + LDSCTL_OFF))[u] = 0u;
    if (tid < 32) ptab[tid] = (unsigned long long)args.in[tid];
    if (tid == 32) ptab[32] = (unsigned long long)args.out;
    if (tid == 33) ptab[33] = (unsigned long long)args.ws;
    __syncthreads();
    Ctx c0; c0.in = (const float* const*)(const void*)(lds_raw + LDSCTL_OFF + 1024);
    { unsigned long long o = ptab[32], w = ptab[33];
      c0.out = (float*)(((unsigned long long)(unsigned)__builtin_amdgcn_readfirstlane((int)(o >> 32)) << 32) | (unsigned)__builtin_amdgcn_readfirstlane((int)o));
      c0.ws = (unsigned char*)(((unsigned long long)(unsigned)__builtin_amdgcn_readfirstlane((int)(w >> 32)) << 32) | (unsigned)__builtin_amdgcn_readfirstlane((int)w)); }
    XcdBarrier bar; bar.bar = (unsigned*)(args.ws + WS_CTL) + CW_BAR; bar.x = 0; bar.st = nullptr;
    if (args.ph_hi - args.ph_lo > 1) bar = xcd_barrier_post((unsigned*)(args.ws + WS_CTL) + CW_BAR, MISC + 8);
    run_from<0>(c0, lds, wave, G, args.ph_lo, args.ph_hi, bar);
}

extern "C" void kernel_launch(void* const* d_in, const int* in_sizes, int n_in, void* d_out, int out_size, void* d_ws, size_t ws_size, hipStream_t stream) {
    static int grid = 0;
    if (grid == 0) {
        if (n_in != 32 || in_sizes[0] != T * D || out_size != T * D || ws_size < WS_END) { fprintf(stderr, "kernel_launch: unexpected shapes (n_in %d in0 %d out %d ws %zu need %zu)\n", n_in, n_in > 0 ? in_sizes[0] : -1, out_size, ws_size, (size_t)WS_END); grid = -1; return; }
        int dev = 0, cus = 0, per_cu = 0;
        if (hipGetDevice(&dev) != hipSuccess || hipDeviceGetAttribute(&cus, hipDeviceAttributeMultiprocessorCount, dev) != hipSuccess) { grid = -1; return; }
        if (hipFuncSetAttribute((const void*)mk_fwd, hipFuncAttributeMaxDynamicSharedMemorySize, LDS_BYTES) != hipSuccess) { fprintf(stderr, "kernel_launch: hipFuncSetAttribute failed\n"); grid = -1; return; }
        if (hipOccupancyMaxActiveBlocksPerMultiprocessor(&per_cu, (const void*)mk_fwd, NWAVES * 64, LDS_BYTES) != hipSuccess || per_cu < 1) { fprintf(stderr, "kernel_launch: occupancy query reports %d blocks per CU\n", per_cu); per_cu = 1; }
        (void)hipGetLastError();
        grid = cus;
    }
    if (grid < 0) return;
    (void)hipMemsetAsync((char*)d_ws + WS_CTL, 0, CTL_BYTES, stream);
    Args a; memset(&a, 0, sizeof(a));
    for (int i = 0; i < 32; ++i) a.in[i] = (const float*)d_in[i];
    a.out = (float*)d_out; a.ws = (unsigned char*)d_ws;
#if MK_PER_PHASE
    for (int ph = 0; ph < NPH; ++ph) { a.ph_lo = ph; a.ph_hi = ph + 1; hipLaunchKernelGGL(mk_fwd, dim3(grid), dim3(NWAVES * 64), LDS_BYTES, stream, a); }
#else
    a.ph_lo = 0; a.ph_hi = NPH;
    void* kargs[] = {&a};
    hipError_t e = hipLaunchCooperativeKernel((const void*)mk_fwd, dim3(grid), dim3(NWAVES * 64), kargs, LDS_BYTES, stream);
    if (e != hipSuccess) fprintf(stderr, "kernel_launch: cooperative launch failed: %s\n", hipGetErrorString(e));
#endif
}
#endif
```
